# Optimizing an MI355X kernel written in HIP

```python
import jax, jax.numpy as jnp
from jax import lax
import numpy as np

D_MODEL = 2048
BATCH = 1
SEQ = 16384
DEPTH = 2

N_EVEN = (DEPTH + 1) // 2
N_ODD = DEPTH // 2
EPS = 1e-6
ROPE_THETA = 10000.0
Q_BLOCK = 128

M_HEADS = 4
M_QK = 128
M_V = 256
M_CHUNK = 64
GATE_SOFTCAP = 15.0

A_HEADS = 8
A_NOPE = 128
A_ROPE = 64
A_V = 128
A_Q_LORA = 768
A_KV_LORA = 512

S_HEADS = 32
S_KV_HEADS = 4
S_HD = 64
S_WINDOW = 128

N_EXPERTS = 64
TOP_K = 8
N_GROUPS = 8
TOPK_GROUPS = 4
E_FF = 256
SHARED_FF = 256
ROUTED_SCALE = 2.5
E_BLOCK = 256

IN_SIZES = (
    M_HEADS * M_QK,
    M_HEADS * M_QK,
    M_HEADS * M_V,
    M_HEADS * M_V,
    M_HEADS,
    M_HEADS,
    A_Q_LORA,
    A_KV_LORA,
    A_ROPE,
)
IN_DIM = sum(IN_SIZES)
MIX_OUT = M_HEADS * M_V + A_HEADS * A_V
SWA_QKV = (S_HEADS + 2 * S_KV_HEADS) * S_HD

kernel_name = "hybrid_mlstm_mla_swa_moe_adaln"


def rms_norm(x, gain=None):
    xf = x.astype(jnp.float32)
    y = xf * lax.rsqrt(jnp.mean(xf * xf, axis=-1, keepdims=True) + EPS)
    if gain is not None:
        y = y * gain.astype(jnp.float32)
    return y.astype(x.dtype)


def rope(x, positions):
    d = x.shape[-1]
    half = d // 2
    inv_freq = jnp.power(ROPE_THETA, -jnp.arange(half, dtype=jnp.float32) / half)
    ang = positions.astype(jnp.float32)[..., None] * inv_freq
    cos = jnp.cos(ang)[:, :, None, :]
    sin = jnp.sin(ang)[:, :, None, :]
    xf = x.astype(jnp.float32)
    x1, x2 = xf[..., :half], xf[..., half:]
    out = jnp.concatenate([x1 * cos - x2 * sin, x2 * cos + x1 * sin], axis=-1)
    return out.astype(x.dtype)


def modulate(x, shift, scale):
    return rms_norm(x) * (1 + scale[:, None, :]) + shift[:, None, :]


def mlstm_chunkwise(q, k, v, i_pre, f_pre):
    B, S, H, dk = q.shape
    dv = v.shape[-1]
    L = M_CHUNK
    nc = S // L
    q = q.astype(jnp.float32)
    k = k.astype(jnp.float32) * (dk ** -0.5)
    v = v.astype(jnp.float32)
    ig = GATE_SOFTCAP * jnp.tanh(i_pre.astype(jnp.float32) / GATE_SOFTCAP)
    lf = jax.nn.log_sigmoid(GATE_SOFTCAP * jnp.tanh(f_pre.astype(jnp.float32) / GATE_SOFTCAP))

    def to_chunks(t):
        return t.reshape(B, nc, L, H, t.shape[-1]).transpose(1, 0, 3, 2, 4)

    def gate_chunks(t):
        return t.reshape(B, nc, L, H).transpose(1, 0, 3, 2)

    causal = jnp.tril(jnp.ones((L, L), dtype=bool))

    def step(carry, xs):
        C, n, m = carry
        qc, kc, vc, igc, lfc = xs
        b = jnp.cumsum(lfc, axis=-1)
        Dm = b[..., :, None] - b[..., None, :] + igc[..., None, :]
        Dm = jnp.where(causal, Dm, -jnp.inf)
        inter = b + m[..., None]
        m_row = jnp.maximum(inter, jnp.max(Dm, axis=-1))
        w_intra = jnp.exp(Dm - m_row[..., None])
        w_inter = jnp.exp(inter - m_row)
        s = jnp.einsum('bhjd,bhsd->bhjs', qc, kc) * w_intra
        num = (jnp.einsum('bhjs,bhsv->bhjv', s, vc)
               + w_inter[..., None] * jnp.einsum('bhjd,bhvd->bhjv', qc, C))
        den = jnp.sum(s, axis=-1) + w_inter * jnp.einsum('bhjd,bhd->bhj', qc, n)
        h = num / jnp.maximum(jnp.abs(den), jnp.exp(-m_row))[..., None]
        bL = b[..., -1]
        g = bL[..., None] - b + igc
        m_new = jnp.maximum(bL + m, jnp.max(g, axis=-1))
        ws = jnp.exp(g - m_new[..., None])
        decay = jnp.exp(bL + m - m_new)
        C_new = decay[..., None, None] * C + jnp.einsum('bhs,bhsv,bhsd->bhvd', ws, vc, kc)
        n_new = decay[..., None] * n + jnp.einsum('bhs,bhsd->bhd', ws, kc)
        return (C_new, n_new, m_new), h

    init = (jnp.zeros((B, H, dv, dk), jnp.float32),
            jnp.zeros((B, H, dk), jnp.float32),
            jnp.zeros((B, H), jnp.float32))
    _, h = lax.scan(step, init, (to_chunks(q), to_chunks(k), to_chunks(v),
                                 gate_chunks(ig), gate_chunks(lf)))
    return h.transpose(1, 0, 3, 2, 4).reshape(B, S, H, dv)


def causal_attention_blocks(q, k, v, scale):
    B, S, H, dq = q.shape
    nb = S // Q_BLOCK
    outs = []
    for bi in range(nb):
        lo = bi * Q_BLOCK
        hi = lo + Q_BLOCK
        s = jnp.einsum('bqhd,bkhd->bhqk', q[:, lo:hi], k[:, :hi],
                       preferred_element_type=jnp.float32) * scale
        mask = jnp.arange(hi)[None, :] <= (lo + jnp.arange(Q_BLOCK))[:, None]
        p = jax.nn.softmax(jnp.where(mask, s, -jnp.inf), axis=-1)
        outs.append(jnp.einsum('bhqk,bkhd->bqhd', p.astype(v.dtype), v[:, :hi]))
    return jnp.concatenate(outs, axis=1)


def mla(cq, ckv, kr, positions, q_norm, kv_norm, w_uq, w_ukv):
    B, S, _ = cq.shape
    q = (rms_norm(cq, q_norm) @ w_uq).reshape(B, S, A_HEADS, A_NOPE + A_ROPE)
    q = jnp.concatenate([q[..., :A_NOPE], rope(q[..., A_NOPE:], positions)], axis=-1)
    kv = (rms_norm(ckv, kv_norm) @ w_ukv).reshape(B, S, A_HEADS, A_NOPE + A_V)
    k_nope, v = kv[..., :A_NOPE], kv[..., A_NOPE:]
    k_pe = rope(kr[:, :, None, :], positions)
    k = jnp.concatenate([k_nope, jnp.broadcast_to(k_pe, (B, S, A_HEADS, A_ROPE))], axis=-1)
    o = causal_attention_blocks(q, k, v, (A_NOPE + A_ROPE) ** -0.5)
    return o.reshape(B, S, A_HEADS * A_V)


def even_mixer(h, positions, w_in, b_if, mlstm_norm, q_norm, kv_norm, w_uq, w_ukv, w_out):
    B, S, _ = h.shape
    proj = h @ w_in
    parts = []
    off = 0
    for sz in IN_SIZES:
        parts.append(proj[..., off:off + sz])
        off += sz
    mq, mk, mv, mo, mi, mf, cq, ckv, kr = parts
    hm = mlstm_chunkwise(mq.reshape(B, S, M_HEADS, M_QK), mk.reshape(B, S, M_HEADS, M_QK),
                         mv.reshape(B, S, M_HEADS, M_V),
                         mi + b_if[:M_HEADS], mf + b_if[M_HEADS:])
    hm = rms_norm(hm).reshape(B, S, M_HEADS * M_V) * mlstm_norm.astype(jnp.float32)
    hm = (hm * jax.nn.sigmoid(mo.astype(jnp.float32))).astype(h.dtype)
    ha = mla(cq, ckv, kr, positions, q_norm, kv_norm, w_uq, w_ukv)
    return jnp.concatenate([hm, ha], axis=-1) @ w_out


def swa_sinks(q, k, v, sinks):
    B, S, Hq, D = q.shape
    Hkv = k.shape[2]
    G = Hq // Hkv
    nb = S // Q_BLOCK
    qb = q.reshape(B, nb, Q_BLOCK, Hkv, G, D).transpose(1, 0, 2, 3, 4, 5)

    def window(t):
        tb = t.reshape(B, nb, Q_BLOCK, Hkv, D)
        prev = jnp.concatenate([jnp.zeros_like(tb[:, :1]), tb[:, :-1]], axis=1)
        return jnp.concatenate([prev, tb], axis=2).transpose(1, 0, 2, 3, 4)

    kw, vw = window(k), window(v)
    dist = Q_BLOCK + jnp.arange(Q_BLOCK)[:, None] - jnp.arange(2 * Q_BLOCK)[None, :]
    band = (dist >= 0) & (dist < S_WINDOW)
    sink = sinks.astype(jnp.float32).reshape(Hkv, G)[None, :, :, None, None]
    scale = D ** -0.5

    def one(args):
        qi, ki, vi, bidx = args
        s = jnp.einsum('bqhgd,bkhd->bhgqk', qi, ki, preferred_element_type=jnp.float32) * scale
        kpos = bidx * Q_BLOCK - Q_BLOCK + jnp.arange(2 * Q_BLOCK)
        valid = band & (kpos >= 0)[None, :]
        s = jnp.where(valid, s, -jnp.inf)
        m = jnp.maximum(jnp.max(s, axis=-1, keepdims=True), sink)
        p = jnp.exp(s - m)
        p = p / (jnp.sum(p, axis=-1, keepdims=True) + jnp.exp(sink - m))
        return jnp.einsum('bhgqk,bkhd->bqhgd', p.astype(vi.dtype), vi)

    out = lax.map(one, (qb, kw, vw, jnp.arange(nb)))
    return out.transpose(1, 0, 2, 3, 4, 5).reshape(B, S, Hq * D)


def odd_mixer(h, positions, w_qkv, b_qkv, sinks, w_o):
    B, S, _ = h.shape
    qkv = h @ w_qkv + b_qkv
    nq = S_HEADS * S_HD
    nk = S_KV_HEADS * S_HD
    q = rope(qkv[..., :nq].reshape(B, S, S_HEADS, S_HD), positions)
    k = rope(qkv[..., nq:nq + nk].reshape(B, S, S_KV_HEADS, S_HD), positions)
    v = qkv[..., nq + nk:].reshape(B, S, S_KV_HEADS, S_HD)
    return swa_sinks(q, k, v, sinks) @ w_o


def moe(h, w_router, router_bias, w_gate_up, w_down, ws_gate_up, ws_down):
    B, S, D = h.shape
    T = B * S
    TK = T * TOP_K
    hf = h.reshape(T, D)
    scores = jax.nn.sigmoid(jnp.matmul(hf, w_router, preferred_element_type=jnp.float32))
    biased = scores + router_bias.astype(jnp.float32)
    per_group = N_EXPERTS // N_GROUPS
    grp_score = jnp.sum(lax.top_k(biased.reshape(T, N_GROUPS, per_group), 2)[0], axis=-1)
    _, top_groups = lax.top_k(grp_score, TOPK_GROUPS)
    gmask = jnp.sum(jax.nn.one_hot(top_groups, N_GROUPS, dtype=jnp.float32), axis=1) > 0
    masked = jnp.where(jnp.repeat(gmask, per_group, axis=-1), biased, -jnp.inf)
    _, idx = lax.top_k(masked, TOP_K)
    w = jnp.take_along_axis(scores, idx, axis=-1)
    w = w / jnp.sum(w, axis=-1, keepdims=True) * ROUTED_SCALE
    flat_e = idx.reshape(-1)
    order = jnp.argsort(flat_e)
    se = flat_e[order]
    stok = (jnp.arange(TK, dtype=jnp.int32) // TOP_K)[order]
    sw = w.reshape(-1)[order]
    gs = jnp.bincount(flat_e, length=N_EXPERTS).astype(jnp.int32)
    start = jnp.cumsum(gs) - gs
    pgs = ((gs + E_BLOCK - 1) // E_BLOCK) * E_BLOCK
    pend = jnp.cumsum(pgs)
    pstart = pend - pgs
    dest = pstart[se] + jnp.arange(TK, dtype=jnp.int32) - start[se]
    NPAD = TK + N_EXPERTS * E_BLOCK
    nblk = NPAD // E_BLOCK
    src = jnp.full((NPAD,), T, jnp.int32).at[dest].set(stok)
    wbuf = jnp.zeros((NPAD,), jnp.float32).at[dest].set(sw)
    xbuf = jnp.take(hf, src, axis=0, mode='fill', fill_value=0)
    block_e = jnp.minimum(jnp.searchsorted(pend, jnp.arange(nblk) * E_BLOCK, side='right'),
                          N_EXPERTS - 1)

    def expert_block(args):
        xb, e = args
        gu = xb @ w_gate_up[e]
        return (jax.nn.silu(gu[:, :E_FF]) * gu[:, E_FF:]) @ w_down[e]

    ybuf = lax.map(expert_block, (xbuf.reshape(nblk, E_BLOCK, D), block_e)).reshape(NPAD, D)
    ybuf = ybuf * wbuf[:, None].astype(ybuf.dtype)
    routed = jnp.zeros((T, D), ybuf.dtype).at[src].add(ybuf, mode='drop')
    sg = hf @ ws_gate_up
    shared = (jax.nn.silu(sg[:, :SHARED_FF]) * sg[:, SHARED_FF:]) @ ws_down
    return (routed + shared).reshape(B, S, D)


def setup_inputs(seed: int = 0) -> dict:
    key = jax.random.key(seed)
    ks = iter(jax.random.split(key, 40))
    f32 = jnp.float32
    D = D_MODEL

    def nrm(shape, scale):
        return jax.random.normal(next(ks), shape, f32) * scale

    def gain(shape):
        return 1.0 + 0.02 * jax.random.normal(next(ks), shape, f32)

    x = nrm((BATCH, SEQ, D), 1.0)
    c = nrm((BATCH, D), 1.0)
    offset = jax.random.randint(next(ks), (BATCH, 1), 0, 1024, dtype=jnp.int32)
    positions = offset + jnp.arange(SEQ, dtype=jnp.int32)[None, :]

    w_ada = nrm((DEPTH, D, 6 * D), 0.5 * D ** -0.5)
    b_ada = nrm((DEPTH, 6 * D), 0.02)

    a_w_in = nrm((N_EVEN, D, IN_DIM), D ** -0.5)
    b_i = nrm((N_EVEN, M_HEADS), 0.1)
    b_f = 3.0 + 0.5 * jax.random.normal(next(ks), (N_EVEN, M_HEADS), f32)
    a_b_if = jnp.concatenate([b_i, b_f], axis=-1)
    a_mlstm_norm = gain((N_EVEN, M_HEADS * M_V))
    a_q_norm = gain((N_EVEN, A_Q_LORA))
    a_kv_norm = gain((N_EVEN, A_KV_LORA))
    a_w_uq = nrm((N_EVEN, A_Q_LORA, A_HEADS * (A_NOPE + A_ROPE)), A_Q_LORA ** -0.5)
    a_w_ukv = nrm((N_EVEN, A_KV_LORA, A_HEADS * (A_NOPE + A_V)), A_KV_LORA ** -0.5)
    a_w_out = nrm((N_EVEN, MIX_OUT, D), MIX_OUT ** -0.5)

    s_w_qkv = nrm((N_ODD, D, SWA_QKV), D ** -0.5)
    s_b_qkv = nrm((N_ODD, SWA_QKV), 0.02)
    s_sinks = nrm((N_ODD, S_HEADS), 1.0)
    s_w_o = nrm((N_ODD, S_HEADS * S_HD, D), (S_HEADS * S_HD) ** -0.5)

    e_w_router = nrm((DEPTH, D, N_EXPERTS), D ** -0.5)
    e_router_bias = nrm((DEPTH, N_EXPERTS), 0.01)
    e_w_gate_up = nrm((DEPTH, N_EXPERTS, D, 2 * E_FF), D ** -0.5)
    e_w_down = nrm((DEPTH, N_EXPERTS, E_FF, D), E_FF ** -0.5)
    e_ws_gate_up = nrm((DEPTH, D, 2 * SHARED_FF), D ** -0.5)
    e_ws_down = nrm((DEPTH, SHARED_FF, D), SHARED_FF ** -0.5)

    final_norm = gain((D,))
    return {
        "x": x, "c": c, "positions": positions,
        "w_ada": w_ada, "b_ada": b_ada,
        "a_w_in": a_w_in, "a_b_if": a_b_if, "a_mlstm_norm": a_mlstm_norm,
        "a_q_norm": a_q_norm, "a_kv_norm": a_kv_norm, "a_w_uq": a_w_uq,
        "a_w_ukv": a_w_ukv, "a_w_out": a_w_out,
        "s_w_qkv": s_w_qkv, "s_b_qkv": s_b_qkv, "s_sinks": s_sinks, "s_w_o": s_w_o,
        "e_w_router": e_w_router, "e_router_bias": e_router_bias,
        "e_w_gate_up": e_w_gate_up, "e_w_down": e_w_down,
        "e_ws_gate_up": e_ws_gate_up, "e_ws_down": e_ws_down,
        "final_norm": final_norm,
    }


def reference(x, c, positions, w_ada, b_ada,
              a_w_in, a_b_if, a_mlstm_norm, a_q_norm, a_kv_norm, a_w_uq, a_w_ukv, a_w_out,
              s_w_qkv, s_b_qkv, s_sinks, s_w_o,
              e_w_router, e_router_bias, e_w_gate_up, e_w_down, e_ws_gate_up, e_ws_down,
              final_norm):
    c_act = jax.nn.silu(c)
    for layer in range(DEPTH):
        mod = c_act @ w_ada[layer] + b_ada[layer]
        sh1, sc1, g1, sh2, sc2, g2 = jnp.split(mod, 6, axis=-1)
        h = modulate(x, sh1, sc1)
        if layer % 2 == 0:
            e = layer // 2
            mix = even_mixer(h, positions, a_w_in[e], a_b_if[e], a_mlstm_norm[e], a_q_norm[e],
                             a_kv_norm[e], a_w_uq[e], a_w_ukv[e], a_w_out[e])
        else:
            o = layer // 2
            mix = odd_mixer(h, positions, s_w_qkv[o], s_b_qkv[o], s_sinks[o], s_w_o[o])
        x = x + g1[:, None, :] * mix
        h = modulate(x, sh2, sc2)
        x = x + g2[:, None, :] * moe(h, e_w_router[layer], e_router_bias[layer],
                                     e_w_gate_up[layer], e_w_down[layer],
                                     e_ws_gate_up[layer], e_ws_down[layer])
    return rms_norm(x, final_norm)
```

```cpp
#include <hip/hip_runtime.h>
#include <cstdio>
#include <cstdint>
#include <cstring>

#ifndef PROBE_EXTRA_BARRIERS
#define PROBE_EXTRA_BARRIERS 0
#endif
#ifndef PROBE_DOWN_NOSTORE
#define PROBE_DOWN_NOSTORE 0
#endif
#ifndef EXP_DUP_LDS
#define EXP_DUP_LDS 0
#endif
#ifndef EXP_DUP_QK
#define EXP_DUP_QK 0
#endif
#ifndef EXP_DUP_EXP
#define EXP_DUP_EXP 0
#endif
#ifndef ATT_STAGGER
#define ATT_STAGGER 0
#endif
#ifndef NT_STORES
#define NT_STORES 0
#endif
#ifndef DENSE_XCD
#define DENSE_XCD 0
#endif
#ifndef PROBE_SET
#define PROBE_SET 0
#endif
#define PRB(bit) _Pragma("unroll") for (int rep_ = 0; rep_ < (((PROBE_SET) >> (bit)) & 1) + 1; ++rep_)
#ifndef PROBE_REP_MLA
#define PROBE_REP_MLA 1
#endif
#ifndef MCV_BLOCKS
#define MCV_BLOCKS 32
#endif
#ifndef MK_MULTI
#define MK_MULTI 0
#endif

#define LAS __attribute__((address_space(3)))
typedef unsigned short bf16_t;
typedef short bf16x8 __attribute__((ext_vector_type(8)));
typedef short s16x4 __attribute__((ext_vector_type(4)));
typedef float f32x4 __attribute__((ext_vector_type(4)));
typedef float f32x16 __attribute__((ext_vector_type(16)));
typedef unsigned u32x4 __attribute__((ext_vector_type(4)));
typedef unsigned u32x2 __attribute__((ext_vector_type(2)));

constexpr int T = 16384, D = 2048;
constexpr int IN_DIM = 4424, IN_PAD = 4608;
constexpr int OFF_MQ = 0, OFF_MK = 512, OFF_MV = 1024, OFF_MO = 2048, OFF_MI = 3072, OFF_MF = 3076, OFF_CQ = 3080, OFF_CKV = 3848, OFF_KR = 4360;
constexpr int NE = 64, TOPK = 8, EFF = 256;
constexpr int NSLOT = T + T * TOPK + NE * 256;
constexpr int NCH = 256;
constexpr float EPS = 1e-6f;

constexpr size_t al256(size_t x) { return (x + 255) & ~(size_t)255; }
constexpr size_t WS_ZERO = 0;
constexpr size_t ZB_BAR = 0;
constexpr size_t ZB_MOD = 16384;
constexpr size_t ZB_CTR = 16384 + 98304;
constexpr size_t ZERO_BYTES = 16384 + 98304 + 16384;
constexpr size_t WS_ROPE = al256(WS_ZERO + ZERO_BYTES);
constexpr size_t WS_WIN = al256(WS_ROPE + (size_t)T * 32 * 8);
constexpr size_t WS_WUQ = al256(WS_WIN + (size_t)IN_PAD * 2048 * 2);
constexpr size_t WS_WUKV = al256(WS_WUQ + (size_t)1536 * 768 * 2);
constexpr size_t WS_WOUT = al256(WS_WUKV + (size_t)2048 * 512 * 2);
constexpr size_t WS_WQKV = al256(WS_WOUT + (size_t)2048 * 2048 * 2);
constexpr size_t WS_WO = al256(WS_WQKV + (size_t)2560 * 2048 * 2);
constexpr size_t WS_WR = al256(WS_WO + (size_t)2048 * 2048 * 2);
constexpr size_t WS_WGU = al256(WS_WR + (size_t)2 * 256 * 4096 * 2);
constexpr size_t WS_WDN = al256(WS_WGU + (size_t)2 * 65 * 512 * 2048 * 2);
constexpr size_t WS_HA = al256(WS_WDN + (size_t)2 * 65 * 2048 * 256 * 2);
constexpr size_t WS_H2 = al256(WS_HA + (size_t)T * 2048 * 2);
constexpr size_t WS_XA = al256(WS_H2 + (size_t)T * 4096 * 2);
constexpr size_t WS_XB = al256(WS_XA + (size_t)T * 2048 * 4);
constexpr size_t WS_HCAT = al256(WS_XB + (size_t)T * 2048 * 4);
constexpr size_t WS_GA = al256(WS_HCAT + (size_t)T * 2048 * 2);
constexpr size_t WS_GB = al256(WS_GA + (size_t)4 * T * 4);
constexpr size_t WS_GCM = al256(WS_GB + (size_t)4 * T * 4);
constexpr size_t WS_GST = al256(WS_GCM + (size_t)4 * T * 4);
constexpr size_t WS_DN = al256(WS_GST + 16384);
constexpr size_t WS_NST = al256(WS_DN + (size_t)NCH * 4 * 128 * 4);
constexpr size_t WS_LOGP = al256(WS_NST + (size_t)NCH * 4 * 128 * 4);
constexpr size_t WS_TKI = al256(WS_LOGP + (size_t)4 * T * 128 * 4);
constexpr size_t WS_TKW = al256(WS_TKI + (size_t)T * 8 * 4);
constexpr size_t WS_PSLOT = al256(WS_TKW + (size_t)T * 8 * 4);
constexpr size_t WS_HIST = al256(WS_PSLOT + (size_t)T * 8 * 4);
constexpr size_t WS_ETAB = al256(WS_HIST + (size_t)256 * 64 * 4);
constexpr size_t WS_ROWTOK = al256(WS_ETAB + 4096);
constexpr size_t WS_ACT = al256(WS_ROWTOK + (size_t)NSLOT * 4);
constexpr size_t WS_Y = al256(WS_ACT + (size_t)NSLOT * 256 * 2);
constexpr size_t WS_PROJ = WS_Y;
constexpr size_t WS_CQN = al256(WS_PROJ + (size_t)T * IN_PAD * 2);
constexpr size_t WS_CKVN = al256(WS_CQN + (size_t)T * 768 * 2);
constexpr size_t WS_KPE = al256(WS_CKVN + (size_t)T * 512 * 2);
constexpr size_t WS_QRAW = al256(WS_KPE + (size_t)T * 64 * 2);
constexpr size_t WS_KVRAW = al256(WS_QRAW + (size_t)T * 1536 * 2);
constexpr size_t WS_DC = al256(WS_KVRAW + (size_t)T * 2048 * 2);
constexpr size_t WS_CST = al256(WS_DC + (size_t)NCH * 4 * 256 * 128 * 2);
constexpr size_t WS_MIXEND = al256(WS_CST + (size_t)NCH * 4 * 256 * 128 * 2);
constexpr size_t WS_END = al256(WS_Y + (size_t)NSLOT * 2048 * 2);
static_assert(WS_MIXEND <= WS_END, "mixer temporaries must fit inside the Y region");

__device__ __forceinline__ unsigned cvt_pk_bf16(float lo, float hi) { unsigned r; asm volatile("v_cvt_pk_bf16_f32 %0, %1, %2" : "=v"(r) : "v"(lo), "v"(hi)); return r; }
__device__ __forceinline__ float bf2f(unsigned short h) { return __uint_as_float((unsigned)h << 16); }
__device__ __forceinline__ float bflo(unsigned w) { return __uint_as_float(w << 16); }
__device__ __forceinline__ float bfhi(unsigned w) { return __uint_as_float(w & 0xffff0000u); }
__device__ __forceinline__ bf16_t f2bf(float f) { return (bf16_t)(cvt_pk_bf16(f, f) & 0xffffu); }
template <int CTRL> __device__ __forceinline__ float dpp_add(float v) { return v + __int_as_float(__builtin_amdgcn_update_dpp(0, __float_as_int(v), CTRL, 0xF, 0xF, true)); }
__device__ __forceinline__ float wave_sum(float v) {
    v = dpp_add<0xB1>(v); v = dpp_add<0x4E>(v); v = dpp_add<0x141>(v); v = dpp_add<0x140>(v);
    v += __int_as_float(__builtin_amdgcn_ds_swizzle(__float_as_int(v), 0x401F));
    return __int_as_float(__builtin_amdgcn_readlane(__float_as_int(v), 0)) + __int_as_float(__builtin_amdgcn_readlane(__float_as_int(v), 32));
}
__device__ __forceinline__ float sigmoidf_(float x) { return 1.0f / (1.0f + __expf(-x)); }

#define XB_TMO      128
#define XB_XCNT(j)  (256  + 64 * (j))
#define XB_XSUB(j)  (1280 + 64 * (j))
#define XB_XGEN(j)  (2304 + 64 * (j))
#define XB_TOP      3328
#define XB_TOPGEN   3392
#define XCD_BAR_WORDS 3456
#define XB_SPIN_CAP (1u << 22)
__device__ __forceinline__ unsigned xb_ld(unsigned* p)              { return __hip_atomic_load(p, __ATOMIC_RELAXED, __HIP_MEMORY_SCOPE_AGENT); }
__device__ __forceinline__ unsigned xb_add(unsigned* p, unsigned v) { return __hip_atomic_fetch_add(p, v, __ATOMIC_RELAXED, __HIP_MEMORY_SCOPE_AGENT); }
__device__ __forceinline__ unsigned xb_xcc_id() { return (unsigned)__builtin_amdgcn_s_getreg((3 << 11) | 20) & 0xFu; }
#define XB_SPIN(cond, bar) do { unsigned _sp = 0; while (cond) { __builtin_amdgcn_s_sleep(1); \
    if ((++_sp & 255u) == 0u) { if (xb_ld(&(bar)[XB_TMO])) break; if (_sp > XB_SPIN_CAP) { atomicAdd(&(bar)[XB_TMO], 1u); break; } } } } while (0)
struct XcdBarrier { unsigned* bar; unsigned x; volatile LAS unsigned* st; };
__device__ __forceinline__ XcdBarrier xcd_barrier_post(unsigned* bar, volatile LAS unsigned* st) {
    XcdBarrier b; b.bar = bar; b.x = xb_xcc_id(); b.st = st;
    if (threadIdx.x == 0) (void)xb_add(&bar[XB_XCNT(b.x)], 1u);
    return b;
}
__device__ __forceinline__ void xcd_barrier_complete(unsigned* bar, unsigned x, unsigned& nloc, unsigned& nx) {
    const unsigned G = gridDim.x * gridDim.y * gridDim.z;
    unsigned sum, cnt, mine, sp = 0u;
    for (;;) {
        sum = 0u; cnt = 0u; mine = 0u;
#pragma unroll
        for (unsigned j = 0; j < 16; ++j) { const unsigned c = xb_ld(&bar[XB_XCNT(j)]); sum += c; cnt += (c > 0u) ? 1u : 0u; mine = (j == x) ? c : mine; }
        if (sum == G) break;
        __builtin_amdgcn_s_sleep(1);
        if ((++sp & 255u) == 0u) { if (xb_ld(&bar[XB_TMO])) break; if (sp > XB_SPIN_CAP) { atomicAdd(&bar[XB_TMO], 1u); break; } }
    }
    nloc = mine > 0u ? mine : 1u; nx = cnt > 0u ? cnt : 1u;
}
__device__ __forceinline__ void xcd_barrier(const XcdBarrier& b) {
    asm volatile("s_waitcnt vmcnt(0)" ::: "memory");
    __syncthreads();
    if (threadIdx.x == 0) {
        unsigned* bar = b.bar;
        __builtin_amdgcn_s_waitcnt(0);
        unsigned nloc = b.st[0], nx = b.st[1];
        if (nloc == 0u) { xcd_barrier_complete(bar, b.x, nloc, nx); b.st[0] = nloc; b.st[1] = nx; }
        const unsigned old = xb_add(&bar[XB_XSUB(b.x)], 1u);
        const unsigned gen = old / nloc;
        if (old + 1u == (gen + 1u) * nloc) {
            __builtin_amdgcn_fence(__ATOMIC_RELEASE, "agent");
            asm volatile("s_waitcnt vmcnt(0)" ::: "memory");
            const unsigned og = xb_add(&bar[XB_TOP], 1u);
            const unsigned tg = og / nx;
            if (og + 1u == (tg + 1u) * nx) xb_add(&bar[XB_TOPGEN], 1u);
            else XB_SPIN(xb_ld(&bar[XB_TOPGEN]) == tg, bar);
            __builtin_amdgcn_fence(__ATOMIC_ACQUIRE, "agent");
            xb_add(&bar[XB_XGEN(b.x)], 1u);
            asm volatile("s_waitcnt vmcnt(0)" ::: "memory");
        } else {
            XB_SPIN(xb_ld(&bar[XB_XGEN(b.x)]) == gen, bar);
            __builtin_amdgcn_fence(__ATOMIC_ACQUIRE, "agent");
            asm volatile("s_waitcnt vmcnt(0)" ::: "memory");
        }
    }
    __syncthreads();
}

struct Args {
    const float* in[24];
    float* out;
    unsigned char* ws;
    int ph_lo, ph_hi;
};
constexpr int NTHREADS = 512;
constexpr int LDS_MAIN = 131072, LDS_AUX = 16384;
constexpr int LDS_BYTES = LDS_MAIN + LDS_AUX + 16;

struct Frame {
    LAS unsigned char* lds;
    LAS unsigned char* aux;
    const float* const* in;
    float* out;
    unsigned char* ws;
    int tid, lane, wid, G, bid;
};
#define WSP(T_, off) ((T_*)(F.ws + (off)))

namespace pg8 {
constexpr int BM = 256, BK = 64, HALF = 128, HTB = HALF * BK * 2, STAGE_BYTES = 8 * HTB;
__device__ __forceinline__ int lds_byte(int r, int c) { const int st = (r >> 4) * 2 + (c >> 5), rr = r & 15, cc = c & 31, ob = rr * 64 + cc * 2; return st * 1024 + (ob ^ (((ob >> 9) & 1) << 5)); }
__device__ __forceinline__ void stage_rc(int b, int& R, int& C) { const int st = b / 1024, sb = b % 1024, swz = sb ^ (((sb >> 9) & 1) << 5); R = (st >> 1) * 16 + swz / 64; C = (st & 1) * 32 + (swz % 64) / 2; }
__device__ __forceinline__ int perm32(int rho) { const int n = rho >> 4, i = rho & 15; return 8 * (i >> 2) + 4 * n + (i & 3); }
struct Unit { int a, b, c, d; };

template <class P>
__device__ __forceinline__ void gemm_phase(LAS unsigned char* lds, const P& p) {
    const int tid = threadIdx.x, wid = __builtin_amdgcn_readfirstlane(tid >> 6), lane = tid & 63, wr = wid >> 2, wc = wid & 3, fr = lane & 15, fq = lane >> 4;
    const int K = p.K, nt = K / BK;
    const int G = p.stride(), c0 = p.first();
    const int NU = p.nunits();
    if (c0 >= NU) return;
    int R[2], C[2]; unsigned voffB[2][2];
#pragma unroll
    for (int i = 0; i < 2; ++i) { stage_rc(tid * 16 + i * 8192, R[i], C[i]); const int Rb = P::PERM ? ((R[i] & ~31) + perm32(R[i] & 31)) : R[i];
#pragma unroll
        for (int h = 0; h < 2; ++h) voffB[h][i] = (unsigned)((h * HALF + Rb) * p.ldb + C[i]) * 2u; }
    const size_t kstep = (size_t)(BK * 2);
    const unsigned ldsw = (unsigned)wid * 1024u;
    const int aoff = lds_byte(wr * 64 + fr, fq * 8), boff = lds_byte(wc * 32 + fr, fq * 8);
    const char* const Ab = p.abase();
#define PG8_SA(b, h) (((b) * 2 + (h)) * HTB)
#define PG8_SB(b, h) ((4 + (b) * 2 + (h)) * HTB)
#define PG8_STAGE(bufoff, gbase, o0, o1) do { \
        __builtin_amdgcn_global_load_lds((const unsigned*)((const char*)(gbase) + (o0)), (LAS unsigned*)(lds + (bufoff) + ldsw), 16, 0, 0); \
        __builtin_amdgcn_global_load_lds((const unsigned*)((const char*)(gbase) + (o1)), (LAS unsigned*)(lds + (bufoff) + ldsw + 8192), 16, 0, 0); } while (0)
#define PG8_LDA(dst, b, h) do { _Pragma("unroll") for (int m = 0; m < 4; ++m) _Pragma("unroll") for (int k = 0; k < 2; ++k) dst[m][k] = *(const LAS bf16x8*)(lds + PG8_SA(b, h) + aoff + m * 2048 + k * 1024); } while (0)
#define PG8_LDB(dst, b, h) do { _Pragma("unroll") for (int n = 0; n < 2; ++n) _Pragma("unroll") for (int k = 0; k < 2; ++k) dst[n][k] = *(const LAS bf16x8*)(lds + PG8_SB(b, h) + boff + n * 2048 + k * 1024); } while (0)
#define PG8_MMA(ai, bj, At, Bt) do { __builtin_amdgcn_s_setprio(1); _Pragma("unroll") for (int m = 0; m < 4; ++m) _Pragma("unroll") for (int n = 0; n < 2; ++n) _Pragma("unroll") for (int k = 0; k < 2; ++k) \
        acc[ai][bj][m][n] = __builtin_amdgcn_mfma_f32_16x16x32_bf16(Bt[n][k], At[m][k], acc[ai][bj][m][n], 0, 0, 0); __builtin_amdgcn_s_setprio(0); } while (0)
#define PG8_WAIT_V(n) asm volatile("s_waitcnt vmcnt(" #n ")" ::: "memory")
#define PG8_WAIT_L(n) asm volatile("s_waitcnt lgkmcnt(" #n ")" ::: "memory")
#define PG8_BAR __builtin_amdgcn_s_barrier()
#define PG8_SCHED __builtin_amdgcn_sched_barrier(0)
    Unit cur, nxt; int ui = 0;
    p.unit(c0, cur);
    unsigned aoc[2][2], aon[2][2];
    p.a_off(cur, R, C, aoc);
    f32x4 acc[2][2][4][2];
#pragma unroll
    for (int a = 0; a < 2; ++a)
#pragma unroll
        for (int b = 0; b < 2; ++b)
#pragma unroll
            for (int m = 0; m < 4; ++m)
#pragma unroll
                for (int n = 0; n < 2; ++n) acc[a][b][m][n] = (f32x4){0.f, 0.f, 0.f, 0.f};
    bf16x8 At[4][2], B0[2][2], B1[2][2];
    const char* cB = p.bbase(cur);
    PG8_STAGE(PG8_SB(0, 0), cB, voffB[0][0], voffB[0][1]); PG8_STAGE(PG8_SA(0, 0), Ab, aoc[0][0], aoc[0][1]);
    PG8_STAGE(PG8_SB(0, 1), cB, voffB[1][0], voffB[1][1]); PG8_STAGE(PG8_SA(0, 1), Ab, aoc[1][0], aoc[1][1]);
    if (wr == 1) PG8_BAR;
    PG8_WAIT_V(4); PG8_BAR;
    PG8_STAGE(PG8_SB(1, 0), cB + kstep, voffB[0][0], voffB[0][1]); PG8_STAGE(PG8_SA(1, 0), Ab + kstep, aoc[0][0], aoc[0][1]);
    PG8_STAGE(PG8_SB(1, 1), cB + kstep, voffB[1][0], voffB[1][1]);
    PG8_WAIT_V(6); PG8_BAR;
    for (;;) {
        const bool has_next = (c0 + (ui + 1) * G) < NU;
        if (has_next) { p.unit(c0 + (ui + 1) * G, nxt); p.a_off(nxt, R, C, aon); }
        else { nxt = cur;
#pragma unroll
            for (int h = 0; h < 2; ++h)
#pragma unroll
                for (int i = 0; i < 2; ++i) aon[h][i] = aoc[h][i]; }
        const char* nB = has_next ? p.bbase(nxt) : cB;
        for (int t = 0; t < nt; t += 2) {
            const bool last = (t == nt - 2);
            const char* a1 = Ab + (size_t)(t + 1) * kstep;
            const char* a2 = last ? Ab : Ab + (size_t)(t + 2) * kstep; const char* b2 = last ? nB : cB + (size_t)(t + 2) * kstep;
            const char* a3 = a2 + kstep; const char* b3 = b2 + kstep;
            unsigned ao2[2][2];
#pragma unroll
            for (int h = 0; h < 2; ++h)
#pragma unroll
                for (int i = 0; i < 2; ++i) ao2[h][i] = last ? aon[h][i] : aoc[h][i];
            PG8_LDB(B0, 0, 0); PG8_SCHED; PG8_LDA(At, 0, 0); PG8_STAGE(PG8_SA(1, 1), a1, aoc[1][0], aoc[1][1]);
            PG8_WAIT_L(8); PG8_BAR; PG8_WAIT_L(0); PG8_MMA(0, 0, At, B0); PG8_BAR; PG8_SCHED;
            PG8_LDB(B1, 0, 1); PG8_STAGE(PG8_SB(0, 0), b2, voffB[0][0], voffB[0][1]);
            PG8_BAR; PG8_WAIT_L(0); PG8_MMA(0, 1, At, B1); PG8_BAR;
            PG8_LDA(At, 0, 1); PG8_STAGE(PG8_SA(0, 0), a2, ao2[0][0], ao2[0][1]);
            PG8_BAR; PG8_WAIT_L(0); PG8_MMA(1, 0, At, B0); PG8_BAR; PG8_SCHED;
            PG8_STAGE(PG8_SB(0, 1), b2, voffB[1][0], voffB[1][1]);
            PG8_WAIT_V(6); PG8_BAR; PG8_MMA(1, 1, At, B1); PG8_BAR;
            PG8_LDB(B0, 1, 0); PG8_SCHED; PG8_LDA(At, 1, 0); PG8_STAGE(PG8_SA(0, 1), a2, ao2[1][0], ao2[1][1]);
            PG8_WAIT_L(8); PG8_BAR; PG8_WAIT_L(0); PG8_MMA(0, 0, At, B0); PG8_BAR; PG8_SCHED;
            PG8_LDB(B1, 1, 1); PG8_STAGE(PG8_SB(1, 0), b3, voffB[0][0], voffB[0][1]);
            PG8_BAR; PG8_WAIT_L(0); PG8_MMA(0, 1, At, B1); PG8_BAR;
            PG8_LDA(At, 1, 1); PG8_STAGE(PG8_SA(1, 0), a3, ao2[0][0], ao2[0][1]);
            PG8_BAR; PG8_WAIT_L(0); PG8_MMA(1, 0, At, B0); PG8_BAR; PG8_SCHED;
            PG8_STAGE(PG8_SB(1, 1), b3, voffB[1][0], voffB[1][1]);
            PG8_WAIT_V(6); PG8_BAR; PG8_MMA(1, 1, At, B1); PG8_BAR;
        }
        p.epi(acc, cur, wr, wc, fr, fq);
        if (!has_next) break;
#pragma unroll
        for (int a = 0; a < 2; ++a)
#pragma unroll
            for (int b = 0; b < 2; ++b)
#pragma unroll
                for (int m = 0; m < 4; ++m)
#pragma unroll
                    for (int n = 0; n < 2; ++n) acc[a][b][m][n] = (f32x4){0.f, 0.f, 0.f, 0.f};
        cur = nxt; cB = nB; ++ui;
#pragma unroll
        for (int h = 0; h < 2; ++h)
#pragma unroll
            for (int i = 0; i < 2; ++i) aoc[h][i] = aon[h][i];
    }
    PG8_WAIT_V(0);
    if (wr == 0) PG8_BAR;
    PG8_BAR;
#undef PG8_SA
#undef PG8_SB
#undef PG8_STAGE
#undef PG8_LDA
#undef PG8_LDB
#undef PG8_MMA
#undef PG8_WAIT_V
#undef PG8_WAIT_L
#undef PG8_BAR
#undef PG8_SCHED
}
}

__device__ __forceinline__ void adaln_sc(const Frame& F) {
    const float* c = F.in[1]; LAS float* sc = (LAS float*)F.lds;
    __syncthreads();
    for (int i = F.tid; i < 2048; i += NTHREADS) { const float cv = c[i]; sc[i] = cv / (1.0f + expf(-cv)); }
    __syncthreads();
}
__device__ __forceinline__ void adaln_unit(const Frame& F, int u) {
    const float* w_ada = F.in[3]; const float* b_ada = F.in[4];
    float* mod = WSP(float, WS_ZERO + ZB_MOD);
    const LAS float* sc = (const LAS float*)F.lds;
    LAS f32x4* part = (LAS f32x4*)(F.lds + 8192);
    const int cg = F.tid % 24, kg = F.tid / 24;
    const int l = u >> 7, col0 = (u & 127) * 96;
    if (F.tid < 504) {
        f32x4 acc = (f32x4){0.f, 0.f, 0.f, 0.f};
        const float* wp = w_ada + (size_t)l * 2048 * 12288 + col0 + cg * 4;
#pragma unroll 7
        for (int k = kg; k < 2048; k += 21) { const f32x4 w = *(const f32x4*)(wp + (size_t)k * 12288); acc += w * sc[k]; }
        part[kg * 24 + cg] = acc;
    }
    __syncthreads();
    if (F.tid < 96) { float s_ = 0.f; const LAS float* pf = (const LAS float*)part;
        for (int g = 0; g < 21; ++g) s_ += pf[g * 96 + F.tid];
        mod[(size_t)l * 12288 + col0 + F.tid] = s_ + b_ada[(size_t)l * 12288 + col0 + F.tid]; }
    __syncthreads();
}
__device__ __forceinline__ void ph_adaln(const Frame& F) {
    if (F.bid >= 128 && F.G >= 256) return;
    adaln_sc(F);
    for (int u = F.bid; u < 128; u += F.G) adaln_unit(F, u);
}

__device__ __forceinline__ void ph_rope_table(const Frame& F) {
    const int* pos = (const int*)F.in[2];
    float2* tab = WSP(float2, WS_ROPE);
    for (int idx = F.bid * NTHREADS + F.tid; idx < T * 32; idx += F.G * NTHREADS) {
        const int t = idx >> 5, i = idx & 31;
        const float inv_freq = (float)exp2(-(double)i * (13.287712379549449 / 32.0));
        const float ang = (float)pos[t] * inv_freq;
        const double rev = (double)ang * 0.15915494309189535;
        const float fr = (float)(rev - rint(rev));
        tab[idx] = make_float2(__builtin_amdgcn_cosf(fr), __builtin_amdgcn_sinf(fr));
    }
}

struct CvtJob { const float* src; bf16_t* dst; int K, Nsrc, Ndst, batch, mode, tiles_per_mat, tile0; size_t sbs, dbs; };
__device__ __forceinline__ void cvt_load(const Frame& F, const CvtJob& j, int lt, f32x4 (&v)[2][2]) {
    const int b = lt / j.tiles_per_mat, r = lt - b * j.tiles_per_mat;
    const int nkt = j.K / 128, ntile = r / nkt, kt = r - ntile * nkt;
    const float* src = j.src + (size_t)b * j.sbs;
    const int n4 = F.tid & 15, kp = F.tid >> 4;
    const int nd = ntile * 64 + n4 * 4;
    int scol; bool valid;
    if (j.mode == 1) { scol = ((nd >> 7) & 1) * 256 + (nd >> 8) * 128 + (nd & 127); valid = true; }
    else { scol = nd; valid = nd < j.Nsrc; }
#pragma unroll
    for (int jj = 0; jj < 2; ++jj)
#pragma unroll
        for (int e = 0; e < 2; ++e) { const int k = kt * 128 + jj * 64 + kp * 2 + e;
            v[jj][e] = valid ? __builtin_nontemporal_load((const f32x4*)(src + (size_t)k * j.Nsrc + scol)) : (f32x4){0.f, 0.f, 0.f, 0.f}; }
}
__device__ __forceinline__ void cvt_store(const Frame& F, const CvtJob& j, int lt, const f32x4 (&v)[2][2]) {
    const int b = lt / j.tiles_per_mat, r = lt - b * j.tiles_per_mat;
    const int nkt = j.K / 128, ntile = r / nkt, kt = r - ntile * nkt;
    bf16_t* dst = j.dst + (size_t)b * j.dbs;
    LAS unsigned* L = (LAS unsigned*)F.lds;
    const int n4 = F.tid & 15, kp = F.tid >> 4;
#pragma unroll
    for (int jj = 0; jj < 2; ++jj)
#pragma unroll
        for (int i = 0; i < 4; ++i) L[(n4 * 4 + i) * 65 + jj * 32 + kp] = cvt_pk_bf16(v[jj][0][i], v[jj][1][i]);
    __syncthreads();
    const int n = F.tid >> 3, ch = F.tid & 7;
    u32x4 o0, o1;
    o0.x = L[n * 65 + ch * 8 + 0]; o0.y = L[n * 65 + ch * 8 + 1]; o0.z = L[n * 65 + ch * 8 + 2]; o0.w = L[n * 65 + ch * 8 + 3];
    o1.x = L[n * 65 + ch * 8 + 4]; o1.y = L[n * 65 + ch * 8 + 5]; o1.z = L[n * 65 + ch * 8 + 6]; o1.w = L[n * 65 + ch * 8 + 7];
    bf16_t* dp = dst + (size_t)(ntile * 64 + n) * j.K + kt * 128 + ch * 16;
    *(u32x4*)dp = o0; *(u32x4*)(dp + 8) = o1;
    __syncthreads();
}
constexpr int NJOBS = 14;
__device__ __forceinline__ CvtJob make_job(const float* src, bf16_t* dst, int K, int Nsrc, int Ndst, int batch, int mode, size_t sbs, size_t dbs) {
    CvtJob j; j.src = src; j.dst = dst; j.K = K; j.Nsrc = Nsrc; j.Ndst = Ndst; j.batch = batch; j.mode = mode; j.sbs = sbs; j.dbs = dbs;
    j.tiles_per_mat = (K / 128) * (Ndst / 64); j.tile0 = 0; return j;
}
__device__ __forceinline__ void ph_convert(const Frame& F) {
    const bool split = F.G >= 256; const int VG = split ? F.G - 128 : F.G, vb_ = split ? F.bid - 128 : F.bid;
    int run = 0;
    if (vb_ >= 0) {
#define DO_JOB(J) do { const CvtJob jb = (J); const int nt_ = jb.tiles_per_mat * jb.batch; \
        int lt = (vb_ - (run % VG) + VG) % VG; f32x4 va[2][2], vb[2][2]; \
        if (lt < nt_) cvt_load(F, jb, lt, va); \
        for (; lt < nt_; lt += VG) { const int ltn = lt + VG; if (ltn < nt_) cvt_load(F, jb, ltn, vb); cvt_store(F, jb, lt, va); \
            _Pragma("unroll") for (int a_ = 0; a_ < 2; ++a_) _Pragma("unroll") for (int b_ = 0; b_ < 2; ++b_) va[a_][b_] = vb[a_][b_]; } \
        run += nt_; } while (0)
    DO_JOB(make_job(F.in[5], WSP(bf16_t, WS_WIN), 2048, IN_DIM, IN_PAD, 1, 0, 0, 0));
    DO_JOB(make_job(F.in[10], WSP(bf16_t, WS_WUQ), 768, 1536, 1536, 1, 0, 0, 0));
    DO_JOB(make_job(F.in[11], WSP(bf16_t, WS_WUKV), 512, 2048, 2048, 1, 0, 0, 0));
    DO_JOB(make_job(F.in[12], WSP(bf16_t, WS_WOUT), 2048, 2048, 2048, 1, 0, 0, 0));
#undef DO_JOB
    }
    bf16_t* wr = WSP(bf16_t, WS_WR);
    for (int idx = F.bid * NTHREADS + F.tid; idx < 2 * 256 * 2048; idx += F.G * NTHREADS) {
        const int l = idx >> 19, n = (idx >> 11) & 255, k = idx & 2047;
        bf16_t o = 0;
        if (n < 128) { const int e = n & 63;
            const float w = F.in[17][((size_t)l * 2048 + k) * 64 + e];
            const bf16_t hi = f2bf(w);
            o = (n < 64) ? hi : f2bf(w - bf2f(hi)); }
        wr[idx] = o;
    }
}

constexpr int MCV_CHUNK = 32;
constexpr int MCV_LAYER_TILES = 8192 + 128 + 4096 + 64;
constexpr int MCV_NMOE = 2 * MCV_LAYER_TILES / MCV_CHUNK;
constexpr int MCV_NCVT = MCV_NMOE + 20 + 16;
constexpr int MCV_NCHUNK = MCV_NCVT + 128;
__device__ __forceinline__ int grab(const Frame& F, unsigned* ctr) {
    LAS int* sl = (LAS int*)(F.aux + 16000);
    __syncthreads();
    if (F.tid == 0) *sl = (int)__hip_atomic_fetch_add(ctr, 1u, __ATOMIC_RELAXED, __HIP_MEMORY_SCOPE_AGENT);
    __syncthreads();
    return __builtin_amdgcn_readfirstlane(*sl);
}
__device__ __forceinline__ void moe_cvt_chunk(const Frame& F, int c) {
    if (c >= MCV_NCVT) { adaln_sc(F); adaln_unit(F, 128 + (c - MCV_NCVT)); return; }
    const int gt = c * MCV_CHUNK, l = gt / MCV_LAYER_TILES, r = gt - l * MCV_LAYER_TILES;
    CvtJob jb; int lt0;
    if (c >= MCV_NMOE + 20) { lt0 = (c - MCV_NMOE - 20) * MCV_CHUNK; jb = make_job(F.in[16], WSP(bf16_t, WS_WO), 2048, 2048, 2048, 1, 0, 0, 0); }
    else if (c >= MCV_NMOE) { lt0 = (c - MCV_NMOE) * MCV_CHUNK; jb = make_job(F.in[13], WSP(bf16_t, WS_WQKV), 2048, 2560, 2560, 1, 0, 0, 0); }
    else if (r < 8192) { lt0 = r; jb = make_job(F.in[19] + (size_t)l * 64 * 2048 * 512, WSP(bf16_t, WS_WGU) + (size_t)l * 65 * 512 * 2048, 2048, 512, 512, 64, 1, (size_t)2048 * 512, (size_t)512 * 2048); }
    else if (r < 8320) { lt0 = r - 8192; jb = make_job(F.in[21] + (size_t)l * 2048 * 512, WSP(bf16_t, WS_WGU) + ((size_t)l * 65 + 64) * 512 * 2048, 2048, 512, 512, 1, 1, 0, 0); }
    else if (r < 12416) { lt0 = r - 8320; jb = make_job(F.in[20] + (size_t)l * 64 * 256 * 2048, WSP(bf16_t, WS_WDN) + (size_t)l * 65 * 2048 * 256, 256, 2048, 2048, 64, 0, (size_t)256 * 2048, (size_t)2048 * 256); }
    else { lt0 = r - 12416; jb = make_job(F.in[22] + (size_t)l * 256 * 2048, WSP(bf16_t, WS_WDN) + ((size_t)l * 65 + 64) * 2048 * 256, 256, 2048, 2048, 1, 0, 0, 0); }
    f32x4 v0[2][2], v1[2][2], v2[2][2], v3[2][2];
    cvt_load(F, jb, lt0, v0); cvt_load(F, jb, lt0 + 1, v1); cvt_load(F, jb, lt0 + 2, v2);
#pragma unroll 1
    for (int i = 0; i < MCV_CHUNK; i += 4) {
        cvt_load(F, jb, lt0 + i + 3, v3); cvt_store(F, jb, lt0 + i, v0);
        if (i + 4 < MCV_CHUNK) cvt_load(F, jb, lt0 + i + 4, v0);
        cvt_store(F, jb, lt0 + i + 1, v1);
        if (i + 4 < MCV_CHUNK) cvt_load(F, jb, lt0 + i + 5, v1);
        cvt_store(F, jb, lt0 + i + 2, v2);
        if (i + 4 < MCV_CHUNK) cvt_load(F, jb, lt0 + i + 6, v2);
        cvt_store(F, jb, lt0 + i + 3, v3);
    }
}
__device__ __forceinline__ void moe_cvt_queue(const Frame& F) {
    unsigned* ctr = WSP(unsigned, WS_ZERO + ZB_CTR);
    for (;;) { const int c = grab(F, ctr); if (c >= MCV_NCHUNK) break; moe_cvt_chunk(F, c); }
}

template <int MODE>
__device__ __forceinline__ void ph_modulate(const Frame& F, const void* x, const float* shift, const float* scale, bf16_t* out) {
    f32x4 sc[8], sh[8];
#pragma unroll
    for (int j = 0; j < 8; ++j) { const int col = 4 * F.lane + 256 * j; sc[j] = *(const f32x4*)(scale + col) + 1.0f; sh[j] = *(const f32x4*)(shift + col); }
    for (int row = F.bid * 8 + F.wid; row < T; row += F.G * 8) {
        f32x4 v[8]; float ss = 0.f;
        if (MODE == 1) { u32x2 xw[8];
#pragma unroll
            for (int j = 0; j < 8; ++j) xw[j] = *(const u32x2*)((const bf16_t*)x + (size_t)row * D + 4 * F.lane + 256 * j);
#pragma unroll
            for (int j = 0; j < 8; ++j) v[j] = (f32x4){bflo(xw[j].x), bfhi(xw[j].x), bflo(xw[j].y), bfhi(xw[j].y)};
        }
#pragma unroll
        for (int j = 0; j < 8; ++j) { if (MODE == 0) v[j] = __builtin_nontemporal_load((const f32x4*)((const float*)x + (size_t)row * D + 4 * F.lane + 256 * j)); ss += v[j][0] * v[j][0] + v[j][1] * v[j][1] + v[j][2] * v[j][2] + v[j][3] * v[j][3]; }
        ss = wave_sum(ss);
        const float rstd = rsqrtf(ss * (1.0f / D) + EPS);
#pragma unroll
        for (int j = 0; j < 8; ++j) {
            const f32x4 h = (v[j] * rstd) * sc[j] + sh[j];
            const int col = 4 * F.lane + 256 * j;
            u32x2 hi; hi.x = cvt_pk_bf16(h[0], h[1]); hi.y = cvt_pk_bf16(h[2], h[3]);
            if (MODE == 0) { *(u32x2*)(out + (size_t)row * 2048 + col) = hi; }
            else {
                *(u32x2*)(out + (size_t)row * 2048 + col) = hi;
            }
        }
    }
}

typedef float f32x2_ __attribute__((ext_vector_type(2)));
template <int FINAL>
__device__ __forceinline__ void ph_combine(const Frame& F, const bf16_t* xold, const float* g, bf16_t* xnew, const float* shift, const float* scale, bf16_t* hout, float* fout) {
    const unsigned char* Y = WSP(unsigned char, WS_Y); const int* pslot = WSP(int, WS_PSLOT); const float* tkw = WSP(float, WS_TKW);
    for (int row = F.bid * 8 + F.wid; row < T; row += F.G * 8) {
        int sl[9]; float w[9];
#pragma unroll
        for (int k = 0; k < 8; ++k) { sl[k] = pslot[row * 8 + k]; w[k] = tkw[row * 8 + k] * (1.0f / 8.0f); }
        sl[8] = row; w[8] = 1.0f / 8.0f;
        float xn[2][16]; float ss = 0.f;
#pragma unroll
        for (int j = 0; j < 2; ++j) {
            const int col = 16 * F.lane + 1024 * j;
            float a[16];
#pragma unroll
            for (int e = 0; e < 16; ++e) a[e] = 0.f;
#pragma unroll
            for (int k = 0; k < 9; ++k) { const u32x4 y = __builtin_nontemporal_load((const u32x4*)(Y + (size_t)sl[k] * 2048 + col));
#pragma unroll
                for (int q = 0; q < 4; ++q) { const f32x2_ lo = __builtin_amdgcn_cvt_pk_f32_fp8((int)y[q], false), hi = __builtin_amdgcn_cvt_pk_f32_fp8((int)y[q], true);
                    a[4 * q + 0] += w[k] * lo[0]; a[4 * q + 1] += w[k] * lo[1]; a[4 * q + 2] += w[k] * hi[0]; a[4 * q + 3] += w[k] * hi[1]; } }
            const u32x4 xw0 = *(const u32x4*)(xold + (size_t)row * D + col), xw1 = *(const u32x4*)(xold + (size_t)row * D + col + 8);
            const unsigned xw[8] = {xw0.x, xw0.y, xw0.z, xw0.w, xw1.x, xw1.y, xw1.z, xw1.w};
#pragma unroll
            for (int q = 0; q < 4; ++q) { const f32x4 x0 = (f32x4){bflo(xw[2 * q]), bfhi(xw[2 * q]), bflo(xw[2 * q + 1]), bfhi(xw[2 * q + 1])}; const f32x4 g0 = *(const f32x4*)(g + col + 4 * q);
#pragma unroll
                for (int e = 0; e < 4; ++e) { const float v = x0[e] + g0[e] * a[4 * q + e]; xn[j][4 * q + e] = v; ss += v * v; } }
            if (!FINAL) { u32x4 o0, o1; o0.x = cvt_pk_bf16(xn[j][0], xn[j][1]); o0.y = cvt_pk_bf16(xn[j][2], xn[j][3]); o0.z = cvt_pk_bf16(xn[j][4], xn[j][5]); o0.w = cvt_pk_bf16(xn[j][6], xn[j][7]);
                o1.x = cvt_pk_bf16(xn[j][8], xn[j][9]); o1.y = cvt_pk_bf16(xn[j][10], xn[j][11]); o1.z = cvt_pk_bf16(xn[j][12], xn[j][13]); o1.w = cvt_pk_bf16(xn[j][14], xn[j][15]);
                *(u32x4*)(xnew + (size_t)row * D + col) = o0; *(u32x4*)(xnew + (size_t)row * D + col + 8) = o1; }
        }
        ss = wave_sum(ss);
        const float rstd = rsqrtf(ss * (1.0f / D) + EPS);
#pragma unroll
        for (int j = 0; j < 2; ++j) {
            const int col = 16 * F.lane + 1024 * j;
            float h[16];
#pragma unroll
            for (int q = 0; q < 4; ++q) { const f32x4 s0 = *(const f32x4*)(scale + col + 4 * q);
                if (FINAL) { f32x4 o0;
#pragma unroll
                    for (int e = 0; e < 4; ++e) o0[e] = xn[j][4 * q + e] * rstd * s0[e];
                    *(f32x4*)(fout + (size_t)row * D + col + 4 * q) = o0; }
                else { const f32x4 h0 = *(const f32x4*)(shift + col + 4 * q);
#pragma unroll
                    for (int e = 0; e < 4; ++e) h[4 * q + e] = xn[j][4 * q + e] * rstd * (1.0f + s0[e]) + h0[e]; } }
            if (!FINAL) { u32x4 o0, o1; o0.x = cvt_pk_bf16(h[0], h[1]); o0.y = cvt_pk_bf16(h[2], h[3]); o0.z = cvt_pk_bf16(h[4], h[5]); o0.w = cvt_pk_bf16(h[6], h[7]);
                o1.x = cvt_pk_bf16(h[8], h[9]); o1.y = cvt_pk_bf16(h[10], h[11]); o1.z = cvt_pk_bf16(h[12], h[13]); o1.w = cvt_pk_bf16(h[14], h[15]);
                *(u32x4*)(hout + (size_t)row * 2048 + col) = o0; *(u32x4*)(hout + (size_t)row * 2048 + col + 8) = o1; }
        }
    }
}

using pg8::Unit;
template <bool NT>
__device__ __forceinline__ void store_bf16_tile(const f32x4 (&acc)[2][2][4][2], bf16_t* O, int ldc, int row0, int col0, const float* bias, int bcol0, int wr, int wc, int fr, int fq) {
    const int r0 = row0 + wr * 64 + fr, c0 = col0 + wc * 32 + 8 * fq, bc0 = bcol0 + wc * 32 + 8 * fq;
    f32x4 bv[2][2];
#pragma unroll
    for (int bj = 0; bj < 2; ++bj)
#pragma unroll
        for (int n = 0; n < 2; ++n) bv[bj][n] = bias ? *(const f32x4*)(bias + bc0 + bj * 128 + 4 * n) : (f32x4){0.f, 0.f, 0.f, 0.f};
#pragma unroll
    for (int ai = 0; ai < 2; ++ai)
#pragma unroll
        for (int m = 0; m < 4; ++m) { bf16_t* rowp = O + (size_t)(r0 + ai * 128 + m * 16) * ldc + c0;
#pragma unroll
            for (int bj = 0; bj < 2; ++bj) { const f32x4 v0 = acc[ai][bj][m][0] + bv[bj][0], v1 = acc[ai][bj][m][1] + bv[bj][1];
                u32x4 w; w.x = cvt_pk_bf16(v0[0], v0[1]); w.y = cvt_pk_bf16(v0[2], v0[3]); w.z = cvt_pk_bf16(v1[0], v1[1]); w.w = cvt_pk_bf16(v1[2], v1[3]);
                if (NT) __builtin_nontemporal_store(w, (u32x4*)(rowp + bj * 128)); else *(u32x4*)(rowp + bj * 128) = w; } }
}

struct PolDenseBase {
    const bf16_t* A; const bf16_t* Bt; int lda, ldb, K, nM, nN;
    __device__ __forceinline__ int nunits() const { return nM * nN; }
    __device__ __forceinline__ int first() const { return blockIdx.x; }
    __device__ __forceinline__ int stride() const { return gridDim.x; }
    __device__ __forceinline__ void unit(int L, Unit& u) const {
#if DENSE_XCD
        const int nwg = nM * nN; int wgid = L;
        if ((gridDim.x & 7) == 0) { const int q = nwg / 8, r = nwg % 8, xcd = wgid % 8, off = wgid / 8; wgid = (xcd < r ? xcd * (q + 1) : r * (q + 1) + (xcd - r) * q) + off; }
        const int nig = 8 * nN, gid = wgid / nig, fm = gid * 8, gsz = (nM - fm) < 8 ? (nM - fm) : 8;
        u.a = fm + ((wgid % nig) % gsz); u.b = (wgid % nig) / gsz; u.c = 0; u.d = 0;
#else
        u.a = L / nN; u.b = L - u.a * nN; u.c = 0; u.d = 0;
#endif
    }
    __device__ __forceinline__ const char* abase() const { return (const char*)A; }
    __device__ __forceinline__ void a_off(const Unit& u, const int (&R)[2], const int (&C)[2], unsigned (&off)[2][2]) const {
#pragma unroll
        for (int h = 0; h < 2; ++h)
#pragma unroll
            for (int i = 0; i < 2; ++i) off[h][i] = (unsigned)((u.a * 256 + h * 128 + R[i]) * lda + C[i]) * 2u;
    }
    __device__ __forceinline__ const char* bbase(const Unit& u) const { return (const char*)(Bt + (size_t)u.b * 256 * ldb); }
};
struct PolBf16 : PolDenseBase {
    static constexpr bool PERM = true;
    bf16_t* O; int ldc; const float* bias;
    __device__ __forceinline__ void epi(const f32x4 (&acc)[2][2][4][2], const Unit& u, int wr, int wc, int fr, int fq) const {
        store_bf16_tile<false>(acc, O, ldc, u.a * 256, u.b * 256, bias, u.b * 256, wr, wc, fr, fq);
    }
};
template <bool XIN_BF16>
struct PolResid : PolDenseBase {
    static constexpr bool PERM = true;
    const void* xin; const float* g; bf16_t* xout;
    __device__ __forceinline__ void epi(const f32x4 (&acc)[2][2][4][2], const Unit& u, int wr, int wc, int fr, int fq) const {
        const int row0 = u.a * 256 + wr * 64 + fr, col0 = u.b * 256 + wc * 32 + 8 * fq;
        f32x4 gv[2][2];
#pragma unroll
        for (int bj = 0; bj < 2; ++bj)
#pragma unroll
            for (int n = 0; n < 2; ++n) gv[bj][n] = *(const f32x4*)(g + col0 + bj * 128 + n * 4);
#pragma unroll
        for (int ai = 0; ai < 2; ++ai)
#pragma unroll
            for (int mp = 0; mp < 2; ++mp) {
                f32x4 xi[2][2][2];
                if (XIN_BF16) {
                    u32x4 xw[2][2];
#pragma unroll
                    for (int mm = 0; mm < 2; ++mm) { const size_t ro = (size_t)(row0 + ai * 128 + (mp * 2 + mm) * 16) * D + col0;
#pragma unroll
                        for (int bj = 0; bj < 2; ++bj) xw[mm][bj] = *(const u32x4*)((const bf16_t*)xin + ro + bj * 128); }
                    __builtin_amdgcn_sched_barrier(0);
#pragma unroll
                    for (int mm = 0; mm < 2; ++mm)
#pragma unroll
                        for (int bj = 0; bj < 2; ++bj) { xi[mm][bj][0] = (f32x4){bflo(xw[mm][bj].x), bfhi(xw[mm][bj].x), bflo(xw[mm][bj].y), bfhi(xw[mm][bj].y)};
                            xi[mm][bj][1] = (f32x4){bflo(xw[mm][bj].z), bfhi(xw[mm][bj].z), bflo(xw[mm][bj].w), bfhi(xw[mm][bj].w)}; }
                } else {
#pragma unroll
                    for (int mm = 0; mm < 2; ++mm) { const size_t ro = (size_t)(row0 + ai * 128 + (mp * 2 + mm) * 16) * D + col0;
#pragma unroll
                        for (int bj = 0; bj < 2; ++bj)
#pragma unroll
                            for (int n = 0; n < 2; ++n) xi[mm][bj][n] = *(const f32x4*)((const float*)xin + ro + bj * 128 + n * 4); }
                    __builtin_amdgcn_sched_barrier(0);
                }
#pragma unroll
                for (int mm = 0; mm < 2; ++mm) { const size_t ro = (size_t)(row0 + ai * 128 + (mp * 2 + mm) * 16) * D + col0;
#pragma unroll
                    for (int bj = 0; bj < 2; ++bj) { const f32x4 v0 = xi[mm][bj][0] + gv[bj][0] * acc[ai][bj][mp * 2 + mm][0], v1 = xi[mm][bj][1] + gv[bj][1] * acc[ai][bj][mp * 2 + mm][1];
                        u32x4 w; w.x = cvt_pk_bf16(v0[0], v0[1]); w.y = cvt_pk_bf16(v0[2], v0[3]); w.z = cvt_pk_bf16(v1[0], v1[1]); w.w = cvt_pk_bf16(v1[2], v1[3]);
                        *(u32x4*)(xout + ro + bj * 128) = w; } }
                __builtin_amdgcn_sched_barrier(0);
            }
    }
};
struct PolRouter {
    static constexpr bool PERM = false;
    const bf16_t* A; const bf16_t* Bt; float* part; int K, ldb;
    __device__ __forceinline__ int nunits() const { return 64 * 4; }
    __device__ __forceinline__ int first() const { return blockIdx.x; }
    __device__ __forceinline__ int stride() const { return gridDim.x; }
    __device__ __forceinline__ void unit(int L, Unit& u) const { u.a = L >> 2; u.b = L & 3; u.c = 0; u.d = 0; }
    __device__ __forceinline__ const char* abase() const { return (const char*)A; }
    __device__ __forceinline__ void a_off(const Unit& u, const int (&R)[2], const int (&C)[2], unsigned (&off)[2][2]) const {
#pragma unroll
        for (int h = 0; h < 2; ++h)
#pragma unroll
            for (int i = 0; i < 2; ++i) off[h][i] = (unsigned)((u.a * 256 + h * 128 + R[i]) * 2048 + u.b * 512 + C[i]) * 2u;
    }
    __device__ __forceinline__ const char* bbase(const Unit& u) const { return (const char*)(Bt + (size_t)u.b * 512); }
    __device__ __forceinline__ void epi(const f32x4 (&acc)[2][2][4][2], const Unit& u, int wr, int wc, int fr, int fq) const {
        const int row0 = u.a * 256 + wr * 64 + fr, col0 = wc * 32 + 4 * fq;
        float* P = part + (size_t)u.b * T * 128;
#pragma unroll
        for (int ai = 0; ai < 2; ++ai)
#pragma unroll
            for (int m = 0; m < 4; ++m)
#pragma unroll
                for (int n = 0; n < 2; ++n) *(f32x4*)(P + (size_t)(row0 + ai * 128 + m * 16) * 128 + col0 + n * 16) = acc[ai][0][m][n];
    }
};
struct MoeTab { const LAS int* blk_e; const LAS int* blk_row0; int rb0, nrb, rank, nrank; };
__device__ __forceinline__ void moe_decode(const MoeTab& tb, int j, int NT, Unit& u) {
    const int rbl = j / NT, pn = j - rbl * NT, rb = tb.rb0 + rbl;
    u.a = tb.blk_row0[rb]; u.b = pn; u.c = tb.blk_e[rb]; u.d = 0;
}
struct PolGateUp {
    static constexpr bool PERM = true;
    const bf16_t* A; const bf16_t* W; const int* rowtok; bf16_t* act; MoeTab tb; int K, ldb; const LAS int* ridx;
    __device__ __forceinline__ int nunits() const { return tb.nrb * 2; }
    __device__ __forceinline__ int first() const { return tb.rank; }
    __device__ __forceinline__ int stride() const { return tb.nrank; }
    __device__ __forceinline__ void unit(int L, Unit& u) const { moe_decode(tb, L, 2, u); u.d = (L - tb.rank) / tb.nrank; }
    __device__ __forceinline__ const char* abase() const { return (const char*)A; }
    __device__ __forceinline__ void a_off(const Unit& u, const int (&R)[2], const int (&C)[2], unsigned (&off)[2][2]) const {
#pragma unroll
        for (int h = 0; h < 2; ++h)
#pragma unroll
            for (int i = 0; i < 2; ++i) { const int tok = (u.d < 8) ? ridx[u.d * 256 + h * 128 + R[i]] : rowtok[u.a + h * 128 + R[i]]; off[h][i] = (unsigned)(tok * 2048 + C[i]) * 2u; }
    }
    __device__ __forceinline__ const char* bbase(const Unit& u) const { return (const char*)(W + ((size_t)u.c * 512 + (size_t)u.b * 256) * 2048); }
    __device__ __forceinline__ void epi(const f32x4 (&acc)[2][2][4][2], const Unit& u, int wr, int wc, int fr, int fq) const {
        const int r0 = u.a + wr * 64 + fr, c0 = u.b * 128 + wc * 32 + 8 * fq;
#pragma unroll
        for (int ai = 0; ai < 2; ++ai)
#pragma unroll
            for (int m = 0; m < 4; ++m) {
                float o[8];
#pragma unroll
                for (int n = 0; n < 2; ++n)
#pragma unroll
                    for (int e = 0; e < 4; ++e) { const float gt = acc[ai][0][m][n][e], up = acc[ai][1][m][n][e]; o[n * 4 + e] = gt / (1.0f + __expf(-gt)) * up; }
                u32x4 w; w.x = cvt_pk_bf16(o[0], o[1]); w.y = cvt_pk_bf16(o[2], o[3]); w.z = cvt_pk_bf16(o[4], o[5]); w.w = cvt_pk_bf16(o[6], o[7]);
                *(u32x4*)(act + (size_t)(r0 + ai * 128 + m * 16) * 256 + c0) = w; }
    }
};
constexpr float Y_SCALE = 8.0f;
struct PolDown {
    static constexpr bool PERM = true;
    const bf16_t* A; const bf16_t* W; unsigned char* Y; MoeTab tb; int K, ldb; int nostore;
    __device__ __forceinline__ int nunits() const { return tb.nrb * 8; }
    __device__ __forceinline__ int first() const { return tb.rank; }
    __device__ __forceinline__ int stride() const { return tb.nrank; }
    __device__ __forceinline__ void unit(int L, Unit& u) const { moe_decode(tb, L, 8, u); }
    __device__ __forceinline__ const char* abase() const { return (const char*)A; }
    __device__ __forceinline__ void a_off(const Unit& u, const int (&R)[2], const int (&C)[2], unsigned (&off)[2][2]) const {
#pragma unroll
        for (int h = 0; h < 2; ++h)
#pragma unroll
            for (int i = 0; i < 2; ++i) off[h][i] = (unsigned)((u.a + h * 128 + R[i]) * 256 + C[i]) * 2u;
    }
    __device__ __forceinline__ const char* bbase(const Unit& u) const { return (const char*)(W + ((size_t)u.c * 2048 + (size_t)u.b * 256) * 256); }
    __device__ __forceinline__ void epi(const f32x4 (&acc)[2][2][4][2], const Unit& u, int wr, int wc, int fr, int fq) const {
        const int odd = fq & 1, pq = fq >> 1;
#pragma unroll
        for (int ai = 0; ai < 2; ++ai)
#pragma unroll
            for (int bj = 0; bj < 2; ++bj) {
                int D[4][2];
#pragma unroll
                for (int m = 0; m < 4; ++m)
#pragma unroll
                    for (int n = 0; n < 2; ++n) { const f32x4 v = acc[ai][bj][m][n] * Y_SCALE; int w_ = __builtin_amdgcn_cvt_pk_fp8_f32(v[0], v[1], 0, false); D[m][n] = __builtin_amdgcn_cvt_pk_fp8_f32(v[2], v[3], w_, true); }
#pragma unroll
                for (int pr = 0; pr < 2; ++pr) {
                    const int s0 = odd ? D[2 * pr][0] : D[2 * pr + 1][0], s1 = odd ? D[2 * pr][1] : D[2 * pr + 1][1];
                    const int r0 = __shfl_xor(s0, 16), r1 = __shfl_xor(s1, 16);
                    u32x4 w;
                    if (odd) { w.x = (unsigned)r0; w.y = (unsigned)r1; w.z = (unsigned)D[2 * pr + 1][0]; w.w = (unsigned)D[2 * pr + 1][1]; }
                    else { w.x = (unsigned)D[2 * pr][0]; w.y = (unsigned)D[2 * pr][1]; w.z = (unsigned)r0; w.w = (unsigned)r1; }
                    const int row = u.a + ai * 128 + wr * 64 + (2 * pr + odd) * 16 + fr, col = u.b * 256 + bj * 128 + wc * 32 + pq * 16;
                    if (!nostore) { if (NT_STORES) __builtin_nontemporal_store(w, (u32x4*)(Y + (size_t)row * 2048 + col)); else *(u32x4*)(Y + (size_t)row * 2048 + col) = w; } else asm volatile("" :: "v"(w));
                }
            }
    }
};


__device__ __forceinline__ void ph_route(const Frame& F, int layer) {
    const float* part = WSP(float, WS_LOGP); const float* rbias = F.in[18] + layer * 64;
    int* tki = WSP(int, WS_TKI); float* tkw = WSP(float, WS_TKW); int* hist = WSP(int, WS_HIST);
    LAS int* lh = (LAS int*)F.aux;
    const int lane = F.lane; const int g = lane >> 3;
    const float bia = rbias[lane];
    for (int tb = F.bid; tb < 256; tb += F.G) {
        if (F.tid < 64) lh[F.tid] = 0;
        __syncthreads();
        for (int ti = 0; ti < 8; ++ti) {
            const int t = tb * 64 + F.wid * 8 + ti;
            float logit = 0.f;
#pragma unroll
            for (int ks = 0; ks < 4; ++ks) { const float* pr = part + ((size_t)ks * T + t) * 128; logit += pr[lane] + pr[64 + lane]; }
            const float score = 1.0f / (1.0f + expf(-logit));
            const float biased = score + bia;
            float m1 = biased;
            m1 = fmaxf(m1, __shfl_xor(m1, 1)); m1 = fmaxf(m1, __shfl_xor(m1, 2)); m1 = fmaxf(m1, __shfl_xor(m1, 4));
            const unsigned long long eqm = __ballot(biased == m1);
            const unsigned long long gm = eqm & (0xFFull << (8 * g));
            const int first = __builtin_ctzll(gm);
            float v2 = (lane == first) ? -__builtin_inff() : biased;
            v2 = fmaxf(v2, __shfl_xor(v2, 1)); v2 = fmaxf(v2, __shfl_xor(v2, 2)); v2 = fmaxf(v2, __shfl_xor(v2, 4));
            const float gs = m1 + v2;
            int cnt = 0;
#pragma unroll
            for (int gg = 0; gg < 8; ++gg) { const float o = __shfl(gs, 8 * gg); cnt += ((o > gs) || (o == gs && gg < g)) ? 1 : 0; }
            const bool sel = cnt < 4;
            const float masked = sel ? biased : -__builtin_inff();
            int rank = 0;
#pragma unroll
            for (int l = 0; l < 64; ++l) { const float o = __int_as_float(__builtin_amdgcn_readlane(__float_as_int(masked), l)); rank += ((o > masked) || (o == masked && l < lane)) ? 1 : 0; }
            const bool chosen = sel && rank < 8;
            const float wsum = wave_sum(chosen ? score : 0.f);
            if (chosen) { tki[t * 8 + rank] = lane; tkw[t * 8 + rank] = score / wsum * 2.5f; (void)__hip_atomic_fetch_add(lh + lane, 1, __ATOMIC_RELAXED, __HIP_MEMORY_SCOPE_WORKGROUP); }
        }
        __syncthreads();
        if (F.tid < 64) hist[tb * 64 + F.tid] = lh[F.tid];
        __syncthreads();
    }
}

__device__ __forceinline__ void ph_dispatch(const Frame& F) {
    const int* hist = WSP(int, WS_HIST); const int* tki = WSP(int, WS_TKI);
    int* pslot = WSP(int, WS_PSLOT); int* rowtok = WSP(int, WS_ROWTOK); int* etab = WSP(int, WS_ETAB);
    LAS int* tot = (LAS int*)F.aux; LAS int* pre = tot + 64; LAS int* eoff = tot + 128; LAS int* cursor = tot + 192;
    for (int tb = F.bid; tb < 256; tb += F.G) {
        if (F.tid < 64) { int s = 0, p = 0; for (int b = 0; b < 256; ++b) { const int h = hist[b * 64 + F.tid]; s += h; p += (b < tb) ? h : 0; } tot[F.tid] = s; pre[F.tid] = p; }
        __syncthreads();
        if (F.tid == 0) { int off = T; for (int e = 0; e < 64; ++e) { eoff[e] = off; cursor[e] = off + pre[e]; off += (tot[e] + 255) & ~255; } }
        __syncthreads();
        if (tb == 0 && F.tid < 64) { etab[F.tid] = eoff[F.tid]; etab[64 + F.tid] = tot[F.tid]; }
        { const int t = tb * 64 + (F.tid >> 3), k = F.tid & 7; const int e = tki[t * 8 + k];
          LAS int* pe = tot + 256;
          pe[F.tid] = e;
          __syncthreads();
          int rnk = 0;
          for (int q = 0; q < F.tid; ++q) rnk += (pe[q] == e) ? 1 : 0;
          const int slot = cursor[e] + rnk; rowtok[slot] = t; pslot[t * 8 + k] = slot; }
        if (F.tid < 64) rowtok[tb * 64 + F.tid] = tb * 64 + F.tid;
        if (tb < 64) { const int e = tb; const int beg = eoff[e] + tot[e], end = eoff[e] + ((tot[e] + 255) & ~255); for (int s = beg + F.tid; s < end; s += NTHREADS) rowtok[s] = 0; }
        __syncthreads();
    }
}

__device__ __forceinline__ MoeTab moe_tables(const Frame& F) {
    const int* etab = WSP(int, WS_ETAB);
    LAS int* blk_e = (LAS int*)F.aux; LAS int* blk_row0 = blk_e + 640; LAS int* pre = blk_e + 1280;
    __syncthreads();
    if (F.tid < 64) { blk_e[F.tid] = 64; blk_row0[F.tid] = F.tid * 256; }
    if (F.tid == 0) { int p = 0; for (int e = 0; e < 64; ++e) { pre[e] = p; p += (etab[64 + e] + 255) >> 8; } pre[64] = p; }
    __syncthreads();
    if (F.tid < 64) { const int e = F.tid, nb = (etab[64 + e] + 255) >> 8, b0 = 64 + pre[e], r0 = etab[e]; for (int i = 0; i < nb; ++i) { blk_e[b0 + i] = e; blk_row0[b0 + i] = r0 + i * 256; } }
    __syncthreads();
    const int nblk = 64 + pre[64];
    const int ng = ((F.G & 7) == 0) ? 8 : 1, x = F.bid % ng;
    MoeTab tb; tb.blk_e = blk_e; tb.blk_row0 = blk_row0;
    tb.rb0 = (int)(((long)nblk * x) / ng); tb.nrb = (int)(((long)nblk * (x + 1)) / ng) - tb.rb0; tb.rank = F.bid / ng; tb.nrank = F.G / ng;
    return tb;
}

#define SBAR() __builtin_amdgcn_sched_barrier(0)
__device__ __forceinline__ int v_st(int k, int c) { const int kk = (k & ~0xC) | ((k & 4) << 1) | ((k & 8) >> 1); return ((kk >> 3) * 4 + (c >> 5)) * 512 + ((kk & 7) * 32 + (c & 31)) * 2; }
__device__ __forceinline__ int v_rd_base(int lane) { return ((lane & 3) << 3) | (((lane >> 2) & 3) << 6) | (((lane >> 4) & 1) << 5) | (((lane >> 5) & 1) << 8); }
constexpr int v_rd_off(int d0, int ks, int half) { return d0 * 512 + ks * 4096 + half * 2048; }
__device__ __forceinline__ int crow(int r, int hi) { return (r & 3) + 8 * (r >> 2) + 4 * hi; }
template <int OFF> __device__ __forceinline__ s16x4 trrd(int base) { s16x4 d; asm volatile("ds_read_b64_tr_b16 %0, %1 offset:%2" : "=&v"(d) : "v"(base), "i"(OFF) : "memory"); return d; }
#define LGKM0() asm volatile("s_waitcnt lgkmcnt(0)" ::: "memory")
#define ROPE2(W0, W1, CS, O0, O1) do { const float a0 = bflo(W0), a1 = bfhi(W0), b0_ = bflo(W1), b1_ = bfhi(W1); \
    O0 = cvt_pk_bf16(a0 * CS[0] - b0_ * CS[1], a1 * CS[2] - b1_ * CS[3]); O1 = cvt_pk_bf16(b0_ * CS[0] + a0 * CS[1], b1_ * CS[2] + a1 * CS[3]); } while (0)
__device__ __forceinline__ bf16x8 cat44(s16x4 l, s16x4 h) { return (bf16x8){l[0], l[1], l[2], l[3], h[0], h[1], h[2], h[3]}; }

__device__ __forceinline__ void mask_tile(f32x16& p0, f32x16& p1, int dq, unsigned W) {
    const float NEG = -__builtin_inff();
#pragma unroll
    for (int r = 0; r < 16; ++r) {
        const int c = (r & 3) + 8 * (r >> 2);
        if ((unsigned)(dq - c) >= W) p0[r] = NEG;
        if ((unsigned)(dq - c - 32) >= W) p1[r] = NEG;
    }
}
__device__ __forceinline__ float softmax_tile(f32x16& p0, f32x16& p1, float& m_reg, float& l_reg, float C2, bf16x8& pa0, bf16x8& pa1, bf16x8& pa2, bf16x8& pa3) {
    float pmax = p0[0];
#pragma unroll
    for (int r = 1; r < 16; ++r) pmax = fmaxf(pmax, p0[r]);
#pragma unroll
    for (int r = 0; r < 16; ++r) pmax = fmaxf(pmax, p1[r]);
    { auto rr = __builtin_amdgcn_permlane32_swap(__float_as_uint(pmax), __float_as_uint(pmax), false, false);
      pmax = fmaxf(__uint_as_float(rr[0]), __uint_as_float(rr[1])); }
    float mn, alpha;
    if (__all((pmax - m_reg) * C2 <= 11.5f)) { mn = m_reg; alpha = 1.f; }
    else { mn = fmaxf(m_reg, pmax); alpha = __builtin_amdgcn_exp2f((m_reg - mn) * C2); m_reg = mn; }
    const float mnL = -mn * C2;
    float ps = 0.f;
#pragma unroll
    for (int r = 0; r < 16; ++r) { p0[r] = __builtin_amdgcn_exp2f(fmaf(p0[r], C2, mnL)); ps += p0[r]; }
#pragma unroll
    for (int r = 0; r < 16; ++r) { p1[r] = __builtin_amdgcn_exp2f(fmaf(p1[r], C2, mnL)); ps += p1[r]; }
    { auto rr = __builtin_amdgcn_permlane32_swap(__float_as_uint(ps), __float_as_uint(ps), false, false);
      ps = __uint_as_float(rr[0]) + __uint_as_float(rr[1]); }
    l_reg = l_reg * alpha + ps;
#define PK4(P, B_, OUT) do { unsigned a0 = cvt_pk_bf16(P[B_+0], P[B_+1]), a1 = cvt_pk_bf16(P[B_+2], P[B_+3]);                          \
        unsigned b0 = cvt_pk_bf16(P[B_+4], P[B_+5]), b1 = cvt_pk_bf16(P[B_+6], P[B_+7]);                                             \
        auto r0 = __builtin_amdgcn_permlane32_swap(a0, b0, false, false); auto r1 = __builtin_amdgcn_permlane32_swap(a1, b1, false, false); \
        u32x4 w = {r0[0], r1[0], r0[1], r1[1]}; OUT = *reinterpret_cast<bf16x8*>(&w); } while (0)
    PK4(p0, 0, pa0); PK4(p0, 8, pa1); PK4(p1, 0, pa2); PK4(p1, 8, pa3);
    return alpha;
}
template <int VOFF, int ND0, int KG = 2048>
__device__ __forceinline__ void pv_tile(f32x16* o, int vb, bf16x8 pa0, bf16x8 pa1, bf16x8 pa2, bf16x8 pa3) {
#define PV_D0(d0) do { s16x4 l0, l1, l2, l3, h0, h1, h2, h3; constexpr int b_ = VOFF + d0 * 512; \
        l0 = trrd<b_>(vb); h0 = trrd<b_ + KG>(vb); l1 = trrd<b_ + 2 * KG>(vb); h1 = trrd<b_ + 3 * KG>(vb); l2 = trrd<b_ + 4 * KG>(vb); h2 = trrd<b_ + 5 * KG>(vb); l3 = trrd<b_ + 6 * KG>(vb); h3 = trrd<b_ + 7 * KG>(vb); \
        LGKM0(); SBAR(); \
        o[d0] = __builtin_amdgcn_mfma_f32_32x32x16_bf16(pa0, cat44(l0, h0), o[d0], 0, 0, 0); \
        o[d0] = __builtin_amdgcn_mfma_f32_32x32x16_bf16(pa1, cat44(l1, h1), o[d0], 0, 0, 0); \
        o[d0] = __builtin_amdgcn_mfma_f32_32x32x16_bf16(pa2, cat44(l2, h2), o[d0], 0, 0, 0); \
        o[d0] = __builtin_amdgcn_mfma_f32_32x32x16_bf16(pa3, cat44(l3, h3), o[d0], 0, 0, 0); } while (0)
    PV_D0(0); PV_D0(1);
    if (ND0 > 2) { PV_D0(2); PV_D0(3); }
#undef PV_D0
}

template <int DQK, int DV, int D2>
struct AttnBlk {
    static constexpr int RB = DQK * 2, KBYTES = 64 * RB, VBYTES = 16384, KOFF = 0, VOFF = 2 * KBYTES, SOFF = VOFF + 3 * VBYTES;
    static constexpr int NC = DQK / 16, ND0 = DV / 32, KPIECES = 64 * DQK / 8, KPT = KPIECES / NTHREADS, VPIECES = 64 * DV / 8, VPT = (VPIECES + NTHREADS - 1) / NTHREADS, PPR = DQK / 8, VPR = DV / 8;
    const bf16_t* Q; int ldq; const bf16_t* K1; int ldk1; const bf16_t* K2; int ldk2; const bf16_t* V; int ldv; bf16_t* O; int ldo;
    float C2; float m_init; float l_init; unsigned W;
    int wrow; int wq; int wo; const float* sinks; float sink_scale; const float2* ropeq;

    struct StageOffs { unsigned ko[KPT]; unsigned vo[1]; };
    __device__ __forceinline__ void stage_setup(StageOffs& so_, int tid) const {
#pragma unroll
        for (int i = 0; i < KPT; ++i) { const int p = tid + NTHREADS * i, row = p / PPR, sp = p - row * PPR;
            const int pc = (sp & ~7) | ((sp ^ (row >> 1)) & 7);
            const bool k1 = (D2 == 0 || pc < (DQK - D2) / 8);
            so_.ko[i] = k1 ? (unsigned)(row * ldk1 + pc * 8) * 2u : ((unsigned)(row * ldk2 + (pc - (DQK - D2) / 8) * 8) * 2u) | 0x80000000u; }
        { const int p = tid;
            const int off = p * 16, sub = off >> 9, g8 = sub >> 2, cblk = sub & 3, rem = (off & 511) >> 1, kkl = rem >> 5, cl = rem & 31;
            const int kk = g8 * 8 + kkl, k = (kk & ~0xC) | ((kk & 4) << 1) | ((kk & 8) >> 1), c = cblk * 32 + cl;
            so_.vo[0] = (unsigned)(k * ldv + c) * 2u; }
    }
    __device__ __forceinline__ void stage_tile(LAS unsigned char* lds, int kbuf, int vbuf, int kb, const StageOffs& so_, int tid, int wid) const {
        const char* kb1 = (const char*)(K1 + (size_t)kb * ldk1); const char* kb2 = (const char*)(K2 + (size_t)kb * ldk2); const char* vbp = (const char*)(V + (size_t)kb * ldv);
#pragma unroll
        for (int i = 0; i < KPT; ++i) {
            const unsigned o_ = so_.ko[i]; LAS unsigned* dst_ = (LAS unsigned*)(lds + KOFF + kbuf * KBYTES + (NTHREADS * i + 64 * wid) * 16);
            if (D2 == 0 || !(o_ >> 31)) __builtin_amdgcn_global_load_lds((const unsigned*)(kb1 + o_), dst_, 16, 0, 0);
            else __builtin_amdgcn_global_load_lds((const unsigned*)(kb2 + (o_ & 0x7fffffffu)), dst_, 16, 0, 0); }
#pragma unroll
        for (int i = 0; i < VPT; ++i) { const int p = tid + NTHREADS * i;
            if (VPIECES >= NTHREADS * (i + 1) || p < VPIECES)
                __builtin_amdgcn_global_load_lds((const unsigned*)(vbp + (size_t)i * 32 * ldv * 2 + so_.vo[0]), (LAS unsigned*)(lds + VOFF + vbuf * VBYTES + (NTHREADS * i + 64 * wid) * 16), 16, 0, 0); }
    }
    __device__ __forceinline__ void run(LAS unsigned char* lds, int P0, int j_lo, int j_hi) const {
        const int tid = threadIdx.x, wid = __builtin_amdgcn_readfirstlane(tid >> 6), lane = tid & 63, r32 = lane & 31, hi = lane >> 5;
        const int qlo = P0 + wid * 32, qm = qlo + r32 - 4 * hi;
        const bool grpB = ATT_STAGGER && wid >= 4;
        LAS float* ws = (LAS float*)(lds + SOFF) + wid * 64; LAS float* li_l = ws; LAS float* al_l = ws + 32;
        bf16x8 qr[NC];
#pragma unroll
        for (int c = 0; c < NC; ++c) qr[c] = *(const bf16x8*)(Q + (size_t)(qlo + r32) * ldq + c * 16 + hi * 8);
        float m_reg = m_init, l_reg = l_init; f32x16 o[ND0];
#pragma unroll
        for (int d = 0; d < ND0; ++d) o[d] = f32x16{};
        const int vb0 = (int)(uintptr_t)(lds + VOFF) + v_rd_base(lane);
        const LAS unsigned char* kb4[4];
#pragma unroll
        for (int cl = 0; cl < 4; ++cl) kb4[cl] = lds + KOFF + r32 * RB + ((cl * 32 + hi * 16) ^ (((r32 >> 1) & 7) << 4));
        f32x16 p0, p1; bf16x8 pa0, pa1, pa2, pa3; float alpha = 1.f;
#define ATT_QK(kbuf_) do { \
            _Pragma("unroll") for (int g = 0; g < NC / 4; ++g) { bf16x8 b0[4], b1[4]; \
                _Pragma("unroll") for (int cl = 0; cl < 4; ++cl) { b0[cl] = *(const LAS bf16x8*)(kb4[cl] + (kbuf_) * KBYTES + g * 128); b1[cl] = *(const LAS bf16x8*)(kb4[cl] + (kbuf_) * KBYTES + g * 128 + 32 * RB); } \
                SBAR(); \
                _Pragma("unroll") for (int cl = 0; cl < 4; ++cl) { \
                    if (g == 0 && cl == 0) { p0 = __builtin_amdgcn_mfma_f32_32x32x16_bf16(b0[cl], qr[0], (f32x16){0.f,0.f,0.f,0.f,0.f,0.f,0.f,0.f,0.f,0.f,0.f,0.f,0.f,0.f,0.f,0.f}, 0, 0, 0); \
                                             p1 = __builtin_amdgcn_mfma_f32_32x32x16_bf16(b1[cl], qr[0], (f32x16){0.f,0.f,0.f,0.f,0.f,0.f,0.f,0.f,0.f,0.f,0.f,0.f,0.f,0.f,0.f,0.f}, 0, 0, 0); } \
                    else { p0 = __builtin_amdgcn_mfma_f32_32x32x16_bf16(b0[cl], qr[g * 4 + cl], p0, 0, 0, 0); \
                           p1 = __builtin_amdgcn_mfma_f32_32x32x16_bf16(b1[cl], qr[g * 4 + cl], p1, 0, 0, 0); } } \
                SBAR(); } } while (0)
#define ATT_SM(kb_) do { if ((kb_) + 63 > qlo || (kb_) + (int)W <= qlo + 31) mask_tile(p0, p1, qm - (kb_), W); \
            alpha = softmax_tile(p0, p1, m_reg, l_reg, C2, pa0, pa1, pa2, pa3); } while (0)
#define ATT_PV(vbuf_) do { if (__any(alpha < 1.f)) { if (hi == 0) al_l[r32] = alpha; LGKM0(); \
                _Pragma("unroll") for (int d = 0; d < ND0; ++d) _Pragma("unroll") for (int r = 0; r < 16; ++r) o[d][r] *= al_l[crow(r, hi)]; } \
            if ((vbuf_) == 0) pv_tile<0, ND0>(o, vb0, pa0, pa1, pa2, pa3); else if ((vbuf_) == 1) pv_tile<VBYTES, ND0>(o, vb0, pa0, pa1, pa2, pa3); else pv_tile<2 * VBYTES, ND0>(o, vb0, pa0, pa1, pa2, pa3); } while (0)
        __syncthreads();
        StageOffs SO; stage_setup(SO, tid);
        stage_tile(lds, 0, 0, j_lo * 64, SO, tid, wid);
        asm volatile("s_waitcnt vmcnt(0)" ::: "memory");
        __syncthreads();
        const int NT = j_hi - j_lo;
#if ATT_STAGGER
        {
        int vcur = 0;
        for (int t = 0; t < NT; ++t) {
            const int kbuf = t & 1, kb = (j_lo + t) * 64;
            const int vnext = (vcur == 2) ? 0 : vcur + 1;
            if (t + 1 < NT) stage_tile(lds, kbuf ^ 1, vnext, kb + 64, SO, tid, wid);
            ATT_QK(kbuf); ATT_SM(kb);
            if (grpB) { asm volatile("s_waitcnt vmcnt(0)" ::: "memory"); __syncthreads(); }
            ATT_PV(vcur);
            if (!grpB) { asm volatile("s_waitcnt vmcnt(0)" ::: "memory"); __syncthreads(); }
            vcur = vnext;
        } }
#else
        for (int t = 0; t < NT; ++t) {
            const int kbuf = t & 1, kb = (j_lo + t) * 64;
            if (t + 1 < NT) stage_tile(lds, kbuf ^ 1, kbuf ^ 1, kb + 64, SO, tid, wid);
            ATT_QK(kbuf); ATT_SM(kb);
            if (__any(alpha < 1.f)) { if (hi == 0) al_l[r32] = alpha; LGKM0();
#pragma unroll
                for (int d = 0; d < ND0; ++d)
#pragma unroll
                    for (int r = 0; r < 16; ++r) o[d][r] *= al_l[crow(r, hi)]; }
            if (kbuf == 0) pv_tile<0, ND0>(o, vb0, pa0, pa1, pa2, pa3); else pv_tile<VBYTES, ND0>(o, vb0, pa0, pa1, pa2, pa3);
            asm volatile("s_waitcnt vmcnt(0)" ::: "memory");
            __syncthreads();
        }
#endif
#undef ATT_QK
#undef ATT_SM
#undef ATT_PV
        if (hi == 0) li_l[r32] = l_reg; LGKM0();
        int hi_o = hi, r32_o = r32; asm volatile("" : "+v"(hi_o), "+v"(r32_o));
        bf16_t* Ow = O + (size_t)qlo * ldo;
#pragma unroll
        for (int r = 0; r < 16; ++r) { const int orow = crow(r, hi_o); const float rl = 1.0f / li_l[orow];
#pragma unroll
            for (int d = 0; d < ND0; ++d) { const float v = o[d][r] * rl; const float vn = __shfl_xor(v, 1);
                if ((r32_o & 1) == 0) *(unsigned*)(Ow + (size_t)orow * ldo + d * 32 + r32_o) = cvt_pk_bf16(v, vn); } }
    }
};

__device__ __forceinline__ int v_st64(int k, int c) { const int kk = (k & ~0xC) | ((k & 4) << 1) | ((k & 8) >> 1); return ((kk >> 3) * 2 + (c >> 5)) * 512 + ((kk & 7) * 32 + (c & 31)) * 2; }
__device__ __forceinline__ void ph_swa(const Frame& F) {
    const bf16_t* qkv = WSP(bf16_t, WS_PROJ); bf16_t* hcat = WSP(bf16_t, WS_HCAT); const float* sinks = F.in[15];
    LAS unsigned char* lds = F.lds;
    constexpr int KT = 8192, VT = 8192, VBASE = 6 * KT, SCR = VBASE + 6 * VT;
    const int tid = F.tid, wid = F.wid, lane = F.lane, r32 = lane & 31, hi = lane >> 5;
    const float C2 = 0.125f * 1.4426950408889634f;
    LAS float* ws = (LAS float*)(lds + SCR) + wid * 64; LAS float* li_l = ws; LAS float* al_l = ws + 32;
    const LAS unsigned char* kb4[4];
#pragma unroll
    for (int cl = 0; cl < 4; ++cl) kb4[cl] = lds + r32 * 128 + ((cl * 32 + hi * 16) ^ (((r32 >> 1) & 7) << 4));
    const int vbase = (int)(uintptr_t)(lds + VBASE) + v_rd_base(lane);
    for (int U = F.bid; U < 256; U += F.G) {
        const int hkv = U & 3, P0 = (U >> 2) * 256;
        const int tile0 = (P0 >> 6) - 2 < 0 ? 0 : (P0 >> 6) - 2, ntl = (P0 >> 6) + 4 - tile0;
        __syncthreads();
        { int tq = tid; asm volatile("" : "+v"(tq));
          const float2* rope = WSP(float2, WS_ROPE);
#pragma unroll
          for (int i = 0; i < 3; ++i) { const int q = tq + NTHREADS * i, key = q >> 2, pc = q & 3;
              if (key < ntl * 64) { const int tl = key >> 6, row = key & 63; const int kabs = tile0 * 64 + key; const size_t g = (size_t)kabs * 2560;
                  const u32x4 k0 = *(const u32x4*)(qkv + g + 2048 + 64 * hkv + pc * 8), k1 = *(const u32x4*)(qkv + g + 2048 + 64 * hkv + 32 + pc * 8);
                  const u32x4 v0 = *(const u32x4*)(qkv + g + 2304 + 64 * hkv + pc * 8), v1 = *(const u32x4*)(qkv + g + 2304 + 64 * hkv + 32 + pc * 8);
                  const f32x4 c0 = *(const f32x4*)(rope + (size_t)kabs * 32 + pc * 8), c1 = *(const f32x4*)(rope + (size_t)kabs * 32 + pc * 8 + 2), c2 = *(const f32x4*)(rope + (size_t)kabs * 32 + pc * 8 + 4), c3 = *(const f32x4*)(rope + (size_t)kabs * 32 + pc * 8 + 6);
                  u32x4 r0, r1;
                  ROPE2(k0.x, k1.x, c0, r0.x, r1.x); ROPE2(k0.y, k1.y, c1, r0.y, r1.y); ROPE2(k0.z, k1.z, c2, r0.z, r1.z); ROPE2(k0.w, k1.w, c3, r0.w, r1.w);
                  *(LAS u32x4*)(lds + tl * KT + row * 128 + ((pc * 16) ^ (((row >> 1) & 7) << 4))) = r0;
                  *(LAS u32x4*)(lds + tl * KT + row * 128 + (((pc + 4) * 16) ^ (((row >> 1) & 7) << 4))) = r1;
                  *(LAS u32x4*)(lds + VBASE + tl * VT + v_st64(row, pc * 8)) = v0;
                  *(LAS u32x4*)(lds + VBASE + tl * VT + v_st64(row, 32 + pc * 8)) = v1; } } }
        __syncthreads();
        const int hq = hkv * 8 + wid;
        const float m0 = sinks[hq] * 8.0f;
        const float2* rope = WSP(float2, WS_ROPE);
        u32x4 qn[4]; f32x4 cn[2][4];
#define SWA_LDQ(rb_) do { const int ql_ = P0 + 32 * (rb_); \
            _Pragma("unroll") for (int c = 0; c < 4; ++c) qn[c] = *(const u32x4*)(qkv + (size_t)(ql_ + r32) * 2560 + 64 * hq + c * 16 + hi * 8); \
            _Pragma("unroll") for (int c = 0; c < 2; ++c) { const f32x4* cs = (const f32x4*)(rope + (size_t)(ql_ + r32) * 32 + 16 * c + 8 * hi); cn[c][0] = cs[0]; cn[c][1] = cs[1]; cn[c][2] = cs[2]; cn[c][3] = cs[3]; } } while (0)
        SWA_LDQ(0);
        for (int rb = 0; rb < 8; ++rb) {
            const int qlo = P0 + 32 * rb, qm = qlo + r32 - 4 * hi;
            bf16x8 qr[4];
            {
#pragma unroll
              for (int c = 0; c < 2; ++c) { const u32x4 a = qn[c], b = qn[c + 2]; u32x4 ra, rb_;
                  ROPE2(a.x, b.x, cn[c][0], ra.x, rb_.x); ROPE2(a.y, b.y, cn[c][1], ra.y, rb_.y); ROPE2(a.z, b.z, cn[c][2], ra.z, rb_.z); ROPE2(a.w, b.w, cn[c][3], ra.w, rb_.w);
                  qr[c] = *reinterpret_cast<bf16x8*>(&ra); qr[c + 2] = *reinterpret_cast<bf16x8*>(&rb_); } }
            __builtin_amdgcn_sched_barrier(0);
            if (rb + 1 < 8) SWA_LDQ(rb + 1);
            __builtin_amdgcn_sched_barrier(0);
            float m_reg = m0, l_reg = 1.f; f32x16 o[2] = {f32x16{}, f32x16{}};
            const int tlo = (qlo - 127 < 0) ? 0 : (qlo - 127) >> 6, thi = (qlo + 31) >> 6;
            for (int tile = tlo; tile <= thi; ++tile) {
                const int lt = tile - tile0, kb = tile * 64;
                f32x16 p0 = f32x16{}, p1 = f32x16{};
                { bf16x8 b0[4], b1[4];
#pragma unroll
                  for (int cl = 0; cl < 4; ++cl) { b0[cl] = *(const LAS bf16x8*)(kb4[cl] + lt * KT); b1[cl] = *(const LAS bf16x8*)(kb4[cl] + lt * KT + 32 * 128); }
#pragma unroll
                  for (int cl = 0; cl < 4; ++cl) { p0 = __builtin_amdgcn_mfma_f32_32x32x16_bf16(b0[cl], qr[cl], p0, 0, 0, 0); p1 = __builtin_amdgcn_mfma_f32_32x32x16_bf16(b1[cl], qr[cl], p1, 0, 0, 0); } }
                mask_tile(p0, p1, qm - kb, 128u);
                bf16x8 pa0, pa1, pa2, pa3;
                const float alpha = softmax_tile(p0, p1, m_reg, l_reg, C2, pa0, pa1, pa2, pa3);
                if (__any(alpha < 1.f)) { if (hi == 0) al_l[r32] = alpha; LGKM0();
#pragma unroll
                    for (int d = 0; d < 2; ++d)
#pragma unroll
                        for (int r = 0; r < 16; ++r) o[d][r] *= al_l[crow(r, hi)]; }
                pv_tile<0, 2, 1024>(o, vbase + lt * VT, pa0, pa1, pa2, pa3);
            }
            if (hi == 0) li_l[r32] = l_reg; LGKM0();
            int hi_o = hi, r32_o = r32; asm volatile("" : "+v"(hi_o), "+v"(r32_o));
            bf16_t* Ow = hcat + (size_t)qlo * 2048 + 64 * hq;
#pragma unroll
            for (int r = 0; r < 16; ++r) { const int orow = crow(r, hi_o); const float rl = 1.0f / li_l[orow];
#pragma unroll
                for (int d = 0; d < 2; ++d) { const float v = o[d][r] * rl; const float vn = __shfl_xor(v, 1);
                    if ((r32_o & 1) == 0) *(unsigned*)(Ow + (size_t)orow * 2048 + d * 32 + r32_o) = cvt_pk_bf16(v, vn); } }
        }
    }
    __syncthreads();
}

__device__ __forceinline__ void ph_mla_prep(const Frame& F) {
    const bf16_t* proj = WSP(bf16_t, WS_PROJ); const float* qn = F.in[8]; const float* kvn = F.in[9];
    bf16_t* cqn = WSP(bf16_t, WS_CQN); bf16_t* ckvn = WSP(bf16_t, WS_CKVN); bf16_t* kpe = WSP(bf16_t, WS_KPE); const float2* rope = WSP(float2, WS_ROPE);
    const int lane = F.lane;
    for (int t = F.bid * 8 + F.wid; t < T; t += F.G * 8) {
        const bf16_t* pr = proj + (size_t)t * IN_PAD;
        { float v[3][4]; float ss = 0.f;
#pragma unroll
          for (int j = 0; j < 3; ++j) { const u32x2 w = *(const u32x2*)(pr + OFF_CQ + 4 * lane + 256 * j); v[j][0] = bflo(w.x); v[j][1] = bfhi(w.x); v[j][2] = bflo(w.y); v[j][3] = bfhi(w.y);
              ss += v[j][0] * v[j][0] + v[j][1] * v[j][1] + v[j][2] * v[j][2] + v[j][3] * v[j][3]; }
          ss = wave_sum(ss); const float rstd = rsqrtf(ss * (1.0f / 768.0f) + EPS);
#pragma unroll
          for (int j = 0; j < 3; ++j) { const int col = 4 * lane + 256 * j; const f32x4 g = *(const f32x4*)(qn + col);
              u32x2 o; o.x = cvt_pk_bf16(v[j][0] * rstd * g[0], v[j][1] * rstd * g[1]); o.y = cvt_pk_bf16(v[j][2] * rstd * g[2], v[j][3] * rstd * g[3]);
              *(u32x2*)(cqn + (size_t)t * 768 + col) = o; } }
        { float v[2][4]; float ss = 0.f;
#pragma unroll
          for (int j = 0; j < 2; ++j) { const u32x2 w = *(const u32x2*)(pr + OFF_CKV + 4 * lane + 256 * j); v[j][0] = bflo(w.x); v[j][1] = bfhi(w.x); v[j][2] = bflo(w.y); v[j][3] = bfhi(w.y);
              ss += v[j][0] * v[j][0] + v[j][1] * v[j][1] + v[j][2] * v[j][2] + v[j][3] * v[j][3]; }
          ss = wave_sum(ss); const float rstd = rsqrtf(ss * (1.0f / 512.0f) + EPS);
#pragma unroll
          for (int j = 0; j < 2; ++j) { const int col = 4 * lane + 256 * j; const f32x4 g = *(const f32x4*)(kvn + col);
              u32x2 o; o.x = cvt_pk_bf16(v[j][0] * rstd * g[0], v[j][1] * rstd * g[1]); o.y = cvt_pk_bf16(v[j][2] * rstd * g[2], v[j][3] * rstd * g[3]);
              *(u32x2*)(ckvn + (size_t)t * 512 + col) = o; } }
        if (lane < 32) { const float x1 = bf2f(pr[OFF_KR + lane]), x2 = bf2f(pr[OFF_KR + 32 + lane]); const float2 cs = rope[t * 32 + lane];
            kpe[(size_t)t * 64 + lane] = f2bf(x1 * cs.x - x2 * cs.y); kpe[(size_t)t * 64 + 32 + lane] = f2bf(x2 * cs.x + x1 * cs.y); }
    }
}

__device__ __forceinline__ void ph_gates(const Frame& F) {
    const bf16_t* proj = WSP(bf16_t, WS_PROJ); const float* bif = F.in[6];
    float* GA = WSP(float, WS_GA); float* GB = WSP(float, WS_GB); float* GCM = WSP(float, WS_GCM); float* GST = WSP(float, WS_GST);
    const int lane = F.lane;
    for (int u = F.bid * 8 + F.wid; u < NCH * 4; u += F.G * 8) {
        const int c = u >> 2, h = u & 3, t = c * 64 + lane;
        const float ipre = bf2f(proj[(size_t)t * IN_PAD + OFF_MI + h]) + bif[h], fpre = bf2f(proj[(size_t)t * IN_PAD + OFF_MF + h]) + bif[4 + h];
        const float ig = 15.0f * tanhf(ipre * (1.0f / 15.0f)); const float z = 15.0f * tanhf(fpre * (1.0f / 15.0f));
        const float lf = (z >= 0.f) ? -log1pf(expf(-z)) : z - log1pf(expf(z));
        float b = lf;
#pragma unroll
        for (int o = 1; o < 64; o <<= 1) { const float v = __shfl_up(b, o); if (lane >= o) b += v; }
        const float a = ig - b;
        float cm = a;
#pragma unroll
        for (int o = 1; o < 64; o <<= 1) { const float v = __shfl_up(cm, o); if (lane >= o) cm = fmaxf(cm, v); }
        GA[h * T + t] = a; GB[h * T + t] = b; GCM[h * T + t] = cm;
        if (lane == 63) { GST[h * 256 + c] = cm; GST[1024 + h * 256 + c] = b; }
    }
}

__device__ __forceinline__ void m_scan(const Frame& F, LAS float* mst) {
    float* GST = WSP(float, WS_GST);
    LAS float* tmp = mst + 4 * 257 + 3;
    __syncthreads();
    for (int i = F.tid; i < 2048; i += NTHREADS) tmp[i] = GST[i];
    __syncthreads();
    if (F.tid < 4) { const int h = F.tid; float m = 0.f; mst[h * 257] = 0.f;
        for (int c = 0; c < 256; ++c) { m = tmp[1024 + h * 256 + c] + fmaxf(m, tmp[h * 256 + c]); mst[h * 257 + c + 1] = m; } }
    __syncthreads();
    if (F.bid == 0) for (int i = F.tid; i < 4 * 257; i += NTHREADS) GST[2048 + i] = mst[i];
}

__device__ __forceinline__ void ph_rope_q(const Frame& F) {
    const float2* rope = WSP(float2, WS_ROPE); bf16_t* qraw = WSP(bf16_t, WS_QRAW);
    for (int idx = F.bid * NTHREADS + F.tid; idx < T * 32; idx += F.G * NTHREADS) {
        const int t = idx >> 5, hh = (idx >> 2) & 7, pc = idx & 3;
        bf16_t* p = qraw + (size_t)t * 1536 + hh * 192 + 128 + pc * 8;
        const u32x4 a = *(const u32x4*)p, b = *(const u32x4*)(p + 32);
        const f32x4* cs = (const f32x4*)(rope + (size_t)t * 32 + pc * 8);
        const f32x4 c0 = cs[0], c1 = cs[1], c2 = cs[2], c3 = cs[3];
        u32x4 ra, rb_;
        ROPE2(a.x, b.x, c0, ra.x, rb_.x); ROPE2(a.y, b.y, c1, ra.y, rb_.y); ROPE2(a.z, b.z, c2, ra.z, rb_.z); ROPE2(a.w, b.w, c3, ra.w, rb_.w);
        *(u32x4*)p = ra; *(u32x4*)(p + 32) = rb_;
    }
}

#define TRF(dst, base, TOFF, d0, ks) do { const s16x4 l_ = trrd<(TOFF) + v_rd_off(d0, ks, 0)>(base); const s16x4 h_ = trrd<(TOFF) + v_rd_off(d0, ks, 1)>(base); LGKM0(); dst = cat44(l_, h_); } while (0)
__device__ __forceinline__ void ph_mlstm_B(const Frame& F, const LAS float* mst) {
    const bf16_t* proj = WSP(bf16_t, WS_PROJ); const float* GA = WSP(float, WS_GA); const float* GST = WSP(float, WS_GST);
    bf16_t* dC = WSP(bf16_t, WS_DC); float* DN = WSP(float, WS_DN);
    LAS unsigned char* lds = F.lds;
    const int tid = F.tid, lane = F.lane, w = F.wid, r32 = lane & 31, hi = lane >> 5;
    const int lbase = (int)(uintptr_t)lds + v_rd_base(lane);
    for (int u = F.bid; u < NCH * 4; u += F.G) {
        const int c = u >> 2, h = u & 3, t0 = c * 64;
        const float mx = fmaxf(mst[h * 257 + c], GST[h * 256 + c]);
        __syncthreads();
#pragma unroll
        for (int i = 0; i < 2; ++i) { const int q = tid + NTHREADS * i, s = q >> 4, dc = (q & 15) * 8;
            const u32x4 raw = *(const u32x4*)(proj + (size_t)(t0 + s) * IN_PAD + OFF_MK + h * 128 + dc);
            const float wsc = expf(GA[h * T + t0 + s] - mx) * 0.08838834764831845f;
            u32x4 o; o.x = cvt_pk_bf16(bflo(raw.x) * wsc, bfhi(raw.x) * wsc); o.y = cvt_pk_bf16(bflo(raw.y) * wsc, bfhi(raw.y) * wsc);
            o.z = cvt_pk_bf16(bflo(raw.z) * wsc, bfhi(raw.z) * wsc); o.w = cvt_pk_bf16(bflo(raw.w) * wsc, bfhi(raw.w) * wsc);
            *(LAS u32x4*)(lds + v_st(s, dc)) = o; }
#pragma unroll
        for (int i = 0; i < 4; ++i) { const int q = tid + NTHREADS * i, s = q >> 5, vc = (q & 31) * 8;
            const u32x4 raw = *(const u32x4*)(proj + (size_t)(t0 + s) * IN_PAD + OFF_MV + h * 256 + vc);
            *(LAS u32x4*)(lds + 16384 + (vc >> 7) * 16384 + v_st(s, vc & 127)) = raw; }
        __syncthreads();
        bf16x8 Bf[4];
        {
            const int vb = lbase + 16384 + (w >> 2) * 16384 + (w & 3) * 512;
            TRF(Bf[0], vb, 0, 0, 0); TRF(Bf[1], vb, 0, 0, 1); TRF(Bf[2], vb, 0, 0, 2); TRF(Bf[3], vb, 0, 0, 3);
        }
        f32x16 acc[4];
#define MB_STEP(mb) do { bf16x8 a0, a1, a2, a3; TRF(a0, lbase, 0, mb, 0); TRF(a1, lbase, 0, mb, 1); TRF(a2, lbase, 0, mb, 2); TRF(a3, lbase, 0, mb, 3); \
        f32x16 z = f32x16{}; z = __builtin_amdgcn_mfma_f32_32x32x16_bf16(a0, Bf[0], z, 0, 0, 0); z = __builtin_amdgcn_mfma_f32_32x32x16_bf16(a1, Bf[1], z, 0, 0, 0); \
        z = __builtin_amdgcn_mfma_f32_32x32x16_bf16(a2, Bf[2], z, 0, 0, 0); z = __builtin_amdgcn_mfma_f32_32x32x16_bf16(a3, Bf[3], z, 0, 0, 0); acc[mb] = z; } while (0)
        MB_STEP(0); MB_STEP(1); MB_STEP(2); MB_STEP(3);
#undef MB_STEP
        bf16_t* outp = dC + ((size_t)u * 256 + w * 32 + r32) * 128;
#pragma unroll
        for (int mb = 0; mb < 4; ++mb)
#pragma unroll
            for (int rq = 0; rq < 4; ++rq) { u32x2 o; o.x = cvt_pk_bf16(acc[mb][4 * rq + 0], acc[mb][4 * rq + 1]); o.y = cvt_pk_bf16(acc[mb][4 * rq + 2], acc[mb][4 * rq + 3]);
                *(u32x2*)(outp + mb * 32 + 8 * rq + 4 * hi) = o; }
        if (tid < 128) { float s_ = 0.f; const int d = tid;
            for (int s = 0; s < 64; ++s) s_ += bf2f(*(const LAS bf16_t*)(lds + v_st(s, d & ~7) + (d & 7) * 2));
            DN[(size_t)u * 128 + d] = s_; }
    }
    __syncthreads();
}

__device__ __forceinline__ void ph_mlstm_C(const Frame& F) {
    const float* GST = WSP(float, WS_GST);
    const bf16_t* dC = WSP(bf16_t, WS_DC); bf16_t* Cst = WSP(bf16_t, WS_CST); const float* DN = WSP(float, WS_DN); float* NST = WSP(float, WS_NST);
    LAS float* dec = (LAS float*)F.aux;
    __syncthreads();
    for (int i = F.tid; i < 1024; i += NTHREADS) { const int h = i >> 8, c = i & 255; const float m = GST[2048 + h * 257 + c]; dec[i] = expf(m - fmaxf(m, GST[h * 256 + c])); }
    __syncthreads();
    for (int it = F.bid * 128 + F.tid; F.tid < 128 && it < 32768; it += F.G * 128) {
        const int h = it >> 13, rem = it & 8191;
        const size_t off0 = (size_t)h * 256 * 128 + (size_t)rem * 4;
        float s0 = 0.f, s1 = 0.f, s2 = 0.f, s3 = 0.f;
        u32x2 buf[16];
#pragma unroll
        for (int j = 0; j < 16; ++j) buf[j] = __builtin_nontemporal_load((const u32x2*)(dC + (size_t)j * 131072 + off0));
        for (int cb = 0; cb < 256; cb += 16) {
            u32x2 nb[16];
            if (cb + 16 < 256) {
#pragma unroll
                for (int j = 0; j < 16; ++j) nb[j] = __builtin_nontemporal_load((const u32x2*)(dC + (size_t)(cb + 16 + j) * 131072 + off0));
            }
#pragma unroll
            for (int j = 0; j < 16; ++j) {
                u32x2 o; o.x = cvt_pk_bf16(s0, s1); o.y = cvt_pk_bf16(s2, s3);
                *(u32x2*)(Cst + (size_t)(cb + j) * 131072 + off0) = o;
                const float d = dec[h * 256 + cb + j];
                s0 = d * s0 + bflo(buf[j].x); s1 = d * s1 + bfhi(buf[j].x); s2 = d * s2 + bflo(buf[j].y); s3 = d * s3 + bfhi(buf[j].y);
            }
            if (cb + 16 < 256) {
#pragma unroll
                for (int j = 0; j < 16; ++j) buf[j] = nb[j];
            }
        }
    }
    if (F.bid == F.G - 1) {
        const int it = F.tid; const int h = it >> 7;
        float s = 0.f;
#pragma unroll 16
        for (int c = 0; c < 256; ++c) { NST[(size_t)c * 512 + it] = s; s = dec[h * 256 + c] * s + DN[(size_t)c * 512 + it]; }
    }
}

__device__ __forceinline__ void ph_mlstm_D(const Frame& F) {
    const bf16_t* proj = WSP(bf16_t, WS_PROJ); const float* GA = WSP(float, WS_GA); const float* GB = WSP(float, WS_GB); const float* GCM = WSP(float, WS_GCM);
    const float* GST = WSP(float, WS_GST); const bf16_t* Cst = WSP(bf16_t, WS_CST); const float* NST = WSP(float, WS_NST);
    const float* gain = F.in[7]; bf16_t* hcat = WSP(bf16_t, WS_HCAT);
    const int tid = F.tid, lane = F.lane, r32 = lane & 31, hi = lane >> 5;
    const int hb = F.wid >> 2, wl = F.wid & 3, rh = wl & 1, vh = wl >> 1, htid = tid & 255;
    LAS unsigned char* hl = F.lds + hb * 40960;
    LAS float* a_l = (LAS float*)(hl + 32768); LAS float* n_l = (LAS float*)(hl + 33024); LAS float* rowss = (LAS float*)(hl + 33536);
    LAS float* scr = (LAS float*)(hl + 34048 + wl * 256);
    for (int pi = F.bid; pi < NCH * 2; pi += F.G) {
        const int u = pi * 2 + hb, c = u >> 2, h = u & 3, t0 = c * 64;
        __syncthreads();
        { u32x4 raw[8];
#pragma unroll
          for (int i = 0; i < 8; ++i) { const int q = htid + 256 * i, s = q >> 5, vc = (q & 31) * 8;
              raw[i] = *(const u32x4*)(proj + (size_t)(t0 + s) * IN_PAD + OFF_MV + h * 256 + vc); }
          SBAR();
#pragma unroll
          for (int i = 0; i < 8; ++i) { const int q = htid + 256 * i, s = q >> 5, vc = (q & 31) * 8;
              *(LAS u32x4*)(hl + (vc >> 7) * 16384 + v_st(s, vc & 127)) = raw[i]; } }
        if (htid < 64) a_l[htid] = GA[h * T + t0 + htid];
        if (htid < 128) n_l[htid] = NST[(size_t)u * 128 + htid];
        __syncthreads();
        const int j = 32 * rh + r32, t = t0 + j;
        const float m_c = GST[2048 + h * 257 + c];
        const float M_j = fmaxf(m_c, GCM[h * T + t]), b_j = GB[h * T + t];
        bf16x8 qr[8];
#pragma unroll
        for (int cc = 0; cc < 8; ++cc) qr[cc] = *(const bf16x8*)(proj + (size_t)t * IN_PAD + OFF_MQ + h * 128 + cc * 16 + hi * 8);
        f32x16 p0 = f32x16{}, p1 = f32x16{};
#pragma unroll
        for (int cc = 0; cc < 8; ++cc) {
            const bf16x8 k0 = *(const bf16x8*)(proj + (size_t)(t0 + r32) * IN_PAD + OFF_MK + h * 128 + cc * 16 + hi * 8);
            const bf16x8 k1 = *(const bf16x8*)(proj + (size_t)(t0 + 32 + r32) * IN_PAD + OFF_MK + h * 128 + cc * 16 + hi * 8);
            p0 = __builtin_amdgcn_mfma_f32_32x32x16_bf16(k0, qr[cc], p0, 0, 0, 0);
            p1 = __builtin_amdgcn_mfma_f32_32x32x16_bf16(k1, qr[cc], p1, 0, 0, 0);
        }
        float dsum = 0.f;
#pragma unroll
        for (int r = 0; r < 16; ++r) {
            const int s0 = crow(r, hi), s1 = 32 + s0;
            const float e0 = __expf(fminf(a_l[s0] - M_j, 0.f)) * 0.08838834764831845f, e1 = __expf(fminf(a_l[s1] - M_j, 0.f)) * 0.08838834764831845f;
            const float w0 = (s0 <= j) ? e0 : 0.f, w1 = (s1 <= j) ? e1 : 0.f;
            p0[r] *= w0; p1[r] *= w1; dsum += p0[r] + p1[r];
        }
        { auto rr = __builtin_amdgcn_permlane32_swap(__float_as_uint(dsum), __float_as_uint(dsum), false, false); dsum = __uint_as_float(rr[0]) + __uint_as_float(rr[1]); }
        bf16x8 pa0, pa1, pa2, pa3;
        PK4(p0, 0, pa0); PK4(p0, 8, pa1); PK4(p1, 0, pa2); PK4(p1, 8, pa3);
        f32x16 o[4];
#pragma unroll
        for (int d = 0; d < 4; ++d) o[d] = f32x16{};
        const int vb0 = (int)(uintptr_t)(hl + vh * 16384) + v_rd_base(lane);
        pv_tile<0, 4>(o, vb0, pa0, pa1, pa2, pa3);
        const float w_inter = expf(m_c - M_j);
        float qn = 0.f;
        bf16x8 qs[8];
#pragma unroll
        for (int cc = 0; cc < 8; ++cc) {
            const u32x4 w = *reinterpret_cast<const u32x4*>(&qr[cc]);
            const float q0 = bflo(w.x), q1 = bfhi(w.x), q2 = bflo(w.y), q3 = bfhi(w.y), q4 = bflo(w.z), q5 = bfhi(w.z), q6 = bflo(w.w), q7 = bfhi(w.w);
            const LAS float* np = n_l + cc * 16 + hi * 8;
            qn += q0 * np[0] + q1 * np[1] + q2 * np[2] + q3 * np[3] + q4 * np[4] + q5 * np[5] + q6 * np[6] + q7 * np[7];
            u32x4 o_; o_.x = cvt_pk_bf16(q0 * w_inter, q1 * w_inter); o_.y = cvt_pk_bf16(q2 * w_inter, q3 * w_inter); o_.z = cvt_pk_bf16(q4 * w_inter, q5 * w_inter); o_.w = cvt_pk_bf16(q6 * w_inter, q7 * w_inter);
            qs[cc] = *reinterpret_cast<bf16x8*>(&o_);
        }
        { auto rr = __builtin_amdgcn_permlane32_swap(__float_as_uint(qn), __float_as_uint(qn), false, false); qn = __uint_as_float(rr[0]) + __uint_as_float(rr[1]); }
        {
            const bf16_t* cp = Cst + ((size_t)u * 256 + 128 * vh + r32) * 128 + hi * 8;
            bf16x8 cfa[8], cfb[8];
#pragma unroll
            for (int cc = 0; cc < 8; ++cc) cfa[cc] = *(const bf16x8*)(cp + cc * 16);
#pragma unroll
            for (int cc = 0; cc < 8; ++cc) cfb[cc] = *(const bf16x8*)(cp + (size_t)32 * 128 + cc * 16);
            SBAR();
#pragma unroll
            for (int cc = 0; cc < 8; ++cc) o[0] = __builtin_amdgcn_mfma_f32_32x32x16_bf16(qs[cc], cfa[cc], o[0], 0, 0, 0);
            SBAR();
#pragma unroll
            for (int cc = 0; cc < 8; ++cc) cfa[cc] = *(const bf16x8*)(cp + (size_t)64 * 128 + cc * 16);
            SBAR();
#pragma unroll
            for (int cc = 0; cc < 8; ++cc) o[1] = __builtin_amdgcn_mfma_f32_32x32x16_bf16(qs[cc], cfb[cc], o[1], 0, 0, 0);
            SBAR();
#pragma unroll
            for (int cc = 0; cc < 8; ++cc) cfb[cc] = *(const bf16x8*)(cp + (size_t)96 * 128 + cc * 16);
            SBAR();
#pragma unroll
            for (int cc = 0; cc < 8; ++cc) o[2] = __builtin_amdgcn_mfma_f32_32x32x16_bf16(qs[cc], cfa[cc], o[2], 0, 0, 0);
            SBAR();
#pragma unroll
            for (int cc = 0; cc < 8; ++cc) o[3] = __builtin_amdgcn_mfma_f32_32x32x16_bf16(qs[cc], cfb[cc], o[3], 0, 0, 0);
        }
        const float den = dsum + w_inter * qn;
        const float inv = 1.0f / fmaxf(fabsf(den), expf(-(b_j + M_j)));
        if (hi == 0) scr[r32] = inv;
        LGKM0();
        float ss[16];
#pragma unroll
        for (int r = 0; r < 16; ++r) { const float iv = scr[crow(r, hi)]; float a = 0.f;
#pragma unroll
            for (int d = 0; d < 4; ++d) { o[d][r] *= iv; a += o[d][r] * o[d][r]; }
            a += __shfl_xor(a, 1); a += __shfl_xor(a, 2); a += __shfl_xor(a, 4); a += __shfl_xor(a, 8); a += __shfl_xor(a, 16);
            ss[r] = a; }
        if (r32 == 0) {
#pragma unroll
            for (int r = 0; r < 16; ++r) rowss[vh * 64 + 32 * rh + crow(r, hi)] = ss[r]; }
        __syncthreads();
#pragma unroll
        for (int r = 0; r < 16; ++r) { const int jr = 32 * rh + crow(r, hi);
#pragma unroll
            for (int d = 0; d < 4; ++d) *(LAS bf16_t*)(hl + jr * 512 + (128 * vh + 32 * d + r32) * 2) = f2bf(o[d][r]); }
        __syncthreads();
        { u32x4 ov[8], mv[8];
#pragma unroll
          for (int i = 0; i < 8; ++i) { const int q = htid + 256 * i, row = q >> 5, c8 = (q & 31) * 8;
              ov[i] = *(const LAS u32x4*)(hl + row * 512 + c8 * 2);
              mv[i] = *(const u32x4*)(proj + (size_t)(t0 + row) * IN_PAD + OFF_MO + h * 256 + c8); }
#pragma unroll
          for (int i = 0; i < 8; ++i) { const int q = htid + 256 * i, row = q >> 5, c8 = (q & 31) * 8;
              const float rstd = rsqrtf((rowss[row] + rowss[64 + row]) * (1.0f / 256.0f) + EPS);
              const f32x4 g0 = *(const f32x4*)(gain + h * 256 + c8), g1 = *(const f32x4*)(gain + h * 256 + c8 + 4);
              float v[8];
#pragma unroll
              for (int e = 0; e < 4; ++e) { const unsigned ow = ov[i][e], mw = mv[i][e];
                  v[2 * e] = bflo(ow) * rstd * ((e < 2) ? g0[2 * e] : g1[2 * e - 4]) / (1.0f + __expf(-bflo(mw)));
                  v[2 * e + 1] = bfhi(ow) * rstd * ((e < 2) ? g0[2 * e + 1] : g1[2 * e - 3]) / (1.0f + __expf(-bfhi(mw))); }
              u32x4 w; w.x = cvt_pk_bf16(v[0], v[1]); w.y = cvt_pk_bf16(v[2], v[3]); w.z = cvt_pk_bf16(v[4], v[5]); w.w = cvt_pk_bf16(v[6], v[7]);
              *(u32x4*)(hcat + (size_t)(t0 + row) * 2048 + h * 256 + c8) = w; } }
    }
    __syncthreads();
}

constexpr int NPHASE = 26;
__device__ __forceinline__ void moe_phase_router(const Frame& F, int layer) {
    PolRouter p; p.A = WSP(bf16_t, WS_H2); p.Bt = WSP(bf16_t, WS_WR) + (size_t)layer * 256 * 2048; p.part = WSP(float, WS_LOGP); p.K = 512; p.ldb = 2048;
    pg8::gemm_phase(F.lds, p);
}
__device__ __forceinline__ void moe_phase_gateup(const Frame& F, int layer) {
    PolGateUp p; p.A = WSP(bf16_t, WS_H2); p.W = WSP(bf16_t, WS_WGU) + (size_t)layer * 65 * 512 * 2048; p.rowtok = WSP(int, WS_ROWTOK); p.act = WSP(bf16_t, WS_ACT);
    p.tb = moe_tables(F); p.K = 2048; p.ldb = 2048;
    {
        LAS int* ridx = (LAS int*)(F.aux + 6144);
        for (int idx = F.tid; idx < 8 * 256; idx += NTHREADS) { const int i = idx >> 8, r = idx & 255, L = p.tb.rank + i * p.tb.nrank;
            if (L < p.tb.nrb * 2) ridx[idx] = p.rowtok[p.tb.blk_row0[p.tb.rb0 + (L >> 1)] + r]; }
        __syncthreads();
        p.ridx = ridx; }
    pg8::gemm_phase(F.lds, p);
}
__device__ __forceinline__ void moe_phase_down(const Frame& F, int layer, int nostore = 0) {
    PolDown p; p.nostore = nostore; p.A = WSP(bf16_t, WS_ACT); p.W = WSP(bf16_t, WS_WDN) + (size_t)layer * 65 * 2048 * 256; p.Y = WSP(unsigned char, WS_Y);
    p.tb = moe_tables(F); p.K = 256; p.ldb = 256;
    pg8::gemm_phase(F.lds, p);
}

__global__ void __launch_bounds__(NTHREADS, 2) mk_fwd(Args args) {
    extern __shared__ __attribute__((aligned(16))) unsigned char lds_raw[];
    Frame F;
    F.lds = (LAS unsigned char*)lds_raw; F.aux = F.lds + LDS_MAIN;
    F.in = args.in; F.out = args.out; F.ws = args.ws;
    F.tid = threadIdx.x; F.lane = F.tid & 63; F.wid = __builtin_amdgcn_readfirstlane(F.tid >> 6); F.G = gridDim.x; F.bid = blockIdx.x;
    volatile LAS unsigned* xbw = (volatile LAS unsigned*)(F.lds + LDS_MAIN + LDS_AUX);
    if (F.tid < 4) xbw[F.tid] = 0u;
    __syncthreads();
    const int lo = args.ph_lo, hi = args.ph_hi;
    XcdBarrier bar; bar.bar = WSP(unsigned, WS_ZERO + ZB_BAR); bar.x = 0; bar.st = xbw;
    if (hi - lo > 1) bar = xcd_barrier_post(WSP(unsigned, WS_ZERO + ZB_BAR), xbw);
#ifdef PH_ONLY
#define IN(k) ((k) == PH_ONLY)
#else
#define IN(k) (lo <= (k) && (k) < hi)
#endif
#define SEAM(k) do { if (IN(k) && IN((k) + 1)) xcd_barrier(bar); { int t_ = threadIdx.x; asm volatile("" : "+v"(t_)); F.tid = t_; F.lane = t_ & 63; F.wid = __builtin_amdgcn_readfirstlane(t_ >> 6); } } while (0)
    const float* mod = WSP(float, WS_ZERO + ZB_MOD);
    const float* mod0 = mod; const float* mod1 = mod + 12288;

    if (IN(0)) { PRB(0) { ph_adaln(F); ph_rope_table(F); ph_convert(F); } } SEAM(0);
#if PROBE_EXTRA_BARRIERS
    if (hi - lo > 1) { for (int xb = 0; xb < 16; ++xb) xcd_barrier(bar); }
#endif
    if (IN(1)) { PRB(15) ph_modulate<0>(F, F.in[0], mod0 + 0, mod0 + 2048, WSP(bf16_t, WS_HA)); } SEAM(1);
    if (IN(2)) { PRB(5) { PolBf16 p{{WSP(bf16_t, WS_HA), WSP(bf16_t, WS_WIN), 2048, 2048, 2048, 64, IN_PAD / 256}, WSP(bf16_t, WS_PROJ), IN_PAD, nullptr}; pg8::gemm_phase(F.lds, p); } } SEAM(2);
    if (IN(3)) { PRB(14) { ph_mla_prep(F); ph_gates(F); } } SEAM(3);
    if (IN(4)) {
        LAS float* mst = (LAS float*)F.aux;
        m_scan(F, mst);
        { PolBf16 p{{WSP(bf16_t, WS_CQN), WSP(bf16_t, WS_WUQ), 768, 768, 768, 64, 6}, WSP(bf16_t, WS_QRAW), 1536, nullptr}; pg8::gemm_phase(F.lds, p); }
        { PolBf16 p{{WSP(bf16_t, WS_CKVN), WSP(bf16_t, WS_WUKV), 512, 512, 512, 64, 8}, WSP(bf16_t, WS_KVRAW), 2048, nullptr}; pg8::gemm_phase(F.lds, p); }
        PRB(12) ph_mlstm_B(F, mst);
    } SEAM(4);
    if (IN(5)) { PRB(8) ph_mlstm_C(F); ph_rope_q(F); } SEAM(5);
    if (IN(6)) {
        PRB(13) ph_mlstm_D(F);
        AttnBlk<192, 128, 64> A;
        A.ldq = 1536; A.ldk1 = 2048; A.K2 = WSP(bf16_t, WS_KPE); A.ldk2 = 64; A.ldv = 2048; A.ldo = 2048;
        A.C2 = 0.07216878364870323f * 1.4426950408889634f; A.m_init = -1e30f; A.l_init = 0.f; A.W = 1u << 30; A.wrow = 32; A.wq = 0; A.wo = 0; A.sinks = nullptr; A.sink_scale = 0.f; A.ropeq = WSP(float2, WS_ROPE);
        const bool cvt_first = F.bid < MCV_BLOCKS;
        if (cvt_first) moe_cvt_queue(F);
        unsigned* actr = WSP(unsigned, WS_ZERO + ZB_CTR + 128);
        for (;;) {
            const int u = grab(F, actr); if (u >= 512) break;
            const int h = u & 7, qb = 63 - (u >> 3);
            A.Q = WSP(bf16_t, WS_QRAW) + 192 * h; A.K1 = WSP(bf16_t, WS_KVRAW) + 256 * h; A.V = WSP(bf16_t, WS_KVRAW) + 256 * h + 128; A.O = WSP(bf16_t, WS_HCAT) + 1024 + 128 * h;
            A.run(F.lds, qb * 256, 0, qb * 4 + 4);
        }
        if (!cvt_first) moe_cvt_queue(F);
        __syncthreads();
    } SEAM(6);
    if (IN(7)) { PolResid<false> p{{WSP(bf16_t, WS_HCAT), WSP(bf16_t, WS_WOUT), 2048, 2048, 2048, 64, 8}, F.in[0], mod0 + 4096, WSP(bf16_t, WS_XA)}; pg8::gemm_phase(F.lds, p); } SEAM(7);
    if (IN(8)) { PRB(4) ph_modulate<1>(F, WSP(bf16_t, WS_XA), mod0 + 6144, mod0 + 8192, WSP(bf16_t, WS_H2)); } SEAM(8);
    if (IN(9)) { PRB(6) moe_phase_router(F, 0); } SEAM(9);
    if (IN(10)) { PRB(9) ph_route(F, 0); } SEAM(10);
    if (IN(11)) { PRB(9) ph_dispatch(F); } SEAM(11);
    if (IN(12)) { PRB(1) moe_phase_gateup(F, 0); } SEAM(12);
    if (IN(13)) { moe_phase_down(F, 0);
#if PROBE_DOWN_NOSTORE == 1
        moe_phase_down(F, 0, 1);
#elif PROBE_DOWN_NOSTORE == 2
        moe_phase_down(F, 0, 0);
#endif
    } SEAM(13);
    if (IN(14)) { PRB(3) ph_combine<0>(F, WSP(bf16_t, WS_XA), mod0 + 10240, WSP(bf16_t, WS_XB), mod1 + 0, mod1 + 2048, WSP(bf16_t, WS_HA), nullptr); } SEAM(14);
    if (IN(15)) { PolBf16 p{{WSP(bf16_t, WS_HA), WSP(bf16_t, WS_WQKV), 2048, 2048, 2048, 64, 10}, WSP(bf16_t, WS_PROJ), 2560, F.in[14]}; pg8::gemm_phase(F.lds, p); } SEAM(15);
    if (IN(17)) { PRB(7) ph_swa(F);
    } SEAM(17);
    if (IN(18)) { PolResid<true> p{{WSP(bf16_t, WS_HCAT), WSP(bf16_t, WS_WO), 2048, 2048, 2048, 64, 8}, WSP(bf16_t, WS_XB), mod1 + 4096, WSP(bf16_t, WS_XA)}; pg8::gemm_phase(F.lds, p); } SEAM(18);
    if (IN(19)) { ph_modulate<1>(F, WSP(bf16_t, WS_XA), mod1 + 6144, mod1 + 8192, WSP(bf16_t, WS_H2)); } SEAM(19);
    if (IN(20)) { moe_phase_router(F, 1); } SEAM(20);
    if (IN(21)) { ph_route(F, 1); } SEAM(21);
    if (IN(22)) { ph_dispatch(F); } SEAM(22);
    if (IN(23)) { moe_phase_gateup(F, 1); } SEAM(23);
    if (IN(24)) { moe_phase_down(F, 1); } SEAM(24);
    if (IN(25)) { ph_combine<1>(F, WSP(bf16_t, WS_XA), mod1 + 10240, nullptr, nullptr, F.in[23], nullptr, F.out); }
#undef IN
#undef SEAM
}

#ifdef DBG_DUMP_OFF
__global__ void __launch_bounds__(512) dbg_dump(unsigned char* ws, float* out) {
    const size_t NOUT = (size_t)T * D;
    for (size_t i = (size_t)blockIdx.x * 512 + threadIdx.x; i < NOUT; i += (size_t)gridDim.x * 512) {
        float a = 0.f;
        for (size_t j = i; j < (size_t)(DBG_DUMP_N); j += NOUT) a += (DBG_DUMP_KIND == 0) ? bf2f(((const bf16_t*)(ws + DBG_DUMP_OFF))[j]) : (DBG_DUMP_KIND == 1 ? ((const float*)(ws + DBG_DUMP_OFF))[j] : (DBG_DUMP_KIND == 2 ? (float)((const int*)(ws + DBG_DUMP_OFF))[j] : ((((const int*)(ws + DBG_DUMP_OFF))[j] < 0 || ((const int*)(ws + DBG_DUMP_OFF))[j] > 63) ? 1.0e6f : 0.0f)));
        if (DBG_DUMP_KIND == 4) { a = 0.f; if (i < (size_t)T * 8) { const int sl = ((const int*)(ws + WS_PSLOT))[i]; const int tk = (sl >= 0 && sl < NSLOT) ? ((const int*)(ws + WS_ROWTOK))[sl] : -7; a = (tk == (int)(i >> 3)) ? 0.f : 1.0e6f; } }
        if (DBG_DUMP_KIND == 5) { const int t = (int)(i >> 11), c = (int)(i & 2047); const bf16_t* Yp = (const bf16_t*)(ws + WS_Y); a = bf2f(Yp[(size_t)t * 2048 + c]);
            for (int k = 0; k < 8; ++k) { const int sl = ((const int*)(ws + WS_PSLOT))[t * 8 + k]; a += bf2f(Yp[(size_t)sl * 2048 + c]); } }
        if (DBG_DUMP_KIND == 6) { const int t = (int)(i >> 11), c = (int)(i & 2047); const bf16_t* Ap = (const bf16_t*)(ws + WS_ACT); a = 0.f; if (c < 256) { a = bf2f(Ap[(size_t)t * 256 + c]);
            for (int k = 0; k < 8; ++k) { const int sl = ((const int*)(ws + WS_PSLOT))[t * 8 + k]; a += bf2f(Ap[(size_t)sl * 256 + c]); } } }
        out[i] = a;
    }
}
#endif
extern "C" void kernel_launch(void* const* d_in, const int* in_sizes, int n_in, void* d_out, int out_size, void* d_ws, size_t ws_size, hipStream_t stream) {
    static int grid = 0;
    if (grid == 0) {
        if (n_in != 24 || out_size != T * D || ws_size < WS_END) { fprintf(stderr, "kernel_launch: unexpected shapes (n_in %d out %d ws %zu need %zu)\n", n_in, out_size, ws_size, (size_t)WS_END); grid = -1; return; }
        int dev = 0, cus = 0;
        if (hipGetDevice(&dev) != hipSuccess || hipDeviceGetAttribute(&cus, hipDeviceAttributeMultiprocessorCount, dev) != hipSuccess) { grid = -1; return; }
        if (hipFuncSetAttribute((const void*)mk_fwd, hipFuncAttributeMaxDynamicSharedMemorySize, LDS_BYTES) != hipSuccess) { fprintf(stderr, "kernel_launch: hipFuncSetAttribute failed\n"); grid = -1; return; }
        int per_cu = 0;
        if (hipOccupancyMaxActiveBlocksPerMultiprocessor(&per_cu, (const void*)mk_fwd, NTHREADS, LDS_BYTES) != hipSuccess || per_cu < 1) { fprintf(stderr, "kernel_launch: occupancy query says %d blocks per CU\n", per_cu); }
        (void)hipGetLastError();
        grid = cus;
    }
    if (grid < 0) return;
    (void)hipMemsetAsync((char*)d_ws + WS_ZERO, 0, ZERO_BYTES, stream);
    Args a; memset(&a, 0, sizeof(a));
    for (int i = 0; i < 24; ++i) a.in[i] = (const float*)d_in[i];
    a.out = (float*)d_out; a.ws = (unsigned char*)d_ws;
#if MK_MULTI
#ifdef DBG_DUMP_OFF
    for (int p = 0; p <= DBG_LAST; ++p) { a.ph_lo = p; a.ph_hi = p + 1; hipLaunchKernelGGL(mk_fwd, dim3(grid), dim3(NTHREADS), LDS_BYTES, stream, a); }
    hipLaunchKernelGGL(dbg_dump, dim3(1024), dim3(512), 0, stream, (unsigned char*)d_ws, (float*)d_out);
#else
    for (int p = 0; p < NPHASE; ++p) { a.ph_lo = p; a.ph_hi = p + 1; hipLaunchKernelGGL(mk_fwd, dim3(grid), dim3(NTHREADS), LDS_BYTES, stream, a); }
#endif
#else
    a.ph_lo = 0; a.ph_hi = NPHASE;
    hipLaunchKernelGGL(mk_fwd, dim3(grid), dim3(NTHREADS), LDS_BYTES, stream, a);
#endif
}
```

```cpp
#include <hip/hip_runtime.h>
#include <cstdio>
#include <cstdint>
#include <cstring>

#ifndef PROBE_EXTRA_BARRIERS
#define PROBE_EXTRA_BARRIERS 0
#endif
#ifndef PROBE_DOWN_NOSTORE
#define PROBE_DOWN_NOSTORE 0
#endif
#ifndef EXP_DUP_LDS
#define EXP_DUP_LDS 0
#endif
#ifndef EXP_DUP_QK
#define EXP_DUP_QK 0
#endif
#ifndef EXP_DUP_EXP
#define EXP_DUP_EXP 0
#endif
#ifndef ATT_STAGGER
#define ATT_STAGGER 0
#endif
#ifndef NT_STORES
#define NT_STORES 0
#endif
#ifndef DENSE_XCD
#define DENSE_XCD 0
#endif
#ifndef PROBE_SET
#define PROBE_SET 0
#endif
#define PRB(bit) _Pragma("unroll") for (int rep_ = 0; rep_ < (((PROBE_SET) >> (bit)) & 1) + 1; ++rep_)
#ifndef PROBE_REP_MLA
#define PROBE_REP_MLA 1
#endif
#ifndef MCV_BLOCKS
#define MCV_BLOCKS 32
#endif
#ifndef MK_MULTI
#define MK_MULTI 0
#endif

#define LAS __attribute__((address_space(3)))
typedef unsigned short bf16_t;
typedef short bf16x8 __attribute__((ext_vector_type(8)));
typedef short s16x4 __attribute__((ext_vector_type(4)));
typedef float f32x4 __attribute__((ext_vector_type(4)));
typedef float f32x16 __attribute__((ext_vector_type(16)));
typedef unsigned u32x4 __attribute__((ext_vector_type(4)));
typedef unsigned u32x2 __attribute__((ext_vector_type(2)));

constexpr int T = 16384, D = 2048;
constexpr int IN_DIM = 4424, IN_PAD = 4608;
constexpr int OFF_MQ = 0, OFF_MK = 512, OFF_MV = 1024, OFF_MO = 2048, OFF_MI = 3072, OFF_MF = 3076, OFF_CQ = 3080, OFF_CKV = 3848, OFF_KR = 4360;
constexpr int NE = 64, TOPK = 8, EFF = 256;
constexpr int NSLOT = T + T * TOPK + NE * 256;
constexpr int NCH = 256;
constexpr float EPS = 1e-6f;

constexpr size_t al256(size_t x) { return (x + 255) & ~(size_t)255; }
constexpr size_t WS_ZERO = 0;
constexpr size_t ZB_BAR = 0;
constexpr size_t ZB_MOD = 16384;
constexpr size_t ZB_CTR = 16384 + 98304;
constexpr size_t ZERO_BYTES = 16384 + 98304 + 16384;
constexpr size_t WS_ROPE = al256(WS_ZERO + ZERO_BYTES);
constexpr size_t WS_WIN = al256(WS_ROPE + (size_t)T * 32 * 8);
constexpr size_t WS_WUQ = al256(WS_WIN + (size_t)IN_PAD * 2048 * 2);
constexpr size_t WS_WUKV = al256(WS_WUQ + (size_t)1536 * 768 * 2);
constexpr size_t WS_WOUT = al256(WS_WUKV + (size_t)2048 * 512 * 2);
constexpr size_t WS_WQKV = al256(WS_WOUT + (size_t)2048 * 2048 * 2);
constexpr size_t WS_WO = al256(WS_WQKV + (size_t)2560 * 2048 * 2);
constexpr size_t WS_WR = al256(WS_WO + (size_t)2048 * 2048 * 2);
constexpr size_t WS_WGU = al256(WS_WR + (size_t)2 * 256 * 4096 * 2);
constexpr size_t WS_WDN = al256(WS_WGU + (size_t)2 * 65 * 512 * 2048 * 2);
constexpr size_t WS_HA = al256(WS_WDN + (size_t)2 * 65 * 2048 * 256 * 2);
constexpr size_t WS_H2 = al256(WS_HA + (size_t)T * 2048 * 2);
constexpr size_t WS_XA = al256(WS_H2 + (size_t)T * 4096 * 2);
constexpr size_t WS_XB = al256(WS_XA + (size_t)T * 2048 * 4);
constexpr size_t WS_HCAT = al256(WS_XB + (size_t)T * 2048 * 4);
constexpr size_t WS_GA = al256(WS_HCAT + (size_t)T * 2048 * 2);
constexpr size_t WS_GB = al256(WS_GA + (size_t)4 * T * 4);
constexpr size_t WS_GCM = al256(WS_GB + (size_t)4 * T * 4);
constexpr size_t WS_GST = al256(WS_GCM + (size_t)4 * T * 4);
constexpr size_t WS_DN = al256(WS_GST + 16384);
constexpr size_t WS_NST = al256(WS_DN + (size_t)NCH * 4 * 128 * 4);
constexpr size_t WS_LOGP = al256(WS_NST + (size_t)NCH * 4 * 128 * 4);
constexpr size_t WS_TKI = al256(WS_LOGP + (size_t)4 * T * 128 * 4);
constexpr size_t WS_TKW = al256(WS_TKI + (size_t)T * 8 * 4);
constexpr size_t WS_PSLOT = al256(WS_TKW + (size_t)T * 8 * 4);
constexpr size_t WS_HIST = al256(WS_PSLOT + (size_t)T * 8 * 4);
constexpr size_t WS_ETAB = al256(WS_HIST + (size_t)256 * 64 * 4);
constexpr size_t WS_ROWTOK = al256(WS_ETAB + 4096);
constexpr size_t WS_ACT = al256(WS_ROWTOK + (size_t)NSLOT * 4);
constexpr size_t WS_Y = al256(WS_ACT + (size_t)NSLOT * 256 * 2);
constexpr size_t WS_PROJ = WS_Y;
constexpr size_t WS_CQN = al256(WS_PROJ + (size_t)T * IN_PAD * 2);
constexpr size_t WS_CKVN = al256(WS_CQN + (size_t)T * 768 * 2);
constexpr size_t WS_KPE = al256(WS_CKVN + (size_t)T * 512 * 2);
constexpr size_t WS_QRAW = al256(WS_KPE + (size_t)T * 64 * 2);
constexpr size_t WS_KVRAW = al256(WS_QRAW + (size_t)T * 1536 * 2);
constexpr size_t WS_DC = al256(WS_KVRAW + (size_t)T * 2048 * 2);
constexpr size_t WS_CST = al256(WS_DC + (size_t)NCH * 4 * 256 * 128 * 2);
constexpr size_t WS_MIXEND = al256(WS_CST + (size_t)NCH * 4 * 256 * 128 * 2);
constexpr size_t WS_END = al256(WS_Y + (size_t)NSLOT * 2048 * 2);
static_assert(WS_MIXEND <= WS_END, "mixer temporaries must fit inside the Y region");

__device__ __forceinline__ unsigned cvt_pk_bf16(float lo, float hi) { unsigned r; asm volatile("v_cvt_pk_bf16_f32 %0, %1, %2" : "=v"(r) : "v"(lo), "v"(hi)); return r; }
__device__ __forceinline__ float bf2f(unsigned short h) { return __uint_as_float((unsigned)h << 16); }
__device__ __forceinline__ float bflo(unsigned w) { return __uint_as_float(w << 16); }
__device__ __forceinline__ float bfhi(unsigned w) { return __uint_as_float(w & 0xffff0000u); }
__device__ __forceinline__ bf16_t f2bf(float f) { return (bf16_t)(cvt_pk_bf16(f, f) & 0xffffu); }
template <int CTRL> __device__ __forceinline__ float dpp_add(float v) { return v + __int_as_float(__builtin_amdgcn_update_dpp(0, __float_as_int(v), CTRL, 0xF, 0xF, true)); }
__device__ __forceinline__ float wave_sum(float v) {
    v = dpp_add<0xB1>(v); v = dpp_add<0x4E>(v); v = dpp_add<0x141>(v); v = dpp_add<0x140>(v);
    v += __int_as_float(__builtin_amdgcn_ds_swizzle(__float_as_int(v), 0x401F));
    return __int_as_float(__builtin_amdgcn_readlane(__float_as_int(v), 0)) + __int_as_float(__builtin_amdgcn_readlane(__float_as_int(v), 32));
}
__device__ __forceinline__ float sigmoidf_(float x) { return 1.0f / (1.0f + __expf(-x)); }

#define XB_TMO      128
#define XB_XCNT(j)  (256  + 64 * (j))
#define XB_XSUB(j)  (1280 + 64 * (j))
#define XB_XGEN(j)  (2304 + 64 * (j))
#define XB_TOP      3328
#define XB_TOPGEN   3392
#define XCD_BAR_WORDS 3456
#define XB_SPIN_CAP (1u << 22)
__device__ __forceinline__ unsigned xb_ld(unsigned* p)              { return __hip_atomic_load(p, __ATOMIC_RELAXED, __HIP_MEMORY_SCOPE_AGENT); }
__device__ __forceinline__ unsigned xb_add(unsigned* p, unsigned v) { return __hip_atomic_fetch_add(p, v, __ATOMIC_RELAXED, __HIP_MEMORY_SCOPE_AGENT); }
__device__ __forceinline__ unsigned xb_xcc_id() { return (unsigned)__builtin_amdgcn_s_getreg((3 << 11) | 20) & 0xFu; }
#define XB_SPIN(cond, bar) do { unsigned _sp = 0; while (cond) { __builtin_amdgcn_s_sleep(1); \
    if ((++_sp & 255u) == 0u) { if (xb_ld(&(bar)[XB_TMO])) break; if (_sp > XB_SPIN_CAP) { atomicAdd(&(bar)[XB_TMO], 1u); break; } } } } while (0)
struct XcdBarrier { unsigned* bar; unsigned x; volatile LAS unsigned* st; };
__device__ __forceinline__ XcdBarrier xcd_barrier_post(unsigned* bar, volatile LAS unsigned* st) {
    XcdBarrier b; b.bar = bar; b.x = xb_xcc_id(); b.st = st;
    if (threadIdx.x == 0) (void)xb_add(&bar[XB_XCNT(b.x)], 1u);
    return b;
}
__device__ __forceinline__ void xcd_barrier_complete(unsigned* bar, unsigned x, unsigned& nloc, unsigned& nx) {
    const unsigned G = gridDim.x * gridDim.y * gridDim.z;
    unsigned sum, cnt, mine, sp = 0u;
    for (;;) {
        sum = 0u; cnt = 0u; mine = 0u;
#pragma unroll
        for (unsigned j = 0; j < 16; ++j) { const unsigned c = xb_ld(&bar[XB_XCNT(j)]); sum += c; cnt += (c > 0u) ? 1u : 0u; mine = (j == x) ? c : mine; }
        if (sum == G) break;
        __builtin_amdgcn_s_sleep(1);
        if ((++sp & 255u) == 0u) { if (xb_ld(&bar[XB_TMO])) break; if (sp > XB_SPIN_CAP) { atomicAdd(&bar[XB_TMO], 1u); break; } }
    }
    nloc = mine > 0u ? mine : 1u; nx = cnt > 0u ? cnt : 1u;
}
__device__ __forceinline__ void xcd_barrier(const XcdBarrier& b) {
    asm volatile("s_waitcnt vmcnt(0)" ::: "memory");
    __syncthreads();
    if (threadIdx.x == 0) {
        unsigned* bar = b.bar;
        __builtin_amdgcn_s_waitcnt(0);
        unsigned nloc = b.st[0], nx = b.st[1];
        if (nloc == 0u) { xcd_barrier_complete(bar, b.x, nloc, nx); b.st[0] = nloc; b.st[1] = nx; }
        const unsigned old = xb_add(&bar[XB_XSUB(b.x)], 1u);
        const unsigned gen = old / nloc;
        if (old + 1u == (gen + 1u) * nloc) {
            __builtin_amdgcn_fence(__ATOMIC_RELEASE, "agent");
            asm volatile("s_waitcnt vmcnt(0)" ::: "memory");
            const unsigned og = xb_add(&bar[XB_TOP], 1u);
            const unsigned tg = og / nx;
            if (og + 1u == (tg + 1u) * nx) xb_add(&bar[XB_TOPGEN], 1u);
            else XB_SPIN(xb_ld(&bar[XB_TOPGEN]) == tg, bar);
            __builtin_amdgcn_fence(__ATOMIC_ACQUIRE, "agent");
            xb_add(&bar[XB_XGEN(b.x)], 1u);
            asm volatile("s_waitcnt vmcnt(0)" ::: "memory");
        } else {
            XB_SPIN(xb_ld(&bar[XB_XGEN(b.x)]) == gen, bar);
            __builtin_amdgcn_fence(__ATOMIC_ACQUIRE, "agent");
            asm volatile("s_waitcnt vmcnt(0)" ::: "memory");
        }
    }
    __syncthreads();
}

struct Args {
    const float* in[24];
    float* out;
    unsigned char* ws;
    int ph_lo, ph_hi;
};
constexpr int NTHREADS = 512;
constexpr int LDS_MAIN = 131072, LDS_AUX = 16384;
constexpr int LDS_BYTES = LDS_MAIN + LDS_AUX + 16;

struct Frame {
    LAS unsigned char* lds;
    LAS unsigned char* aux;
    const float* const* in;
    float* out;
    unsigned char* ws;
    int tid, lane, wid, G, bid;
};
#define WSP(T_, off) ((T_*)(F.ws + (off)))

namespace pg8 {
constexpr int BM = 256, BK = 64, HALF = 128, HTB = HALF * BK * 2, STAGE_BYTES = 8 * HTB;
__device__ __forceinline__ int lds_byte(int r, int c) { const int st = (r >> 4) * 2 + (c >> 5), rr = r & 15, cc = c & 31, ob = rr * 64 + cc * 2; return st * 1024 + (ob ^ (((ob >> 9) & 1) << 5)); }
__device__ __forceinline__ void stage_rc(int b, int& R, int& C) { const int st = b / 1024, sb = b % 1024, swz = sb ^ (((sb >> 9) & 1) << 5); R = (st >> 1) * 16 + swz / 64; C = (st & 1) * 32 + (swz % 64) / 2; }
__device__ __forceinline__ int perm32(int rho) { const int n = rho >> 4, i = rho & 15; return 8 * (i >> 2) + 4 * n + (i & 3); }
struct Unit { int a, b, c, d; };

template <class P>
__device__ __forceinline__ void gemm_phase(LAS unsigned char* lds, const P& p) {
    const int tid = threadIdx.x, wid = __builtin_amdgcn_readfirstlane(tid >> 6), lane = tid & 63, wr = wid >> 2, wc = wid & 3, fr = lane & 15, fq = lane >> 4;
    const int K = p.K, nt = K / BK;
    const int G = p.stride(), c0 = p.first();
    const int NU = p.nunits();
    if (c0 >= NU) return;
    int R[2], C[2]; unsigned voffB[2][2];
#pragma unroll
    for (int i = 0; i < 2; ++i) { stage_rc(tid * 16 + i * 8192, R[i], C[i]); const int Rb = P::PERM ? ((R[i] & ~31) + perm32(R[i] & 31)) : R[i];
#pragma unroll
        for (int h = 0; h < 2; ++h) voffB[h][i] = (unsigned)((h * HALF + Rb) * p.ldb + C[i]) * 2u; }
    const size_t kstep = (size_t)(BK * 2);
    const unsigned ldsw = (unsigned)wid * 1024u;
    const int aoff = lds_byte(wr * 64 + fr, fq * 8), boff = lds_byte(wc * 32 + fr, fq * 8);
    const char* const Ab = p.abase();
#define PG8_SA(b, h) (((b) * 2 + (h)) * HTB)
#define PG8_SB(b, h) ((4 + (b) * 2 + (h)) * HTB)
#define PG8_STAGE(bufoff, gbase, o0, o1) do { \
        __builtin_amdgcn_global_load_lds((const unsigned*)((const char*)(gbase) + (o0)), (LAS unsigned*)(lds + (bufoff) + ldsw), 16, 0, 0); \
        __builtin_amdgcn_global_load_lds((const unsigned*)((const char*)(gbase) + (o1)), (LAS unsigned*)(lds + (bufoff) + ldsw + 8192), 16, 0, 0); } while (0)
#define PG8_LDA(dst, b, h) do { _Pragma("unroll") for (int m = 0; m < 4; ++m) _Pragma("unroll") for (int k = 0; k < 2; ++k) dst[m][k] = *(const LAS bf16x8*)(lds + PG8_SA(b, h) + aoff + m * 2048 + k * 1024); } while (0)
#define PG8_LDB(dst, b, h) do { _Pragma("unroll") for (int n = 0; n < 2; ++n) _Pragma("unroll") for (int k = 0; k < 2; ++k) dst[n][k] = *(const LAS bf16x8*)(lds + PG8_SB(b, h) + boff + n * 2048 + k * 1024); } while (0)
#define PG8_MMA(ai, bj, At, Bt) do { __builtin_amdgcn_s_setprio(1); _Pragma("unroll") for (int m = 0; m < 4; ++m) _Pragma("unroll") for (int n = 0; n < 2; ++n) _Pragma("unroll") for (int k = 0; k < 2; ++k) \
        acc[ai][bj][m][n] = __builtin_amdgcn_mfma_f32_16x16x32_bf16(Bt[n][k], At[m][k], acc[ai][bj][m][n], 0, 0, 0); __builtin_amdgcn_s_setprio(0); } while (0)
#define PG8_WAIT_V(n) asm volatile("s_waitcnt vmcnt(" #n ")" ::: "memory")
#define PG8_WAIT_L(n) asm volatile("s_waitcnt lgkmcnt(" #n ")" ::: "memory")
#define PG8_BAR __builtin_amdgcn_s_barrier()
#define PG8_SCHED __builtin_amdgcn_sched_barrier(0)
    Unit cur, nxt; int ui = 0;
    p.unit(c0, cur);
    unsigned aoc[2][2], aon[2][2];
    p.a_off(cur, R, C, aoc);
    f32x4 acc[2][2][4][2];
#pragma unroll
    for (int a = 0; a < 2; ++a)
#pragma unroll
        for (int b = 0; b < 2; ++b)
#pragma unroll
            for (int m = 0; m < 4; ++m)
#pragma unroll
                for (int n = 0; n < 2; ++n) acc[a][b][m][n] = (f32x4){0.f, 0.f, 0.f, 0.f};
    bf16x8 At[4][2], B0[2][2], B1[2][2];
    const char* cB = p.bbase(cur);
    PG8_STAGE(PG8_SB(0, 0), cB, voffB[0][0], voffB[0][1]); PG8_STAGE(PG8_SA(0, 0), Ab, aoc[0][0], aoc[0][1]);
    PG8_STAGE(PG8_SB(0, 1), cB, voffB[1][0], voffB[1][1]); PG8_STAGE(PG8_SA(0, 1), Ab, aoc[1][0], aoc[1][1]);
    if (wr == 1) PG8_BAR;
    PG8_WAIT_V(4); PG8_BAR;
    PG8_STAGE(PG8_SB(1, 0), cB + kstep, voffB[0][0], voffB[0][1]); PG8_STAGE(PG8_SA(1, 0), Ab + kstep, aoc[0][0], aoc[0][1]);
    PG8_STAGE(PG8_SB(1, 1), cB + kstep, voffB[1][0], voffB[1][1]);
    PG8_WAIT_V(6); PG8_BAR;
    for (;;) {
        const bool has_next = (c0 + (ui + 1) * G) < NU;
        if (has_next) { p.unit(c0 + (ui + 1) * G, nxt); p.a_off(nxt, R, C, aon); }
        else { nxt = cur;
#pragma unroll
            for (int h = 0; h < 2; ++h)
#pragma unroll
                for (int i = 0; i < 2; ++i) aon[h][i] = aoc[h][i]; }
        const char* nB = has_next ? p.bbase(nxt) : cB;
        for (int t = 0; t < nt; t += 2) {
            const bool last = (t == nt - 2);
            const char* a1 = Ab + (size_t)(t + 1) * kstep;
            const char* a2 = last ? Ab : Ab + (size_t)(t + 2) * kstep; const char* b2 = last ? nB : cB + (size_t)(t + 2) * kstep;
            const char* a3 = a2 + kstep; const char* b3 = b2 + kstep;
            unsigned ao2[2][2];
#pragma unroll
            for (int h = 0; h < 2; ++h)
#pragma unroll
                for (int i = 0; i < 2; ++i) ao2[h][i] = last ? aon[h][i] : aoc[h][i];
            PG8_LDB(B0, 0, 0); PG8_SCHED; PG8_LDA(At, 0, 0); PG8_STAGE(PG8_SA(1, 1), a1, aoc[1][0], aoc[1][1]);
            PG8_WAIT_L(8); PG8_BAR; PG8_WAIT_L(0); PG8_MMA(0, 0, At, B0); PG8_BAR; PG8_SCHED;
            PG8_LDB(B1, 0, 1); PG8_STAGE(PG8_SB(0, 0), b2, voffB[0][0], voffB[0][1]);
            PG8_BAR; PG8_WAIT_L(0); PG8_MMA(0, 1, At, B1); PG8_BAR;
            PG8_LDA(At, 0, 1); PG8_STAGE(PG8_SA(0, 0), a2, ao2[0][0], ao2[0][1]);
            PG8_BAR; PG8_WAIT_L(0); PG8_MMA(1, 0, At, B0); PG8_BAR; PG8_SCHED;
            PG8_STAGE(PG8_SB(0, 1), b2, voffB[1][0], voffB[1][1]);
            PG8_WAIT_V(6); PG8_BAR; PG8_MMA(1, 1, At, B1); PG8_BAR;
            PG8_LDB(B0, 1, 0); PG8_SCHED; PG8_LDA(At, 1, 0); PG8_STAGE(PG8_SA(0, 1), a2, ao2[1][0], ao2[1][1]);
            PG8_WAIT_L(8); PG8_BAR; PG8_WAIT_L(0); PG8_MMA(0, 0, At, B0); PG8_BAR; PG8_SCHED;
            PG8_LDB(B1, 1, 1); PG8_STAGE(PG8_SB(1, 0), b3, voffB[0][0], voffB[0][1]);
            PG8_BAR; PG8_WAIT_L(0); PG8_MMA(0, 1, At, B1); PG8_BAR;
            PG8_LDA(At, 1, 1); PG8_STAGE(PG8_SA(1, 0), a3, ao2[0][0], ao2[0][1]);
            PG8_BAR; PG8_WAIT_L(0); PG8_MMA(1, 0, At, B0); PG8_BAR; PG8_SCHED;
            PG8_STAGE(PG8_SB(1, 1), b3, voffB[1][0], voffB[1][1]);
            PG8_WAIT_V(6); PG8_BAR; PG8_MMA(1, 1, At, B1); PG8_BAR;
        }
        p.epi(acc, cur, wr, wc, fr, fq);
        if (!has_next) break;
#pragma unroll
        for (int a = 0; a < 2; ++a)
#pragma unroll
            for (int b = 0; b < 2; ++b)
#pragma unroll
                for (int m = 0; m < 4; ++m)
#pragma unroll
                    for (int n = 0; n < 2; ++n) acc[a][b][m][n] = (f32x4){0.f, 0.f, 0.f, 0.f};
        cur = nxt; cB = nB; ++ui;
#pragma unroll
        for (int h = 0; h < 2; ++h)
#pragma unroll
            for (int i = 0; i < 2; ++i) aoc[h][i] = aon[h][i];
    }
    PG8_WAIT_V(0);
    if (wr == 0) PG8_BAR;
    PG8_BAR;
#undef PG8_SA
#undef PG8_SB
#undef PG8_STAGE
#undef PG8_LDA
#undef PG8_LDB
#undef PG8_MMA
#undef PG8_WAIT_V
#undef PG8_WAIT_L
#undef PG8_BAR
#undef PG8_SCHED
}
}

__device__ __forceinline__ void adaln_sc(const Frame& F) {
    const float* c = F.in[1]; LAS float* sc = (LAS float*)F.lds;
    __syncthreads();
    for (int i = F.tid; i < 2048; i += NTHREADS) { const float cv = c[i]; sc[i] = cv / (1.0f + expf(-cv)); }
    __syncthreads();
}
__device__ __forceinline__ void adaln_unit(const Frame& F, int u) {
    const float* w_ada = F.in[3]; const float* b_ada = F.in[4];
    float* mod = WSP(float, WS_ZERO + ZB_MOD);
    const LAS float* sc = (const LAS float*)F.lds;
    LAS f32x4* part = (LAS f32x4*)(F.lds + 8192);
    const int cg = F.tid % 24, kg = F.tid / 24;
    const int l = u >> 7, col0 = (u & 127) * 96;
    if (F.tid < 504) {
        f32x4 acc = (f32x4){0.f, 0.f, 0.f, 0.f};
        const float* wp = w_ada + (size_t)l * 2048 * 12288 + col0 + cg * 4;
#pragma unroll 7
        for (int k = kg; k < 2048; k += 21) { const f32x4 w = *(const f32x4*)(wp + (size_t)k * 12288); acc += w * sc[k]; }
        part[kg * 24 + cg] = acc;
    }
    __syncthreads();
    if (F.tid < 96) { float s_ = 0.f; const LAS float* pf = (const LAS float*)part;
        for (int g = 0; g < 21; ++g) s_ += pf[g * 96 + F.tid];
        mod[(size_t)l * 12288 + col0 + F.tid] = s_ + b_ada[(size_t)l * 12288 + col0 + F.tid]; }
    __syncthreads();
}
__device__ __forceinline__ void ph_adaln(const Frame& F) {
    if (F.bid >= 128 && F.G >= 256) return;
    adaln_sc(F);
    for (int u = F.bid; u < 128; u += F.G) adaln_unit(F, u);
}

__device__ __forceinline__ void ph_rope_table(const Frame& F) {
    const int* pos = (const int*)F.in[2];
    float2* tab = WSP(float2, WS_ROPE);
    for (int idx = F.bid * NTHREADS + F.tid; idx < T * 32; idx += F.G * NTHREADS) {
        const int t = idx >> 5, i = idx & 31;
        const float inv_freq = (float)exp2(-(double)i * (13.287712379549449 / 32.0));
        const float ang = (float)pos[t] * inv_freq;
        const double rev = (double)ang * 0.15915494309189535;
        const float fr = (float)(rev - rint(rev));
        tab[idx] = make_float2(__builtin_amdgcn_cosf(fr), __builtin_amdgcn_sinf(fr));
    }
}

struct CvtJob { const float* src; bf16_t* dst; int K, Nsrc, Ndst, batch, mode, tiles_per_mat, tile0; size_t sbs, dbs; };
__device__ __forceinline__ void cvt_load(const Frame& F, const CvtJob& j, int lt, f32x4 (&v)[2][2]) {
    const int b = lt / j.tiles_per_mat, r = lt - b * j.tiles_per_mat;
    const int nkt = j.K / 128, ntile = r / nkt, kt = r - ntile * nkt;
    const float* src = j.src + (size_t)b * j.sbs;
    const int n4 = F.tid & 15, kp = F.tid >> 4;
    const int nd = ntile * 64 + n4 * 4;
    int scol; bool valid;
    if (j.mode == 1) { scol = ((nd >> 7) & 1) * 256 + (nd >> 8) * 128 + (nd & 127); valid = true; }
    else { scol = nd; valid = nd < j.Nsrc; }
#pragma unroll
    for (int jj = 0; jj < 2; ++jj)
#pragma unroll
        for (int e = 0; e < 2; ++e) { const int k = kt * 128 + jj * 64 + kp * 2 + e;
            v[jj][e] = valid ? __builtin_nontemporal_load((const f32x4*)(src + (size_t)k * j.Nsrc + scol)) : (f32x4){0.f, 0.f, 0.f, 0.f}; }
}
__device__ __forceinline__ void cvt_store(const Frame& F, const CvtJob& j, int lt, const f32x4 (&v)[2][2]) {
    const int b = lt / j.tiles_per_mat, r = lt - b * j.tiles_per_mat;
    const int nkt = j.K / 128, ntile = r / nkt, kt = r - ntile * nkt;
    bf16_t* dst = j.dst + (size_t)b * j.dbs;
    LAS unsigned* L = (LAS unsigned*)F.lds;
    const int n4 = F.tid & 15, kp = F.tid >> 4;
#pragma unroll
    for (int jj = 0; jj < 2; ++jj)
#pragma unroll
        for (int i = 0; i < 4; ++i) L[(n4 * 4 + i) * 65 + jj * 32 + kp] = cvt_pk_bf16(v[jj][0][i], v[jj][1][i]);
    __syncthreads();
    const int n = F.tid >> 3, ch = F.tid & 7;
    u32x4 o0, o1;
    o0.x = L[n * 65 + ch * 8 + 0]; o0.y = L[n * 65 + ch * 8 + 1]; o0.z = L[n * 65 + ch * 8 + 2]; o0.w = L[n * 65 + ch * 8 + 3];
    o1.x = L[n * 65 + ch * 8 + 4]; o1.y = L[n * 65 + ch * 8 + 5]; o1.z = L[n * 65 + ch * 8 + 6]; o1.w = L[n * 65 + ch * 8 + 7];
    bf16_t* dp = dst + (size_t)(ntile * 64 + n) * j.K + kt * 128 + ch * 16;
    *(u32x4*)dp = o0; *(u32x4*)(dp + 8) = o1;
    __syncthreads();
}
constexpr int NJOBS = 14;
__device__ __forceinline__ CvtJob make_job(const float* src, bf16_t* dst, int K, int Nsrc, int Ndst, int batch, int mode, size_t sbs, size_t dbs) {
    CvtJob j; j.src = src; j.dst = dst; j.K = K; j.Nsrc = Nsrc; j.Ndst = Ndst; j.batch = batch; j.mode = mode; j.sbs = sbs; j.dbs = dbs;
    j.tiles_per_mat = (K / 128) * (Ndst / 64); j.tile0 = 0; return j;
}
__device__ __forceinline__ void ph_convert(const Frame& F) {
    const bool split = F.G >= 256; const int VG = split ? F.G - 128 : F.G, vb_ = split ? F.bid - 128 : F.bid;
    int run = 0;
    if (vb_ >= 0) {
#define DO_JOB(J) do { const CvtJob jb = (J); const int nt_ = jb.tiles_per_mat * jb.batch; \
        int lt = (vb_ - (run % VG) + VG) % VG; f32x4 va[2][2], vb[2][2]; \
        if (lt < nt_) cvt_load(F, jb, lt, va); \
        for (; lt < nt_; lt += VG) { const int ltn = lt + VG; if (ltn < nt_) cvt_load(F, jb, ltn, vb); cvt_store(F, jb, lt, va); \
            _Pragma("unroll") for (int a_ = 0; a_ < 2; ++a_) _Pragma("unroll") for (int b_ = 0; b_ < 2; ++b_) va[a_][b_] = vb[a_][b_]; } \
        run += nt_; } while (0)
    DO_JOB(make_job(F.in[5], WSP(bf16_t, WS_WIN), 2048, IN_DIM, IN_PAD, 1, 0, 0, 0));
    DO_JOB(make_job(F.in[10], WSP(bf16_t, WS_WUQ), 768, 1536, 1536, 1, 0, 0, 0));
    DO_JOB(make_job(F.in[11], WSP(bf16_t, WS_WUKV), 512, 2048, 2048, 1, 0, 0, 0));
    DO_JOB(make_job(F.in[12], WSP(bf16_t, WS_WOUT), 2048, 2048, 2048, 1, 0, 0, 0));
#undef DO_JOB
    }
    bf16_t* wr = WSP(bf16_t, WS_WR);
    for (int idx = F.bid * NTHREADS + F.tid; idx < 2 * 256 * 2048; idx += F.G * NTHREADS) {
        const int l = idx >> 19, n = (idx >> 11) & 255, k = idx & 2047;
        bf16_t o = 0;
        if (n < 128) { const int e = n & 63;
            const float w = F.in[17][((size_t)l * 2048 + k) * 64 + e];
            const bf16_t hi = f2bf(w);
            o = (n < 64) ? hi : f2bf(w - bf2f(hi)); }
        wr[idx] = o;
    }
}

constexpr int MCV_CHUNK = 32;
constexpr int MCV_LAYER_TILES = 8192 + 128 + 4096 + 64;
constexpr int MCV_NMOE = 2 * MCV_LAYER_TILES / MCV_CHUNK;
constexpr int MCV_NCVT = MCV_NMOE + 20 + 16;
constexpr int MCV_NCHUNK = MCV_NCVT + 128;
__device__ __forceinline__ int grab(const Frame& F, unsigned* ctr) {
    LAS int* sl = (LAS int*)(F.aux + 16000);
    __syncthreads();
    if (F.tid == 0) *sl = (int)__hip_atomic_fetch_add(ctr, 1u, __ATOMIC_RELAXED, __HIP_MEMORY_SCOPE_AGENT);
    __syncthreads();
    return __builtin_amdgcn_readfirstlane(*sl);
}
__device__ __forceinline__ void moe_cvt_chunk(const Frame& F, int c) {
    if (c >= MCV_NCVT) { adaln_sc(F); adaln_unit(F, 128 + (c - MCV_NCVT)); return; }
    const int gt = c * MCV_CHUNK, l = gt / MCV_LAYER_TILES, r = gt - l * MCV_LAYER_TILES;
    CvtJob jb; int lt0;
    if (c >= MCV_NMOE + 20) { lt0 = (c - MCV_NMOE - 20) * MCV_CHUNK; jb = make_job(F.in[16], WSP(bf16_t, WS_WO), 2048, 2048, 2048, 1, 0, 0, 0); }
    else if (c >= MCV_NMOE) { lt0 = (c - MCV_NMOE) * MCV_CHUNK; jb = make_job(F.in[13], WSP(bf16_t, WS_WQKV), 2048, 2560, 2560, 1, 0, 0, 0); }
    else if (r < 8192) { lt0 = r; jb = make_job(F.in[19] + (size_t)l * 64 * 2048 * 512, WSP(bf16_t, WS_WGU) + (size_t)l * 65 * 512 * 2048, 2048, 512, 512, 64, 1, (size_t)2048 * 512, (size_t)512 * 2048); }
    else if (r < 8320) { lt0 = r - 8192; jb = make_job(F.in[21] + (size_t)l * 2048 * 512, WSP(bf16_t, WS_WGU) + ((size_t)l * 65 + 64) * 512 * 2048, 2048, 512, 512, 1, 1, 0, 0); }
    else if (r < 12416) { lt0 = r - 8320; jb = make_job(F.in[20] + (size_t)l * 64 * 256 * 2048, WSP(bf16_t, WS_WDN) + (size_t)l * 65 * 2048 * 256, 256, 2048, 2048, 64, 0, (size_t)256 * 2048, (size_t)2048 * 256); }
    else { lt0 = r - 12416; jb = make_job(F.in[22] + (size_t)l * 256 * 2048, WSP(bf16_t, WS_WDN) + ((size_t)l * 65 + 64) * 2048 * 256, 256, 2048, 2048, 1, 0, 0, 0); }
    f32x4 v0[2][2], v1[2][2], v2[2][2], v3[2][2];
    cvt_load(F, jb, lt0, v0); cvt_load(F, jb, lt0 + 1, v1); cvt_load(F, jb, lt0 + 2, v2);
#pragma unroll 1
    for (int i = 0; i < MCV_CHUNK; i += 4) {
        cvt_load(F, jb, lt0 + i + 3, v3); cvt_store(F, jb, lt0 + i, v0);
        if (i + 4 < MCV_CHUNK) cvt_load(F, jb, lt0 + i + 4, v0);
        cvt_store(F, jb, lt0 + i + 1, v1);
        if (i + 4 < MCV_CHUNK) cvt_load(F, jb, lt0 + i + 5, v1);
        cvt_store(F, jb, lt0 + i + 2, v2);
        if (i + 4 < MCV_CHUNK) cvt_load(F, jb, lt0 + i + 6, v2);
        cvt_store(F, jb, lt0 + i + 3, v3);
    }
}
__device__ __forceinline__ void moe_cvt_queue(const Frame& F) {
    unsigned* ctr = WSP(unsigned, WS_ZERO + ZB_CTR);
    for (;;) { const int c = grab(F, ctr); if (c >= MCV_NCHUNK) break; moe_cvt_chunk(F, c); }
}

template <int MODE>
__device__ __forceinline__ void ph_modulate(const Frame& F, const void* x, const float* shift, const float* scale, bf16_t* out) {
    f32x4 sc[8], sh[8];
#pragma unroll
    for (int j = 0; j < 8; ++j) { const int col = 4 * F.lane + 256 * j; sc[j] = *(const f32x4*)(scale + col) + 1.0f; sh[j] = *(const f32x4*)(shift + col); }
    for (int row = F.bid * 8 + F.wid; row < T; row += F.G * 8) {
        f32x4 v[8]; float ss = 0.f;
        if (MODE == 1) { u32x2 xw[8];
#pragma unroll
            for (int j = 0; j < 8; ++j) xw[j] = *(const u32x2*)((const bf16_t*)x + (size_t)row * D + 4 * F.lane + 256 * j);
#pragma unroll
            for (int j = 0; j < 8; ++j) v[j] = (f32x4){bflo(xw[j].x), bfhi(xw[j].x), bflo(xw[j].y), bfhi(xw[j].y)};
        }
#pragma unroll
        for (int j = 0; j < 8; ++j) { if (MODE == 0) v[j] = __builtin_nontemporal_load((const f32x4*)((const float*)x + (size_t)row * D + 4 * F.lane + 256 * j)); ss += v[j][0] * v[j][0] + v[j][1] * v[j][1] + v[j][2] * v[j][2] + v[j][3] * v[j][3]; }
        ss = wave_sum(ss);
        const float rstd = rsqrtf(ss * (1.0f / D) + EPS);
#pragma unroll
        for (int j = 0; j < 8; ++j) {
            const f32x4 h = (v[j] * rstd) * sc[j] + sh[j];
            const int col = 4 * F.lane + 256 * j;
            u32x2 hi; hi.x = cvt_pk_bf16(h[0], h[1]); hi.y = cvt_pk_bf16(h[2], h[3]);
            if (MODE == 0) { *(u32x2*)(out + (size_t)row * 2048 + col) = hi; }
            else {
                *(u32x2*)(out + (size_t)row * 2048 + col) = hi;
            }
        }
    }
}

typedef float f32x2_ __attribute__((ext_vector_type(2)));
template <int FINAL>
__device__ __forceinline__ void ph_combine(const Frame& F, const bf16_t* xold, const float* g, bf16_t* xnew, const float* shift, const float* scale, bf16_t* hout, float* fout) {
    const unsigned char* Y = WSP(unsigned char, WS_Y); const int* pslot = WSP(int, WS_PSLOT); const float* tkw = WSP(float, WS_TKW);
    for (int row = F.bid * 8 + F.wid; row < T; row += F.G * 8) {
        int sl[9]; float w[9];
#pragma unroll
        for (int k = 0; k < 8; ++k) { sl[k] = pslot[row * 8 + k]; w[k] = tkw[row * 8 + k] * (1.0f / 8.0f); }
        sl[8] = row; w[8] = 1.0f / 8.0f;
        float xn[2][16]; float ss = 0.f;
#pragma unroll
        for (int j = 0; j < 2; ++j) {
            const int col = 16 * F.lane + 1024 * j;
            float a[16];
#pragma unroll
            for (int e = 0; e < 16; ++e) a[e] = 0.f;
#pragma unroll
            for (int k = 0; k < 9; ++k) { const u32x4 y = __builtin_nontemporal_load((const u32x4*)(Y + (size_t)sl[k] * 2048 + col));
#pragma unroll
                for (int q = 0; q < 4; ++q) { const f32x2_ lo = __builtin_amdgcn_cvt_pk_f32_fp8((int)y[q], false), hi = __builtin_amdgcn_cvt_pk_f32_fp8((int)y[q], true);
                    a[4 * q + 0] += w[k] * lo[0]; a[4 * q + 1] += w[k] * lo[1]; a[4 * q + 2] += w[k] * hi[0]; a[4 * q + 3] += w[k] * hi[1]; } }
            const u32x4 xw0 = *(const u32x4*)(xold + (size_t)row * D + col), xw1 = *(const u32x4*)(xold + (size_t)row * D + col + 8);
            const unsigned xw[8] = {xw0.x, xw0.y, xw0.z, xw0.w, xw1.x, xw1.y, xw1.z, xw1.w};
#pragma unroll
            for (int q = 0; q < 4; ++q) { const f32x4 x0 = (f32x4){bflo(xw[2 * q]), bfhi(xw[2 * q]), bflo(xw[2 * q + 1]), bfhi(xw[2 * q + 1])}; const f32x4 g0 = *(const f32x4*)(g + col + 4 * q);
#pragma unroll
                for (int e = 0; e < 4; ++e) { const float v = x0[e] + g0[e] * a[4 * q + e]; xn[j][4 * q + e] = v; ss += v * v; } }
            if (!FINAL) { u32x4 o0, o1; o0.x = cvt_pk_bf16(xn[j][0], xn[j][1]); o0.y = cvt_pk_bf16(xn[j][2], xn[j][3]); o0.z = cvt_pk_bf16(xn[j][4], xn[j][5]); o0.w = cvt_pk_bf16(xn[j][6], xn[j][7]);
                o1.x = cvt_pk_bf16(xn[j][8], xn[j][9]); o1.y = cvt_pk_bf16(xn[j][10], xn[j][11]); o1.z = cvt_pk_bf16(xn[j][12], xn[j][13]); o1.w = cvt_pk_bf16(xn[j][14], xn[j][15]);
                *(u32x4*)(xnew + (size_t)row * D + col) = o0; *(u32x4*)(xnew + (size_t)row * D + col + 8) = o1; }
        }
        ss = wave_sum(ss);
        const float rstd = rsqrtf(ss * (1.0f / D) + EPS);
#pragma unroll
        for (int j = 0; j < 2; ++j) {
            const int col = 16 * F.lane + 1024 * j;
            float h[16];
#pragma unroll
            for (int q = 0; q < 4; ++q) { const f32x4 s0 = *(const f32x4*)(scale + col + 4 * q);
                if (FINAL) { f32x4 o0;
#pragma unroll
                    for (int e = 0; e < 4; ++e) o0[e] = xn[j][4 * q + e] * rstd * s0[e];
                    *(f32x4*)(fout + (size_t)row * D + col + 4 * q) = o0; }
                else { const f32x4 h0 = *(const f32x4*)(shift + col + 4 * q);
#pragma unroll
                    for (int e = 0; e < 4; ++e) h[4 * q + e] = xn[j][4 * q + e] * rstd * (1.0f + s0[e]) + h0[e]; } }
            if (!FINAL) { u32x4 o0, o1; o0.x = cvt_pk_bf16(h[0], h[1]); o0.y = cvt_pk_bf16(h[2], h[3]); o0.z = cvt_pk_bf16(h[4], h[5]); o0.w = cvt_pk_bf16(h[6], h[7]);
                o1.x = cvt_pk_bf16(h[8], h[9]); o1.y = cvt_pk_bf16(h[10], h[11]); o1.z = cvt_pk_bf16(h[12], h[13]); o1.w = cvt_pk_bf16(h[14], h[15]);
                *(u32x4*)(hout + (size_t)row * 2048 + col) = o0; *(u32x4*)(hout + (size_t)row * 2048 + col + 8) = o1; }
        }
    }
}

using pg8::Unit;
template <bool NT>
__device__ __forceinline__ void store_bf16_tile(const f32x4 (&acc)[2][2][4][2], bf16_t* O, int ldc, int row0, int col0, const float* bias, int bcol0, int wr, int wc, int fr, int fq) {
    const int r0 = row0 + wr * 64 + fr, c0 = col0 + wc * 32 + 8 * fq, bc0 = bcol0 + wc * 32 + 8 * fq;
    f32x4 bv[2][2];
#pragma unroll
    for (int bj = 0; bj < 2; ++bj)
#pragma unroll
        for (int n = 0; n < 2; ++n) bv[bj][n] = bias ? *(const f32x4*)(bias + bc0 + bj * 128 + 4 * n) : (f32x4){0.f, 0.f, 0.f, 0.f};
#pragma unroll
    for (int ai = 0; ai < 2; ++ai)
#pragma unroll
        for (int m = 0; m < 4; ++m) { bf16_t* rowp = O + (size_t)(r0 + ai * 128 + m * 16) * ldc + c0;
#pragma unroll
            for (int bj = 0; bj < 2; ++bj) { const f32x4 v0 = acc[ai][bj][m][0] + bv[bj][0], v1 = acc[ai][bj][m][1] + bv[bj][1];
                u32x4 w; w.x = cvt_pk_bf16(v0[0], v0[1]); w.y = cvt_pk_bf16(v0[2], v0[3]); w.z = cvt_pk_bf16(v1[0], v1[1]); w.w = cvt_pk_bf16(v1[2], v1[3]);
                if (NT) __builtin_nontemporal_store(w, (u32x4*)(rowp + bj * 128)); else *(u32x4*)(rowp + bj * 128) = w; } }
}

struct PolDenseBase {
    const bf16_t* A; const bf16_t* Bt; int lda, ldb, K, nM, nN;
    __device__ __forceinline__ int nunits() const { return nM * nN; }
    __device__ __forceinline__ int first() const { return blockIdx.x; }
    __device__ __forceinline__ int stride() const { return gridDim.x; }
    __device__ __forceinline__ void unit(int L, Unit& u) const {
#if DENSE_XCD
        const int nwg = nM * nN; int wgid = L;
        if ((gridDim.x & 7) == 0) { const int q = nwg / 8, r = nwg % 8, xcd = wgid % 8, off = wgid / 8; wgid = (xcd < r ? xcd * (q + 1) : r * (q + 1) + (xcd - r) * q) + off; }
        const int nig = 8 * nN, gid = wgid / nig, fm = gid * 8, gsz = (nM - fm) < 8 ? (nM - fm) : 8;
        u.a = fm + ((wgid % nig) % gsz); u.b = (wgid % nig) / gsz; u.c = 0; u.d = 0;
#else
        u.a = L / nN; u.b = L - u.a * nN; u.c = 0; u.d = 0;
#endif
    }
    __device__ __forceinline__ const char* abase() const { return (const char*)A; }
    __device__ __forceinline__ void a_off(const Unit& u, const int (&R)[2], const int (&C)[2], unsigned (&off)[2][2]) const {
#pragma unroll
        for (int h = 0; h < 2; ++h)
#pragma unroll
            for (int i = 0; i < 2; ++i) off[h][i] = (unsigned)((u.a * 256 + h * 128 + R[i]) * lda + C[i]) * 2u;
    }
    __device__ __forceinline__ const char* bbase(const Unit& u) const { return (const char*)(Bt + (size_t)u.b * 256 * ldb); }
};
struct PolBf16 : PolDenseBase {
    static constexpr bool PERM = true;
    bf16_t* O; int ldc; const float* bias;
    __device__ __forceinline__ void epi(const f32x4 (&acc)[2][2][4][2], const Unit& u, int wr, int wc, int fr, int fq) const {
        store_bf16_tile<false>(acc, O, ldc, u.a * 256, u.b * 256, bias, u.b * 256, wr, wc, fr, fq);
    }
};
template <bool XIN_BF16>
struct PolResid : PolDenseBase {
    static constexpr bool PERM = true;
    const void* xin; const float* g; bf16_t* xout;
    __device__ __forceinline__ void epi(const f32x4 (&acc)[2][2][4][2], const Unit& u, int wr, int wc, int fr, int fq) const {
        const int row0 = u.a * 256 + wr * 64 + fr, col0 = u.b * 256 + wc * 32 + 8 * fq;
        f32x4 gv[2][2];
#pragma unroll
        for (int bj = 0; bj < 2; ++bj)
#pragma unroll
            for (int n = 0; n < 2; ++n) gv[bj][n] = *(const f32x4*)(g + col0 + bj * 128 + n * 4);
#pragma unroll
        for (int ai = 0; ai < 2; ++ai)
#pragma unroll
            for (int mp = 0; mp < 2; ++mp) {
                f32x4 xi[2][2][2];
                if (XIN_BF16) {
                    u32x4 xw[2][2];
#pragma unroll
                    for (int mm = 0; mm < 2; ++mm) { const size_t ro = (size_t)(row0 + ai * 128 + (mp * 2 + mm) * 16) * D + col0;
#pragma unroll
                        for (int bj = 0; bj < 2; ++bj) xw[mm][bj] = *(const u32x4*)((const bf16_t*)xin + ro + bj * 128); }
                    __builtin_amdgcn_sched_barrier(0);
#pragma unroll
                    for (int mm = 0; mm < 2; ++mm)
#pragma unroll
                        for (int bj = 0; bj < 2; ++bj) { xi[mm][bj][0] = (f32x4){bflo(xw[mm][bj].x), bfhi(xw[mm][bj].x), bflo(xw[mm][bj].y), bfhi(xw[mm][bj].y)};
                            xi[mm][bj][1] = (f32x4){bflo(xw[mm][bj].z), bfhi(xw[mm][bj].z), bflo(xw[mm][bj].w), bfhi(xw[mm][bj].w)}; }
                } else {
#pragma unroll
                    for (int mm = 0; mm < 2; ++mm) { const size_t ro = (size_t)(row0 + ai * 128 + (mp * 2 + mm) * 16) * D + col0;
#pragma unroll
                        for (int bj = 0; bj < 2; ++bj)
#pragma unroll
                            for (int n = 0; n < 2; ++n) xi[mm][bj][n] = *(const f32x4*)((const float*)xin + ro + bj * 128 + n * 4); }
                    __builtin_amdgcn_sched_barrier(0);
                }
#pragma unroll
                for (int mm = 0; mm < 2; ++mm) { const size_t ro = (size_t)(row0 + ai * 128 + (mp * 2 + mm) * 16) * D + col0;
#pragma unroll
                    for (int bj = 0; bj < 2; ++bj) { const f32x4 v0 = xi[mm][bj][0] + gv[bj][0] * acc[ai][bj][mp * 2 + mm][0], v1 = xi[mm][bj][1] + gv[bj][1] * acc[ai][bj][mp * 2 + mm][1];
                        u32x4 w; w.x = cvt_pk_bf16(v0[0], v0[1]); w.y = cvt_pk_bf16(v0[2], v0[3]); w.z = cvt_pk_bf16(v1[0], v1[1]); w.w = cvt_pk_bf16(v1[2], v1[3]);
                        *(u32x4*)(xout + ro + bj * 128) = w; } }
                __builtin_amdgcn_sched_barrier(0);
            }
    }
};
struct PolRouter {
    static constexpr bool PERM = false;
    const bf16_t* A; const bf16_t* Bt; float* part; int K, ldb;
    __device__ __forceinline__ int nunits() const { return 64 * 4; }
    __device__ __forceinline__ int first() const { return blockIdx.x; }
    __device__ __forceinline__ int stride() const { return gridDim.x; }
    __device__ __forceinline__ void unit(int L, Unit& u) const { u.a = L >> 2; u.b = L & 3; u.c = 0; u.d = 0; }
    __device__ __forceinline__ const char* abase() const { return (const char*)A; }
    __device__ __forceinline__ void a_off(const Unit& u, const int (&R)[2], const int (&C)[2], unsigned (&off)[2][2]) const {
#pragma unroll
        for (int h = 0; h < 2; ++h)
#pragma unroll
            for (int i = 0; i < 2; ++i) off[h][i] = (unsigned)((u.a * 256 + h * 128 + R[i]) * 2048 + u.b * 512 + C[i]) * 2u;
    }
    __device__ __forceinline__ const char* bbase(const Unit& u) const { return (const char*)(Bt + (size_t)u.b * 512); }
    __device__ __forceinline__ void epi(const f32x4 (&acc)[2][2][4][2], const Unit& u, int wr, int wc, int fr, int fq) const {
        const int row0 = u.a * 256 + wr * 64 + fr, col0 = wc * 32 + 4 * fq;
        float* P = part + (size_t)u.b * T * 128;
#pragma unroll
        for (int ai = 0; ai < 2; ++ai)
#pragma unroll
            for (int m = 0; m < 4; ++m)
#pragma unroll
                for (int n = 0; n < 2; ++n) *(f32x4*)(P + (size_t)(row0 + ai * 128 + m * 16) * 128 + col0 + n * 16) = acc[ai][0][m][n];
    }
};
struct MoeTab { const LAS int* blk_e; const LAS int* blk_row0; int rb0, nrb, rank, nrank; };
__device__ __forceinline__ void moe_decode(const MoeTab& tb, int j, int NT, Unit& u) {
    const int rbl = j / NT, pn = j - rbl * NT, rb = tb.rb0 + rbl;
    u.a = tb.blk_row0[rb]; u.b = pn; u.c = tb.blk_e[rb]; u.d = 0;
}
struct PolGateUp {
    static constexpr bool PERM = true;
    const bf16_t* A; const bf16_t* W; const int* rowtok; bf16_t* act; MoeTab tb; int K, ldb; const LAS int* ridx;
    __device__ __forceinline__ int nunits() const { return tb.nrb * 2; }
    __device__ __forceinline__ int first() const { return tb.rank; }
    __device__ __forceinline__ int stride() const { return tb.nrank; }
    __device__ __forceinline__ void unit(int L, Unit& u) const { moe_decode(tb, L, 2, u); u.d = (L - tb.rank) / tb.nrank; }
    __device__ __forceinline__ const char* abase() const { return (const char*)A; }
    __device__ __forceinline__ void a_off(const Unit& u, const int (&R)[2], const int (&C)[2], unsigned (&off)[2][2]) const {
#pragma unroll
        for (int h = 0; h < 2; ++h)
#pragma unroll
            for (int i = 0; i < 2; ++i) { const int tok = (u.d < 8) ? ridx[u.d * 256 + h * 128 + R[i]] : rowtok[u.a + h * 128 + R[i]]; off[h][i] = (unsigned)(tok * 2048 + C[i]) * 2u; }
    }
    __device__ __forceinline__ const char* bbase(const Unit& u) const { return (const char*)(W + ((size_t)u.c * 512 + (size_t)u.b * 256) * 2048); }
    __device__ __forceinline__ void epi(const f32x4 (&acc)[2][2][4][2], const Unit& u, int wr, int wc, int fr, int fq) const {
        const int r0 = u.a + wr * 64 + fr, c0 = u.b * 128 + wc * 32 + 8 * fq;
#pragma unroll
        for (int ai = 0; ai < 2; ++ai)
#pragma unroll
            for (int m = 0; m < 4; ++m) {
                float o[8];
#pragma unroll
                for (int n = 0; n < 2; ++n)
#pragma unroll
                    for (int e = 0; e < 4; ++e) { const float gt = acc[ai][0][m][n][e], up = acc[ai][1][m][n][e]; o[n * 4 + e] = gt / (1.0f + __expf(-gt)) * up; }
                u32x4 w; w.x = cvt_pk_bf16(o[0], o[1]); w.y = cvt_pk_bf16(o[2], o[3]); w.z = cvt_pk_bf16(o[4], o[5]); w.w = cvt_pk_bf16(o[6], o[7]);
                *(u32x4*)(act + (size_t)(r0 + ai * 128 + m * 16) * 256 + c0) = w; }
    }
};
constexpr float Y_SCALE = 8.0f;
struct PolDown {
    static constexpr bool PERM = true;
    const bf16_t* A; const bf16_t* W; unsigned char* Y; MoeTab tb; int K, ldb; int nostore;
    __device__ __forceinline__ int nunits() const { return tb.nrb * 8; }
    __device__ __forceinline__ int first() const { return tb.rank; }
    __device__ __forceinline__ int stride() const { return tb.nrank; }
    __device__ __forceinline__ void unit(int L, Unit& u) const { moe_decode(tb, L, 8, u); }
    __device__ __forceinline__ const char* abase() const { return (const char*)A; }
    __device__ __forceinline__ void a_off(const Unit& u, const int (&R)[2], const int (&C)[2], unsigned (&off)[2][2]) const {
#pragma unroll
        for (int h = 0; h < 2; ++h)
#pragma unroll
            for (int i = 0; i < 2; ++i) off[h][i] = (unsigned)((u.a + h * 128 + R[i]) * 256 + C[i]) * 2u;
    }
    __device__ __forceinline__ const char* bbase(const Unit& u) const { return (const char*)(W + ((size_t)u.c * 2048 + (size_t)u.b * 256) * 256); }
    __device__ __forceinline__ void epi(const f32x4 (&acc)[2][2][4][2], const Unit& u, int wr, int wc, int fr, int fq) const {
        const int odd = fq & 1, pq = fq >> 1;
#pragma unroll
        for (int ai = 0; ai < 2; ++ai)
#pragma unroll
            for (int bj = 0; bj < 2; ++bj) {
                int D[4][2];
#pragma unroll
                for (int m = 0; m < 4; ++m)
#pragma unroll
                    for (int n = 0; n < 2; ++n) { const f32x4 v = acc[ai][bj][m][n] * Y_SCALE; int w_ = __builtin_amdgcn_cvt_pk_fp8_f32(v[0], v[1], 0, false); D[m][n] = __builtin_amdgcn_cvt_pk_fp8_f32(v[2], v[3], w_, true); }
#pragma unroll
                for (int pr = 0; pr < 2; ++pr) {
                    const int s0 = odd ? D[2 * pr][0] : D[2 * pr + 1][0], s1 = odd ? D[2 * pr][1] : D[2 * pr + 1][1];
                    const int r0 = __shfl_xor(s0, 16), r1 = __shfl_xor(s1, 16);
                    u32x4 w;
                    if (odd) { w.x = (unsigned)r0; w.y = (unsigned)r1; w.z = (unsigned)D[2 * pr + 1][0]; w.w = (unsigned)D[2 * pr + 1][1]; }
                    else { w.x = (unsigned)D[2 * pr][0]; w.y = (unsigned)D[2 * pr][1]; w.z = (unsigned)r0; w.w = (unsigned)r1; }
                    const int row = u.a + ai * 128 + wr * 64 + (2 * pr + odd) * 16 + fr, col = u.b * 256 + bj * 128 + wc * 32 + pq * 16;
                    if (!nostore) { if (NT_STORES) __builtin_nontemporal_store(w, (u32x4*)(Y + (size_t)row * 2048 + col)); else *(u32x4*)(Y + (size_t)row * 2048 + col) = w; } else asm volatile("" :: "v"(w));
                }
            }
    }
};


__device__ __forceinline__ void ph_route(const Frame& F, int layer) {
    const float* part = WSP(float, WS_LOGP); const float* rbias = F.in[18] + layer * 64;
    int* tki = WSP(int, WS_TKI); float* tkw = WSP(float, WS_TKW); int* hist = WSP(int, WS_HIST);
    LAS int* lh = (LAS int*)F.aux;
    const int lane = F.lane; const int g = lane >> 3;
    const float bia = rbias[lane];
    for (int tb = F.bid; tb < 256; tb += F.G) {
        if (F.tid < 64) lh[F.tid] = 0;
        __syncthreads();
        for (int ti = 0; ti < 8; ++ti) {
            const int t = tb * 64 + F.wid * 8 + ti;
            float logit = 0.f;
#pragma unroll
            for (int ks = 0; ks < 4; ++ks) { const float* pr = part + ((size_t)ks * T + t) * 128; logit += pr[lane] + pr[64 + lane]; }
            const float score = 1.0f / (1.0f + expf(-logit));
            const float biased = score + bia;
            float m1 = biased;
            m1 = fmaxf(m1, __shfl_xor(m1, 1)); m1 = fmaxf(m1, __shfl_xor(m1, 2)); m1 = fmaxf(m1, __shfl_xor(m1, 4));
            const unsigned long long eqm = __ballot(biased == m1);
            const unsigned long long gm = eqm & (0xFFull << (8 * g));
            const int first = __builtin_ctzll(gm);
            float v2 = (lane == first) ? -__builtin_inff() : biased;
            v2 = fmaxf(v2, __shfl_xor(v2, 1)); v2 = fmaxf(v2, __shfl_xor(v2, 2)); v2 = fmaxf(v2, __shfl_xor(v2, 4));
            const float gs = m1 + v2;
            int cnt = 0;
#pragma unroll
            for (int gg = 0; gg < 8; ++gg) { const float o = __shfl(gs, 8 * gg); cnt += ((o > gs) || (o == gs && gg < g)) ? 1 : 0; }
            const bool sel = cnt < 4;
            const float masked = sel ? biased : -__builtin_inff();
            int rank = 0;
#pragma unroll
            for (int l = 0; l < 64; ++l) { const float o = __int_as_float(__builtin_amdgcn_readlane(__float_as_int(masked), l)); rank += ((o > masked) || (o == masked && l < lane)) ? 1 : 0; }
            const bool chosen = sel && rank < 8;
            const float wsum = wave_sum(chosen ? score : 0.f);
            if (chosen) { tki[t * 8 + rank] = lane; tkw[t * 8 + rank] = score / wsum * 2.5f; (void)__hip_atomic_fetch_add(lh + lane, 1, __ATOMIC_RELAXED, __HIP_MEMORY_SCOPE_WORKGROUP); }
        }
        __syncthreads();
        if (F.tid < 64) hist[tb * 64 + F.tid] = lh[F.tid];
        __syncthreads();
    }
}

__device__ __forceinline__ void ph_dispatch(const Frame& F) {
    const int* hist = WSP(int, WS_HIST); const int* tki = WSP(int, WS_TKI);
    int* pslot = WSP(int, WS_PSLOT); int* rowtok = WSP(int, WS_ROWTOK); int* etab = WSP(int, WS_ETAB);
    LAS int* tot = (LAS int*)F.aux; LAS int* pre = tot + 64; LAS int* eoff = tot + 128; LAS int* cursor = tot + 192;
    for (int tb = F.bid; tb < 256; tb += F.G) {
        if (F.tid < 64) { int s = 0, p = 0; for (int b = 0; b < 256; ++b) { const int h = hist[b * 64 + F.tid]; s += h; p += (b < tb) ? h : 0; } tot[F.tid] = s; pre[F.tid] = p; }
        __syncthreads();
        if (F.tid == 0) { int off = T; for (int e = 0; e < 64; ++e) { eoff[e] = off; cursor[e] = off + pre[e]; off += (tot[e] + 255) & ~255; } }
        __syncthreads();
        if (tb == 0 && F.tid < 64) { etab[F.tid] = eoff[F.tid]; etab[64 + F.tid] = tot[F.tid]; }
        { const int t = tb * 64 + (F.tid >> 3), k = F.tid & 7; const int e = tki[t * 8 + k];
          LAS int* pe = tot + 256;
          pe[F.tid] = e;
          __syncthreads();
          int rnk = 0;
          for (int q = 0; q < F.tid; ++q) rnk += (pe[q] == e) ? 1 : 0;
          const int slot = cursor[e] + rnk; rowtok[slot] = t; pslot[t * 8 + k] = slot; }
        if (F.tid < 64) rowtok[tb * 64 + F.tid] = tb * 64 + F.tid;
        if (tb < 64) { const int e = tb; const int beg = eoff[e] + tot[e], end = eoff[e] + ((tot[e] + 255) & ~255); for (int s = beg + F.tid; s < end; s += NTHREADS) rowtok[s] = 0; }
        __syncthreads();
    }
}

__device__ __forceinline__ MoeTab moe_tables(const Frame& F) {
    const int* etab = WSP(int, WS_ETAB);
    LAS int* blk_e = (LAS int*)F.aux; LAS int* blk_row0 = blk_e + 640; LAS int* pre = blk_e + 1280;
    __syncthreads();
    if (F.tid < 64) { blk_e[F.tid] = 64; blk_row0[F.tid] = F.tid * 256; }
    if (F.tid == 0) { int p = 0; for (int e = 0; e < 64; ++e) { pre[e] = p; p += (etab[64 + e] + 255) >> 8; } pre[64] = p; }
    __syncthreads();
    if (F.tid < 64) { const int e = F.tid, nb = (etab[64 + e] + 255) >> 8, b0 = 64 + pre[e], r0 = etab[e]; for (int i = 0; i < nb; ++i) { blk_e[b0 + i] = e; blk_row0[b0 + i] = r0 + i * 256; } }
    __syncthreads();
    const int nblk = 64 + pre[64];
    const int ng = ((F.G & 7) == 0) ? 8 : 1, x = F.bid % ng;
    MoeTab tb; tb.blk_e = blk_e; tb.blk_row0 = blk_row0;
    tb.rb0 = (int)(((long)nblk * x) / ng); tb.nrb = (int)(((long)nblk * (x + 1)) / ng) - tb.rb0; tb.rank = F.bid / ng; tb.nrank = F.G / ng;
    return tb;
}

#define SBAR() __builtin_amdgcn_sched_barrier(0)
__device__ __forceinline__ int v_st(int k, int c) { const int kk = (k & ~0xC) | ((k & 4) << 1) | ((k & 8) >> 1); return ((kk >> 3) * 4 + (c >> 5)) * 512 + ((kk & 7) * 32 + (c & 31)) * 2; }
__device__ __forceinline__ int v_rd_base(int lane) { return ((lane & 3) << 3) | (((lane >> 2) & 3) << 6) | (((lane >> 4) & 1) << 5) | (((lane >> 5) & 1) << 8); }
constexpr int v_rd_off(int d0, int ks, int half) { return d0 * 512 + ks * 4096 + half * 2048; }
__device__ __forceinline__ int crow(int r, int hi) { return (r & 3) + 8 * (r >> 2) + 4 * hi; }
template <int OFF> __device__ __forceinline__ s16x4 trrd(int base) { s16x4 d; asm volatile("ds_read_b64_tr_b16 %0, %1 offset:%2" : "=&v"(d) : "v"(base), "i"(OFF) : "memory"); return d; }
#define LGKM0() asm volatile("s_waitcnt lgkmcnt(0)" ::: "memory")
#define ROPE2(W0, W1, CS, O0, O1) do { const float a0 = bflo(W0), a1 = bfhi(W0), b0_ = bflo(W1), b1_ = bfhi(W1); \
    O0 = cvt_pk_bf16(a0 * CS[0] - b0_ * CS[1], a1 * CS[2] - b1_ * CS[3]); O1 = cvt_pk_bf16(b0_ * CS[0] + a0 * CS[1], b1_ * CS[2] + a1 * CS[3]); } while (0)
__device__ __forceinline__ bf16x8 cat44(s16x4 l, s16x4 h) { return (bf16x8){l[0], l[1], l[2], l[3], h[0], h[1], h[2], h[3]}; }

__device__ __forceinline__ void mask_tile(f32x16& p0, f32x16& p1, int dq, unsigned W) {
    const float NEG = -__builtin_inff();
#pragma unroll
    for (int r = 0; r < 16; ++r) {
        const int c = (r & 3) + 8 * (r >> 2);
        if ((unsigned)(dq - c) >= W) p0[r] = NEG;
        if ((unsigned)(dq - c - 32) >= W) p1[r] = NEG;
    }
}
__device__ __forceinline__ float softmax_tile(f32x16& p0, f32x16& p1, float& m_reg, float& l_reg, float C2, bf16x8& pa0, bf16x8& pa1, bf16x8& pa2, bf16x8& pa3) {
    float pmax = p0[0];
#pragma unroll
    for (int r = 1; r < 16; ++r) pmax = fmaxf(pmax, p0[r]);
#pragma unroll
    for (int r = 0; r < 16; ++r) pmax = fmaxf(pmax, p1[r]);
    { auto rr = __builtin_amdgcn_permlane32_swap(__float_as_uint(pmax), __float_as_uint(pmax), false, false);
      pmax = fmaxf(__uint_as_float(rr[0]), __uint_as_float(rr[1])); }
    float mn, alpha;
    if (__all((pmax - m_reg) * C2 <= 11.5f)) { mn = m_reg; alpha = 1.f; }
    else { mn = fmaxf(m_reg, pmax); alpha = __builtin_amdgcn_exp2f((m_reg - mn) * C2); m_reg = mn; }
    const float mnL = -mn * C2;
    float ps = 0.f;
#pragma unroll
    for (int r = 0; r < 16; ++r) { p0[r] = __builtin_amdgcn_exp2f(fmaf(p0[r], C2, mnL)); ps += p0[r]; }
#pragma unroll
    for (int r = 0; r < 16; ++r) { p1[r] = __builtin_amdgcn_exp2f(fmaf(p1[r], C2, mnL)); ps += p1[r]; }
    { auto rr = __builtin_amdgcn_permlane32_swap(__float_as_uint(ps), __float_as_uint(ps), false, false);
      ps = __uint_as_float(rr[0]) + __uint_as_float(rr[1]); }
    l_reg = l_reg * alpha + ps;
#define PK4(P, B_, OUT) do { unsigned a0 = cvt_pk_bf16(P[B_+0], P[B_+1]), a1 = cvt_pk_bf16(P[B_+2], P[B_+3]);                          \
        unsigned b0 = cvt_pk_bf16(P[B_+4], P[B_+5]), b1 = cvt_pk_bf16(P[B_+6], P[B_+7]);                                             \
        auto r0 = __builtin_amdgcn_permlane32_swap(a0, b0, false, false); auto r1 = __builtin_amdgcn_permlane32_swap(a1, b1, false, false); \
        u32x4 w = {r0[0], r1[0], r0[1], r1[1]}; OUT = *reinterpret_cast<bf16x8*>(&w); } while (0)
    PK4(p0, 0, pa0); PK4(p0, 8, pa1); PK4(p1, 0, pa2); PK4(p1, 8, pa3);
    return alpha;
}
template <int VOFF, int ND0, int KG = 2048>
__device__ __forceinline__ void pv_tile(f32x16* o, int vb, bf16x8 pa0, bf16x8 pa1, bf16x8 pa2, bf16x8 pa3) {
#define PV_D0(d0) do { s16x4 l0, l1, l2, l3, h0, h1, h2, h3; constexpr int b_ = VOFF + d0 * 512; \
        l0 = trrd<b_>(vb); h0 = trrd<b_ + KG>(vb); l1 = trrd<b_ + 2 * KG>(vb); h1 = trrd<b_ + 3 * KG>(vb); l2 = trrd<b_ + 4 * KG>(vb); h2 = trrd<b_ + 5 * KG>(vb); l3 = trrd<b_ + 6 * KG>(vb); h3 = trrd<b_ + 7 * KG>(vb); \
        LGKM0(); SBAR(); \
        o[d0] = __builtin_amdgcn_mfma_f32_32x32x16_bf16(pa0, cat44(l0, h0), o[d0], 0, 0, 0); \
        o[d0] = __builtin_amdgcn_mfma_f32_32x32x16_bf16(pa1, cat44(l1, h1), o[d0], 0, 0, 0); \
        o[d0] = __builtin_amdgcn_mfma_f32_32x32x16_bf16(pa2, cat44(l2, h2), o[d0], 0, 0, 0); \
        o[d0] = __builtin_amdgcn_mfma_f32_32x32x16_bf16(pa3, cat44(l3, h3), o[d0], 0, 0, 0); } while (0)
    PV_D0(0); PV_D0(1);
    if (ND0 > 2) { PV_D0(2); PV_D0(3); }
#undef PV_D0
}

template <int DQK, int DV, int D2>
struct AttnBlk {
    static constexpr int RB = DQK * 2, KBYTES = 64 * RB, VBYTES = 16384, KOFF = 0, VOFF = 2 * KBYTES, SOFF = VOFF + 3 * VBYTES;
    static constexpr int NC = DQK / 16, ND0 = DV / 32, KPIECES = 64 * DQK / 8, KPT = KPIECES / NTHREADS, VPIECES = 64 * DV / 8, VPT = (VPIECES + NTHREADS - 1) / NTHREADS, PPR = DQK / 8, VPR = DV / 8;
    const bf16_t* Q; int ldq; const bf16_t* K1; int ldk1; const bf16_t* K2; int ldk2; const bf16_t* V; int ldv; bf16_t* O; int ldo;
    float C2; float m_init; float l_init; unsigned W;
    int wrow; int wq; int wo; const float* sinks; float sink_scale; const float2* ropeq;

    struct StageOffs { unsigned ko[KPT]; unsigned vo[1]; };
    __device__ __forceinline__ void stage_setup(StageOffs& so_, int tid) const {
#pragma unroll
        for (int i = 0; i < KPT; ++i) { const int p = tid + NTHREADS * i, row = p / PPR, sp = p - row * PPR;
            const int pc = (sp & ~7) | ((sp ^ (row >> 1)) & 7);
            const bool k1 = (D2 == 0 || pc < (DQK - D2) / 8);
            so_.ko[i] = k1 ? (unsigned)(row * ldk1 + pc * 8) * 2u : ((unsigned)(row * ldk2 + (pc - (DQK - D2) / 8) * 8) * 2u) | 0x80000000u; }
        { const int p = tid;
            const int off = p * 16, sub = off >> 9, g8 = sub >> 2, cblk = sub & 3, rem = (off & 511) >> 1, kkl = rem >> 5, cl = rem & 31;
            const int kk = g8 * 8 + kkl, k = (kk & ~0xC) | ((kk & 4) << 1) | ((kk & 8) >> 1), c = cblk * 32 + cl;
            so_.vo[0] = (unsigned)(k * ldv + c) * 2u; }
    }
    __device__ __forceinline__ void stage_tile(LAS unsigned char* lds, int kbuf, int vbuf, int kb, const StageOffs& so_, int tid, int wid) const {
        const char* kb1 = (const char*)(K1 + (size_t)kb * ldk1); const char* kb2 = (const char*)(K2 + (size_t)kb * ldk2); const char* vbp = (const char*)(V + (size_t)kb * ldv);
#pragma unroll
        for (int i = 0; i < KPT; ++i) {
            const unsigned o_ = so_.ko[i]; LAS unsigned* dst_ = (LAS unsigned*)(lds + KOFF + kbuf * KBYTES + (NTHREADS * i + 64 * wid) * 16);
            if (D2 == 0 || !(o_ >> 31)) __builtin_amdgcn_global_load_lds((const unsigned*)(kb1 + o_), dst_, 16, 0, 0);
            else __builtin_amdgcn_global_load_lds((const unsigned*)(kb2 + (o_ & 0x7fffffffu)), dst_, 16, 0, 0); }
#pragma unroll
        for (int i = 0; i < VPT; ++i) { const int p = tid + NTHREADS * i;
            if (VPIECES >= NTHREADS * (i + 1) || p < VPIECES)
                __builtin_amdgcn_global_load_lds((const unsigned*)(vbp + (size_t)i * 32 * ldv * 2 + so_.vo[0]), (LAS unsigned*)(lds + VOFF + vbuf * VBYTES + (NTHREADS * i + 64 * wid) * 16), 16, 0, 0); }
    }
    __device__ __forceinline__ void run(LAS unsigned char* lds, int P0, int j_lo, int j_hi) const {
        const int tid = threadIdx.x, wid = __builtin_amdgcn_readfirstlane(tid >> 6), lane = tid & 63, r32 = lane & 31, hi = lane >> 5;
        const int qlo = P0 + wid * 32, qm = qlo + r32 - 4 * hi;
        const bool grpB = ATT_STAGGER && wid >= 4;
        LAS float* ws = (LAS float*)(lds + SOFF) + wid * 64; LAS float* li_l = ws; LAS float* al_l = ws + 32;
        bf16x8 qr[NC];
#pragma unroll
        for (int c = 0; c < NC; ++c) qr[c] = *(const bf16x8*)(Q + (size_t)(qlo + r32) * ldq + c * 16 + hi * 8);
        if (NC == 12 && ropeq) {
            const float2* rp = ropeq + (size_t)(qlo + r32) * 32 + hi * 8;
#pragma unroll
            for (int cc = 0; cc < 2; ++cc) {
                const f32x4* cs = (const f32x4*)(rp + cc * 16);
                const f32x4 c0 = cs[0], c1 = cs[1], c2 = cs[2], c3 = cs[3];
                const u32x4 a = __builtin_bit_cast(u32x4, qr[(NC == 12 ? 8 : 0) + cc]), b = __builtin_bit_cast(u32x4, qr[(NC == 12 ? 10 : 0) + cc]);
                u32x4 ra, rb_;
                ROPE2(a.x, b.x, c0, ra.x, rb_.x); ROPE2(a.y, b.y, c1, ra.y, rb_.y); ROPE2(a.z, b.z, c2, ra.z, rb_.z); ROPE2(a.w, b.w, c3, ra.w, rb_.w);
                qr[(NC == 12 ? 8 : 0) + cc] = __builtin_bit_cast(bf16x8, ra); qr[(NC == 12 ? 10 : 0) + cc] = __builtin_bit_cast(bf16x8, rb_);
            }
        }
        float m_reg = m_init, l_reg = l_init; f32x16 o[ND0];
#pragma unroll
        for (int d = 0; d < ND0; ++d) o[d] = f32x16{};
        const int vb0 = (int)(uintptr_t)(lds + VOFF) + v_rd_base(lane);
        const LAS unsigned char* kb4[4];
#pragma unroll
        for (int cl = 0; cl < 4; ++cl) kb4[cl] = lds + KOFF + r32 * RB + ((cl * 32 + hi * 16) ^ (((r32 >> 1) & 7) << 4));
        f32x16 p0, p1; bf16x8 pa0, pa1, pa2, pa3; float alpha = 1.f;
#define ATT_QK(kbuf_) do { \
            _Pragma("unroll") for (int g = 0; g < NC / 4; ++g) { bf16x8 b0[4], b1[4]; \
                _Pragma("unroll") for (int cl = 0; cl < 4; ++cl) { b0[cl] = *(const LAS bf16x8*)(kb4[cl] + (kbuf_) * KBYTES + g * 128); b1[cl] = *(const LAS bf16x8*)(kb4[cl] + (kbuf_) * KBYTES + g * 128 + 32 * RB); } \
                SBAR(); \
                _Pragma("unroll") for (int cl = 0; cl < 4; ++cl) { \
                    if (g == 0 && cl == 0) { p0 = __builtin_amdgcn_mfma_f32_32x32x16_bf16(b0[cl], qr[0], (f32x16){0.f,0.f,0.f,0.f,0.f,0.f,0.f,0.f,0.f,0.f,0.f,0.f,0.f,0.f,0.f,0.f}, 0, 0, 0); \
                                             p1 = __builtin_amdgcn_mfma_f32_32x32x16_bf16(b1[cl], qr[0], (f32x16){0.f,0.f,0.f,0.f,0.f,0.f,0.f,0.f,0.f,0.f,0.f,0.f,0.f,0.f,0.f,0.f}, 0, 0, 0); } \
                    else { p0 = __builtin_amdgcn_mfma_f32_32x32x16_bf16(b0[cl], qr[g * 4 + cl], p0, 0, 0, 0); \
                           p1 = __builtin_amdgcn_mfma_f32_32x32x16_bf16(b1[cl], qr[g * 4 + cl], p1, 0, 0, 0); } } \
                SBAR(); } } while (0)
#define ATT_SM(kb_) do { if ((kb_) + 63 > qlo || (kb_) + (int)W <= qlo + 31) mask_tile(p0, p1, qm - (kb_), W); \
            alpha = softmax_tile(p0, p1, m_reg, l_reg, C2, pa0, pa1, pa2, pa3); } while (0)
#define ATT_PV(vbuf_) do { if (__any(alpha < 1.f)) { if (hi == 0) al_l[r32] = alpha; LGKM0(); \
                _Pragma("unroll") for (int d = 0; d < ND0; ++d) _Pragma("unroll") for (int r = 0; r < 16; ++r) o[d][r] *= al_l[crow(r, hi)]; } \
            if ((vbuf_) == 0) pv_tile<0, ND0>(o, vb0, pa0, pa1, pa2, pa3); else if ((vbuf_) == 1) pv_tile<VBYTES, ND0>(o, vb0, pa0, pa1, pa2, pa3); else pv_tile<2 * VBYTES, ND0>(o, vb0, pa0, pa1, pa2, pa3); } while (0)
        __syncthreads();
        StageOffs SO; stage_setup(SO, tid);
        stage_tile(lds, 0, 0, j_lo * 64, SO, tid, wid);
        asm volatile("s_waitcnt vmcnt(0)" ::: "memory");
        __syncthreads();
        const int NT = j_hi - j_lo;
#if ATT_STAGGER
        {
        int vcur = 0;
        for (int t = 0; t < NT; ++t) {
            const int kbuf = t & 1, kb = (j_lo + t) * 64;
            const int vnext = (vcur == 2) ? 0 : vcur + 1;
            if (t + 1 < NT) stage_tile(lds, kbuf ^ 1, vnext, kb + 64, SO, tid, wid);
            ATT_QK(kbuf); ATT_SM(kb);
            if (grpB) { asm volatile("s_waitcnt vmcnt(0)" ::: "memory"); __syncthreads(); }
            ATT_PV(vcur);
            if (!grpB) { asm volatile("s_waitcnt vmcnt(0)" ::: "memory"); __syncthreads(); }
            vcur = vnext;
        } }
#else
        for (int t = 0; t < NT; ++t) {
            const int kbuf = t & 1, kb = (j_lo + t) * 64;
            if (t + 1 < NT) stage_tile(lds, kbuf ^ 1, kbuf ^ 1, kb + 64, SO, tid, wid);
            ATT_QK(kbuf); ATT_SM(kb);
            if (__any(alpha < 1.f)) { if (hi == 0) al_l[r32] = alpha; LGKM0();
#pragma unroll
                for (int d = 0; d < ND0; ++d)
#pragma unroll
                    for (int r = 0; r < 16; ++r) o[d][r] *= al_l[crow(r, hi)]; }
            if (kbuf == 0) pv_tile<0, ND0>(o, vb0, pa0, pa1, pa2, pa3); else pv_tile<VBYTES, ND0>(o, vb0, pa0, pa1, pa2, pa3);
            asm volatile("s_waitcnt vmcnt(0)" ::: "memory");
            __syncthreads();
        }
#endif
#undef ATT_QK
#undef ATT_SM
#undef ATT_PV
        if (hi == 0) li_l[r32] = l_reg; LGKM0();
        int hi_o = hi, r32_o = r32; asm volatile("" : "+v"(hi_o), "+v"(r32_o));
        bf16_t* Ow = O + (size_t)qlo * ldo;
#pragma unroll
        for (int r = 0; r < 16; ++r) { const int orow = crow(r, hi_o); const float rl = 1.0f / li_l[orow];
#pragma unroll
            for (int d = 0; d < ND0; ++d) { const float v = o[d][r] * rl; const float vn = __shfl_xor(v, 1);
                if ((r32_o & 1) == 0) *(unsigned*)(Ow + (size_t)orow * ldo + d * 32 + r32_o) = cvt_pk_bf16(v, vn); } }
    }
};

__device__ __forceinline__ int v_st64(int k, int c) { const int kk = (k & ~0xC) | ((k & 4) << 1) | ((k & 8) >> 1); return ((kk >> 3) * 2 + (c >> 5)) * 512 + ((kk & 7) * 32 + (c & 31)) * 2; }
__device__ __forceinline__ void ph_swa(const Frame& F) {
    const bf16_t* qkv = WSP(bf16_t, WS_PROJ); bf16_t* hcat = WSP(bf16_t, WS_HCAT); const float* sinks = F.in[15];
    LAS unsigned char* lds = F.lds;
    constexpr int KT = 8192, VT = 8192, VBASE = 6 * KT, SCR = VBASE + 6 * VT;
    const int tid = F.tid, wid = F.wid, lane = F.lane, r32 = lane & 31, hi = lane >> 5;
    const float C2 = 0.125f * 1.4426950408889634f;
    LAS float* ws = (LAS float*)(lds + SCR) + wid * 64; LAS float* li_l = ws; LAS float* al_l = ws + 32;
    const LAS unsigned char* kb4[4];
#pragma unroll
    for (int cl = 0; cl < 4; ++cl) kb4[cl] = lds + r32 * 128 + ((cl * 32 + hi * 16) ^ (((r32 >> 1) & 7) << 4));
    const int vbase = (int)(uintptr_t)(lds + VBASE) + v_rd_base(lane);
    for (int U = F.bid; U < 256; U += F.G) {
        const int hkv = U & 3, P0 = (U >> 2) * 256;
        const int tile0 = (P0 >> 6) - 2 < 0 ? 0 : (P0 >> 6) - 2, ntl = (P0 >> 6) + 4 - tile0;
        __syncthreads();
        { int tq = tid; asm volatile("" : "+v"(tq));
          const float2* rope = WSP(float2, WS_ROPE);
#pragma unroll
          for (int i = 0; i < 3; ++i) { const int q = tq + NTHREADS * i, key = q >> 2, pc = q & 3;
              if (key < ntl * 64) { const int tl = key >> 6, row = key & 63; const int kabs = tile0 * 64 + key; const size_t g = (size_t)kabs * 2560;
                  const u32x4 k0 = *(const u32x4*)(qkv + g + 2048 + 64 * hkv + pc * 8), k1 = *(const u32x4*)(qkv + g + 2048 + 64 * hkv + 32 + pc * 8);
                  const u32x4 v0 = *(const u32x4*)(qkv + g + 2304 + 64 * hkv + pc * 8), v1 = *(const u32x4*)(qkv + g + 2304 + 64 * hkv + 32 + pc * 8);
                  const f32x4 c0 = *(const f32x4*)(rope + (size_t)kabs * 32 + pc * 8), c1 = *(const f32x4*)(rope + (size_t)kabs * 32 + pc * 8 + 2), c2 = *(const f32x4*)(rope + (size_t)kabs * 32 + pc * 8 + 4), c3 = *(const f32x4*)(rope + (size_t)kabs * 32 + pc * 8 + 6);
                  u32x4 r0, r1;
                  ROPE2(k0.x, k1.x, c0, r0.x, r1.x); ROPE2(k0.y, k1.y, c1, r0.y, r1.y); ROPE2(k0.z, k1.z, c2, r0.z, r1.z); ROPE2(k0.w, k1.w, c3, r0.w, r1.w);
                  *(LAS u32x4*)(lds + tl * KT + row * 128 + ((pc * 16) ^ (((row >> 1) & 7) << 4))) = r0;
                  *(LAS u32x4*)(lds + tl * KT + row * 128 + (((pc + 4) * 16) ^ (((row >> 1) & 7) << 4))) = r1;
                  *(LAS u32x4*)(lds + VBASE + tl * VT + v_st64(row, pc * 8)) = v0;
                  *(LAS u32x4*)(lds + VBASE + tl * VT + v_st64(row, 32 + pc * 8)) = v1; } } }
        __syncthreads();
        const int hq = hkv * 8 + wid;
        const float m0 = sinks[hq] * 8.0f;
        const float2* rope = WSP(float2, WS_ROPE);
        u32x4 qn[4]; f32x4 cn[2][4];
#define SWA_LDQ(rb_) do { const int ql_ = P0 + 32 * (rb_); \
            _Pragma("unroll") for (int c = 0; c < 4; ++c) qn[c] = *(const u32x4*)(qkv + (size_t)(ql_ + r32) * 2560 + 64 * hq + c * 16 + hi * 8); \
            _Pragma("unroll") for (int c = 0; c < 2; ++c) { const f32x4* cs = (const f32x4*)(rope + (size_t)(ql_ + r32) * 32 + 16 * c + 8 * hi); cn[c][0] = cs[0]; cn[c][1] = cs[1]; cn[c][2] = cs[2]; cn[c][3] = cs[3]; } } while (0)
        SWA_LDQ(0);
        for (int rb = 0; rb < 8; ++rb) {
            const int qlo = P0 + 32 * rb, qm = qlo + r32 - 4 * hi;
            bf16x8 qr[4];
            {
#pragma unroll
              for (int c = 0; c < 2; ++c) { const u32x4 a = qn[c], b = qn[c + 2]; u32x4 ra, rb_;
                  ROPE2(a.x, b.x, cn[c][0], ra.x, rb_.x); ROPE2(a.y, b.y, cn[c][1], ra.y, rb_.y); ROPE2(a.z, b.z, cn[c][2], ra.z, rb_.z); ROPE2(a.w, b.w, cn[c][3], ra.w, rb_.w);
                  qr[c] = *reinterpret_cast<bf16x8*>(&ra); qr[c + 2] = *reinterpret_cast<bf16x8*>(&rb_); } }
            __builtin_amdgcn_sched_barrier(0);
            if (rb + 1 < 8) SWA_LDQ(rb + 1);
            __builtin_amdgcn_sched_barrier(0);
            float m_reg = m0, l_reg = 1.f; f32x16 o[2] = {f32x16{}, f32x16{}};
            const int tlo = (qlo - 127 < 0) ? 0 : (qlo - 127) >> 6, thi = (qlo + 31) >> 6;
            for (int tile = tlo; tile <= thi; ++tile) {
                const int lt = tile - tile0, kb = tile * 64;
                f32x16 p0 = f32x16{}, p1 = f32x16{};
                { bf16x8 b0[4], b1[4];
#pragma unroll
                  for (int cl = 0; cl < 4; ++cl) { b0[cl] = *(const LAS bf16x8*)(kb4[cl] + lt * KT); b1[cl] = *(const LAS bf16x8*)(kb4[cl] + lt * KT + 32 * 128); }
#pragma unroll
                  for (int cl = 0; cl < 4; ++cl) { p0 = __builtin_amdgcn_mfma_f32_32x32x16_bf16(b0[cl], qr[cl], p0, 0, 0, 0); p1 = __builtin_amdgcn_mfma_f32_32x32x16_bf16(b1[cl], qr[cl], p1, 0, 0, 0); } }
                mask_tile(p0, p1, qm - kb, 128u);
                bf16x8 pa0, pa1, pa2, pa3;
                const float alpha = softmax_tile(p0, p1, m_reg, l_reg, C2, pa0, pa1, pa2, pa3);
                if (__any(alpha < 1.f)) { if (hi == 0) al_l[r32] = alpha; LGKM0();
#pragma unroll
                    for (int d = 0; d < 2; ++d)
#pragma unroll
                        for (int r = 0; r < 16; ++r) o[d][r] *= al_l[crow(r, hi)]; }
                pv_tile<0, 2, 1024>(o, vbase + lt * VT, pa0, pa1, pa2, pa3);
            }
            if (hi == 0) li_l[r32] = l_reg; LGKM0();
            int hi_o = hi, r32_o = r32; asm volatile("" : "+v"(hi_o), "+v"(r32_o));
            bf16_t* Ow = hcat + (size_t)qlo * 2048 + 64 * hq;
#pragma unroll
            for (int r = 0; r < 16; ++r) { const int orow = crow(r, hi_o); const float rl = 1.0f / li_l[orow];
#pragma unroll
                for (int d = 0; d < 2; ++d) { const float v = o[d][r] * rl; const float vn = __shfl_xor(v, 1);
                    if ((r32_o & 1) == 0) *(unsigned*)(Ow + (size_t)orow * 2048 + d * 32 + r32_o) = cvt_pk_bf16(v, vn); } }
        }
    }
    __syncthreads();
}

__device__ __forceinline__ void ph_mla_prep(const Frame& F) {
    const bf16_t* proj = WSP(bf16_t, WS_PROJ); const float* qn = F.in[8]; const float* kvn = F.in[9];
    bf16_t* cqn = WSP(bf16_t, WS_CQN); bf16_t* ckvn = WSP(bf16_t, WS_CKVN); bf16_t* kpe = WSP(bf16_t, WS_KPE); const float2* rope = WSP(float2, WS_ROPE);
    const int lane = F.lane;
    for (int t = F.bid * 8 + F.wid; t < T; t += F.G * 8) {
        const bf16_t* pr = proj + (size_t)t * IN_PAD;
        { float v[3][4]; float ss = 0.f;
#pragma unroll
          for (int j = 0; j < 3; ++j) { const u32x2 w = *(const u32x2*)(pr + OFF_CQ + 4 * lane + 256 * j); v[j][0] = bflo(w.x); v[j][1] = bfhi(w.x); v[j][2] = bflo(w.y); v[j][3] = bfhi(w.y);
              ss += v[j][0] * v[j][0] + v[j][1] * v[j][1] + v[j][2] * v[j][2] + v[j][3] * v[j][3]; }
          ss = wave_sum(ss); const float rstd = rsqrtf(ss * (1.0f / 768.0f) + EPS);
#pragma unroll
          for (int j = 0; j < 3; ++j) { const int col = 4 * lane + 256 * j; const f32x4 g = *(const f32x4*)(qn + col);
              u32x2 o; o.x = cvt_pk_bf16(v[j][0] * rstd * g[0], v[j][1] * rstd * g[1]); o.y = cvt_pk_bf16(v[j][2] * rstd * g[2], v[j][3] * rstd * g[3]);
              *(u32x2*)(cqn + (size_t)t * 768 + col) = o; } }
        { float v[2][4]; float ss = 0.f;
#pragma unroll
          for (int j = 0; j < 2; ++j) { const u32x2 w = *(const u32x2*)(pr + OFF_CKV + 4 * lane + 256 * j); v[j][0] = bflo(w.x); v[j][1] = bfhi(w.x); v[j][2] = bflo(w.y); v[j][3] = bfhi(w.y);
              ss += v[j][0] * v[j][0] + v[j][1] * v[j][1] + v[j][2] * v[j][2] + v[j][3] * v[j][3]; }
          ss = wave_sum(ss); const float rstd = rsqrtf(ss * (1.0f / 512.0f) + EPS);
#pragma unroll
          for (int j = 0; j < 2; ++j) { const int col = 4 * lane + 256 * j; const f32x4 g = *(const f32x4*)(kvn + col);
              u32x2 o; o.x = cvt_pk_bf16(v[j][0] * rstd * g[0], v[j][1] * rstd * g[1]); o.y = cvt_pk_bf16(v[j][2] * rstd * g[2], v[j][3] * rstd * g[3]);
              *(u32x2*)(ckvn + (size_t)t * 512 + col) = o; } }
        if (lane < 32) { const float x1 = bf2f(pr[OFF_KR + lane]), x2 = bf2f(pr[OFF_KR + 32 + lane]); const float2 cs = rope[t * 32 + lane];
            kpe[(size_t)t * 64 + lane] = f2bf(x1 * cs.x - x2 * cs.y); kpe[(size_t)t * 64 + 32 + lane] = f2bf(x2 * cs.x + x1 * cs.y); }
    }
}

__device__ __forceinline__ void ph_gates(const Frame& F) {
    const bf16_t* proj = WSP(bf16_t, WS_PROJ); const float* bif = F.in[6];
    float* GA = WSP(float, WS_GA); float* GB = WSP(float, WS_GB); float* GCM = WSP(float, WS_GCM); float* GST = WSP(float, WS_GST);
    const int lane = F.lane;
    for (int u = F.bid * 8 + F.wid; u < NCH * 4; u += F.G * 8) {
        const int c = u >> 2, h = u & 3, t = c * 64 + lane;
        const float ipre = bf2f(proj[(size_t)t * IN_PAD + OFF_MI + h]) + bif[h], fpre = bf2f(proj[(size_t)t * IN_PAD + OFF_MF + h]) + bif[4 + h];
        const float ig = 15.0f * tanhf(ipre * (1.0f / 15.0f)); const float z = 15.0f * tanhf(fpre * (1.0f / 15.0f));
        const float lf = (z >= 0.f) ? -log1pf(expf(-z)) : z - log1pf(expf(z));
        float b = lf;
#pragma unroll
        for (int o = 1; o < 64; o <<= 1) { const float v = __shfl_up(b, o); if (lane >= o) b += v; }
        const float a = ig - b;
        float cm = a;
#pragma unroll
        for (int o = 1; o < 64; o <<= 1) { const float v = __shfl_up(cm, o); if (lane >= o) cm = fmaxf(cm, v); }
        GA[h * T + t] = a; GB[h * T + t] = b; GCM[h * T + t] = cm;
        if (lane == 63) { GST[h * 256 + c] = cm; GST[1024 + h * 256 + c] = b; }
    }
}

__device__ __forceinline__ void m_scan(const Frame& F, LAS float* mst) {
    float* GST = WSP(float, WS_GST);
    LAS float* tmp = mst + 4 * 257 + 3;
    __syncthreads();
    for (int i = F.tid; i < 2048; i += NTHREADS) tmp[i] = GST[i];
    __syncthreads();
    if (F.tid < 4) { const int h = F.tid; float m = 0.f; mst[h * 257] = 0.f;
        for (int c = 0; c < 256; ++c) { m = tmp[1024 + h * 256 + c] + fmaxf(m, tmp[h * 256 + c]); mst[h * 257 + c + 1] = m; } }
    __syncthreads();
    if (F.bid == 0) for (int i = F.tid; i < 4 * 257; i += NTHREADS) GST[2048 + i] = mst[i];
}

__device__ __forceinline__ void ph_rope_q(const Frame& F) {
    const float2* rope = WSP(float2, WS_ROPE); bf16_t* qraw = WSP(bf16_t, WS_QRAW);
    for (int idx = F.bid * NTHREADS + F.tid; idx < T * 32; idx += F.G * NTHREADS) {
        const int t = idx >> 5, hh = (idx >> 2) & 7, pc = idx & 3;
        bf16_t* p = qraw + (size_t)t * 1536 + hh * 192 + 128 + pc * 8;
        const u32x4 a = *(const u32x4*)p, b = *(const u32x4*)(p + 32);
        const f32x4* cs = (const f32x4*)(rope + (size_t)t * 32 + pc * 8);
        const f32x4 c0 = cs[0], c1 = cs[1], c2 = cs[2], c3 = cs[3];
        u32x4 ra, rb_;
        ROPE2(a.x, b.x, c0, ra.x, rb_.x); ROPE2(a.y, b.y, c1, ra.y, rb_.y); ROPE2(a.z, b.z, c2, ra.z, rb_.z); ROPE2(a.w, b.w, c3, ra.w, rb_.w);
        *(u32x4*)p = ra; *(u32x4*)(p + 32) = rb_;
    }
}

#define TRF(dst, base, TOFF, d0, ks) do { const s16x4 l_ = trrd<(TOFF) + v_rd_off(d0, ks, 0)>(base); const s16x4 h_ = trrd<(TOFF) + v_rd_off(d0, ks, 1)>(base); LGKM0(); dst = cat44(l_, h_); } while (0)
__device__ __forceinline__ void ph_mlstm_B(const Frame& F, const LAS float* mst) {
    const bf16_t* proj = WSP(bf16_t, WS_PROJ); const float* GA = WSP(float, WS_GA); const float* GST = WSP(float, WS_GST);
    bf16_t* dC = WSP(bf16_t, WS_DC); float* DN = WSP(float, WS_DN);
    LAS unsigned char* lds = F.lds;
    const int tid = F.tid, lane = F.lane, w = F.wid, r32 = lane & 31, hi = lane >> 5;
    const int lbase = (int)(uintptr_t)lds + v_rd_base(lane);
    for (int u = F.bid; u < NCH * 4; u += F.G) {
        const int c = u >> 2, h = u & 3, t0 = c * 64;
        const float mx = fmaxf(mst[h * 257 + c], GST[h * 256 + c]);
        __syncthreads();
#pragma unroll
        for (int i = 0; i < 2; ++i) { const int q = tid + NTHREADS * i, s = q >> 4, dc = (q & 15) * 8;
            const u32x4 raw = *(const u32x4*)(proj + (size_t)(t0 + s) * IN_PAD + OFF_MK + h * 128 + dc);
            const float wsc = expf(GA[h * T + t0 + s] - mx) * 0.08838834764831845f;
            u32x4 o; o.x = cvt_pk_bf16(bflo(raw.x) * wsc, bfhi(raw.x) * wsc); o.y = cvt_pk_bf16(bflo(raw.y) * wsc, bfhi(raw.y) * wsc);
            o.z = cvt_pk_bf16(bflo(raw.z) * wsc, bfhi(raw.z) * wsc); o.w = cvt_pk_bf16(bflo(raw.w) * wsc, bfhi(raw.w) * wsc);
            *(LAS u32x4*)(lds + v_st(s, dc)) = o; }
#pragma unroll
        for (int i = 0; i < 4; ++i) { const int q = tid + NTHREADS * i, s = q >> 5, vc = (q & 31) * 8;
            const u32x4 raw = *(const u32x4*)(proj + (size_t)(t0 + s) * IN_PAD + OFF_MV + h * 256 + vc);
            *(LAS u32x4*)(lds + 16384 + (vc >> 7) * 16384 + v_st(s, vc & 127)) = raw; }
        __syncthreads();
        bf16x8 Bf[4];
        {
            const int vb = lbase + 16384 + (w >> 2) * 16384 + (w & 3) * 512;
            TRF(Bf[0], vb, 0, 0, 0); TRF(Bf[1], vb, 0, 0, 1); TRF(Bf[2], vb, 0, 0, 2); TRF(Bf[3], vb, 0, 0, 3);
        }
        f32x16 acc[4];
#define MB_STEP(mb) do { bf16x8 a0, a1, a2, a3; TRF(a0, lbase, 0, mb, 0); TRF(a1, lbase, 0, mb, 1); TRF(a2, lbase, 0, mb, 2); TRF(a3, lbase, 0, mb, 3); \
        f32x16 z = f32x16{}; z = __builtin_amdgcn_mfma_f32_32x32x16_bf16(a0, Bf[0], z, 0, 0, 0); z = __builtin_amdgcn_mfma_f32_32x32x16_bf16(a1, Bf[1], z, 0, 0, 0); \
        z = __builtin_amdgcn_mfma_f32_32x32x16_bf16(a2, Bf[2], z, 0, 0, 0); z = __builtin_amdgcn_mfma_f32_32x32x16_bf16(a3, Bf[3], z, 0, 0, 0); acc[mb] = z; } while (0)
        MB_STEP(0); MB_STEP(1); MB_STEP(2); MB_STEP(3);
#undef MB_STEP
        bf16_t* outp = dC + ((size_t)u * 256 + w * 32 + r32) * 128;
#pragma unroll
        for (int mb = 0; mb < 4; ++mb)
#pragma unroll
            for (int rq = 0; rq < 4; ++rq) { u32x2 o; o.x = cvt_pk_bf16(acc[mb][4 * rq + 0], acc[mb][4 * rq + 1]); o.y = cvt_pk_bf16(acc[mb][4 * rq + 2], acc[mb][4 * rq + 3]);
                *(u32x2*)(outp + mb * 32 + 8 * rq + 4 * hi) = o; }
        if (tid < 128) { float s_ = 0.f; const int d = tid;
            for (int s = 0; s < 64; ++s) s_ += bf2f(*(const LAS bf16_t*)(lds + v_st(s, d & ~7) + (d & 7) * 2));
            DN[(size_t)u * 128 + d] = s_; }
    }
    __syncthreads();
}

__device__ __forceinline__ void mlstm_C_item(const Frame& F, int item) {
    const float* GST = WSP(float, WS_GST);
    const bf16_t* dC = WSP(bf16_t, WS_DC); bf16_t* Cst = WSP(bf16_t, WS_CST); const float* DN = WSP(float, WS_DN); float* NST = WSP(float, WS_NST);
    LAS float* dec = (LAS float*)F.aux;
    __syncthreads();
    for (int i = F.tid; i < 1024; i += NTHREADS) { const int h = i >> 8, c = i & 255; const float m = GST[2048 + h * 257 + c]; dec[i] = expf(m - fmaxf(m, GST[h * 256 + c])); }
    __syncthreads();
    if (item < 64) {
        const int it = item * 512 + F.tid;
        const int h = it >> 13, rem = it & 8191;
        const size_t off0 = (size_t)h * 256 * 128 + (size_t)rem * 4;
        float s0 = 0.f, s1 = 0.f, s2 = 0.f, s3 = 0.f;
        u32x2 buf[16];
#pragma unroll
        for (int j = 0; j < 16; ++j) buf[j] = __builtin_nontemporal_load((const u32x2*)(dC + (size_t)j * 131072 + off0));
        for (int cb = 0; cb < 256; cb += 16) {
            u32x2 nb[16];
            if (cb + 16 < 256) {
#pragma unroll
                for (int j = 0; j < 16; ++j) nb[j] = __builtin_nontemporal_load((const u32x2*)(dC + (size_t)(cb + 16 + j) * 131072 + off0));
            }
#pragma unroll
            for (int j = 0; j < 16; ++j) {
                const unsigned long long o = (unsigned long long)cvt_pk_bf16(s0, s1) | ((unsigned long long)cvt_pk_bf16(s2, s3) << 32);
                __hip_atomic_store((unsigned long long*)(Cst + (size_t)(cb + j) * 131072 + off0), o, __ATOMIC_RELAXED, __HIP_MEMORY_SCOPE_AGENT);
                const float d = dec[h * 256 + cb + j];
                s0 = d * s0 + bflo(buf[j].x); s1 = d * s1 + bfhi(buf[j].x); s2 = d * s2 + bflo(buf[j].y); s3 = d * s3 + bfhi(buf[j].y);
            }
            if (cb + 16 < 256) {
#pragma unroll
                for (int j = 0; j < 16; ++j) buf[j] = nb[j];
            }
        }
    } else {
        const int it = F.tid; const int h = it >> 7;
        float s = 0.f;
#pragma unroll 16
        for (int c = 0; c < 256; ++c) { __hip_atomic_store((unsigned*)&NST[(size_t)c * 512 + it], __float_as_uint(s), __ATOMIC_RELAXED, __HIP_MEMORY_SCOPE_AGENT); s = dec[h * 256 + c] * s + DN[(size_t)c * 512 + it]; }
    }
}

__device__ __forceinline__ void ph_mlstm_D(const Frame& F) {
    const bf16_t* proj = WSP(bf16_t, WS_PROJ); const float* GA = WSP(float, WS_GA); const float* GB = WSP(float, WS_GB); const float* GCM = WSP(float, WS_GCM);
    const float* GST = WSP(float, WS_GST); const bf16_t* Cst = WSP(bf16_t, WS_CST); const float* NST = WSP(float, WS_NST);
    const float* gain = F.in[7]; bf16_t* hcat = WSP(bf16_t, WS_HCAT);
    const int tid = F.tid, lane = F.lane, r32 = lane & 31, hi = lane >> 5;
    const int hb = F.wid >> 2, wl = F.wid & 3, rh = wl & 1, vh = wl >> 1, htid = tid & 255;
    LAS unsigned char* hl = F.lds + hb * 40960;
    LAS float* a_l = (LAS float*)(hl + 32768); LAS float* n_l = (LAS float*)(hl + 33024); LAS float* rowss = (LAS float*)(hl + 33536);
    LAS float* scr = (LAS float*)(hl + 34048 + wl * 256);
    for (int pi = F.bid; pi < NCH * 2; pi += F.G) {
        const int u = pi * 2 + hb, c = u >> 2, h = u & 3, t0 = c * 64;
        __syncthreads();
        { u32x4 raw[8];
#pragma unroll
          for (int i = 0; i < 8; ++i) { const int q = htid + 256 * i, s = q >> 5, vc = (q & 31) * 8;
              raw[i] = *(const u32x4*)(proj + (size_t)(t0 + s) * IN_PAD + OFF_MV + h * 256 + vc); }
          SBAR();
#pragma unroll
          for (int i = 0; i < 8; ++i) { const int q = htid + 256 * i, s = q >> 5, vc = (q & 31) * 8;
              *(LAS u32x4*)(hl + (vc >> 7) * 16384 + v_st(s, vc & 127)) = raw[i]; } }
        if (htid < 64) a_l[htid] = GA[h * T + t0 + htid];
        if (htid < 128) n_l[htid] = NST[(size_t)u * 128 + htid];
        __syncthreads();
        const int j = 32 * rh + r32, t = t0 + j;
        const float m_c = GST[2048 + h * 257 + c];
        const float M_j = fmaxf(m_c, GCM[h * T + t]), b_j = GB[h * T + t];
        bf16x8 qr[8];
#pragma unroll
        for (int cc = 0; cc < 8; ++cc) qr[cc] = *(const bf16x8*)(proj + (size_t)t * IN_PAD + OFF_MQ + h * 128 + cc * 16 + hi * 8);
        f32x16 p0 = f32x16{}, p1 = f32x16{};
#pragma unroll
        for (int cc = 0; cc < 8; ++cc) {
            const bf16x8 k0 = *(const bf16x8*)(proj + (size_t)(t0 + r32) * IN_PAD + OFF_MK + h * 128 + cc * 16 + hi * 8);
            const bf16x8 k1 = *(const bf16x8*)(proj + (size_t)(t0 + 32 + r32) * IN_PAD + OFF_MK + h * 128 + cc * 16 + hi * 8);
            p0 = __builtin_amdgcn_mfma_f32_32x32x16_bf16(k0, qr[cc], p0, 0, 0, 0);
            p1 = __builtin_amdgcn_mfma_f32_32x32x16_bf16(k1, qr[cc], p1, 0, 0, 0);
        }
        float dsum = 0.f;
#pragma unroll
        for (int r = 0; r < 16; ++r) {
            const int s0 = crow(r, hi), s1 = 32 + s0;
            const float e0 = __expf(fminf(a_l[s0] - M_j, 0.f)) * 0.08838834764831845f, e1 = __expf(fminf(a_l[s1] - M_j, 0.f)) * 0.08838834764831845f;
            const float w0 = (s0 <= j) ? e0 : 0.f, w1 = (s1 <= j) ? e1 : 0.f;
            p0[r] *= w0; p1[r] *= w1; dsum += p0[r] + p1[r];
        }
        { auto rr = __builtin_amdgcn_permlane32_swap(__float_as_uint(dsum), __float_as_uint(dsum), false, false); dsum = __uint_as_float(rr[0]) + __uint_as_float(rr[1]); }
        bf16x8 pa0, pa1, pa2, pa3;
        PK4(p0, 0, pa0); PK4(p0, 8, pa1); PK4(p1, 0, pa2); PK4(p1, 8, pa3);
        f32x16 o[4];
#pragma unroll
        for (int d = 0; d < 4; ++d) o[d] = f32x16{};
        const int vb0 = (int)(uintptr_t)(hl + vh * 16384) + v_rd_base(lane);
        pv_tile<0, 4>(o, vb0, pa0, pa1, pa2, pa3);
        const float w_inter = expf(m_c - M_j);
        float qn = 0.f;
        bf16x8 qs[8];
#pragma unroll
        for (int cc = 0; cc < 8; ++cc) {
            const u32x4 w = *reinterpret_cast<const u32x4*>(&qr[cc]);
            const float q0 = bflo(w.x), q1 = bfhi(w.x), q2 = bflo(w.y), q3 = bfhi(w.y), q4 = bflo(w.z), q5 = bfhi(w.z), q6 = bflo(w.w), q7 = bfhi(w.w);
            const LAS float* np = n_l + cc * 16 + hi * 8;
            qn += q0 * np[0] + q1 * np[1] + q2 * np[2] + q3 * np[3] + q4 * np[4] + q5 * np[5] + q6 * np[6] + q7 * np[7];
            u32x4 o_; o_.x = cvt_pk_bf16(q0 * w_inter, q1 * w_inter); o_.y = cvt_pk_bf16(q2 * w_inter, q3 * w_inter); o_.z = cvt_pk_bf16(q4 * w_inter, q5 * w_inter); o_.w = cvt_pk_bf16(q6 * w_inter, q7 * w_inter);
            qs[cc] = *reinterpret_cast<bf16x8*>(&o_);
        }
        { auto rr = __builtin_amdgcn_permlane32_swap(__float_as_uint(qn), __float_as_uint(qn), false, false); qn = __uint_as_float(rr[0]) + __uint_as_float(rr[1]); }
        {
            const bf16_t* cp = Cst + ((size_t)u * 256 + 128 * vh + r32) * 128 + hi * 8;
            bf16x8 cfa[8], cfb[8];
#pragma unroll
            for (int cc = 0; cc < 8; ++cc) cfa[cc] = *(const bf16x8*)(cp + cc * 16);
#pragma unroll
            for (int cc = 0; cc < 8; ++cc) cfb[cc] = *(const bf16x8*)(cp + (size_t)32 * 128 + cc * 16);
            SBAR();
#pragma unroll
            for (int cc = 0; cc < 8; ++cc) o[0] = __builtin_amdgcn_mfma_f32_32x32x16_bf16(qs[cc], cfa[cc], o[0], 0, 0, 0);
            SBAR();
#pragma unroll
            for (int cc = 0; cc < 8; ++cc) cfa[cc] = *(const bf16x8*)(cp + (size_t)64 * 128 + cc * 16);
            SBAR();
#pragma unroll
            for (int cc = 0; cc < 8; ++cc) o[1] = __builtin_amdgcn_mfma_f32_32x32x16_bf16(qs[cc], cfb[cc], o[1], 0, 0, 0);
            SBAR();
#pragma unroll
            for (int cc = 0; cc < 8; ++cc) cfb[cc] = *(const bf16x8*)(cp + (size_t)96 * 128 + cc * 16);
            SBAR();
#pragma unroll
            for (int cc = 0; cc < 8; ++cc) o[2] = __builtin_amdgcn_mfma_f32_32x32x16_bf16(qs[cc], cfa[cc], o[2], 0, 0, 0);
            SBAR();
#pragma unroll
            for (int cc = 0; cc < 8; ++cc) o[3] = __builtin_amdgcn_mfma_f32_32x32x16_bf16(qs[cc], cfb[cc], o[3], 0, 0, 0);
        }
        const float den = dsum + w_inter * qn;
        const float inv = 1.0f / fmaxf(fabsf(den), expf(-(b_j + M_j)));
        if (hi == 0) scr[r32] = inv;
        LGKM0();
        float ss[16];
#pragma unroll
        for (int r = 0; r < 16; ++r) { const float iv = scr[crow(r, hi)]; float a = 0.f;
#pragma unroll
            for (int d = 0; d < 4; ++d) { o[d][r] *= iv; a += o[d][r] * o[d][r]; }
            a += __shfl_xor(a, 1); a += __shfl_xor(a, 2); a += __shfl_xor(a, 4); a += __shfl_xor(a, 8); a += __shfl_xor(a, 16);
            ss[r] = a; }
        if (r32 == 0) {
#pragma unroll
            for (int r = 0; r < 16; ++r) rowss[vh * 64 + 32 * rh + crow(r, hi)] = ss[r]; }
        __syncthreads();
#pragma unroll
        for (int r = 0; r < 16; ++r) { const int jr = 32 * rh + crow(r, hi);
#pragma unroll
            for (int d = 0; d < 4; ++d) *(LAS bf16_t*)(hl + jr * 512 + (128 * vh + 32 * d + r32) * 2) = f2bf(o[d][r]); }
        __syncthreads();
        { u32x4 ov[8], mv[8];
#pragma unroll
          for (int i = 0; i < 8; ++i) { const int q = htid + 256 * i, row = q >> 5, c8 = (q & 31) * 8;
              ov[i] = *(const LAS u32x4*)(hl + row * 512 + c8 * 2);
              mv[i] = *(const u32x4*)(proj + (size_t)(t0 + row) * IN_PAD + OFF_MO + h * 256 + c8); }
#pragma unroll
          for (int i = 0; i < 8; ++i) { const int q = htid + 256 * i, row = q >> 5, c8 = (q & 31) * 8;
              const float rstd = rsqrtf((rowss[row] + rowss[64 + row]) * (1.0f / 256.0f) + EPS);
              const f32x4 g0 = *(const f32x4*)(gain + h * 256 + c8), g1 = *(const f32x4*)(gain + h * 256 + c8 + 4);
              float v[8];
#pragma unroll
              for (int e = 0; e < 4; ++e) { const unsigned ow = ov[i][e], mw = mv[i][e];
                  v[2 * e] = bflo(ow) * rstd * ((e < 2) ? g0[2 * e] : g1[2 * e - 4]) / (1.0f + __expf(-bflo(mw)));
                  v[2 * e + 1] = bfhi(ow) * rstd * ((e < 2) ? g0[2 * e + 1] : g1[2 * e - 3]) / (1.0f + __expf(-bfhi(mw))); }
              u32x4 w; w.x = cvt_pk_bf16(v[0], v[1]); w.y = cvt_pk_bf16(v[2], v[3]); w.z = cvt_pk_bf16(v[4], v[5]); w.w = cvt_pk_bf16(v[6], v[7]);
              *(u32x4*)(hcat + (size_t)(t0 + row) * 2048 + h * 256 + c8) = w; } }
    }
    __syncthreads();
}

constexpr int NPHASE = 26;
__device__ __forceinline__ void moe_phase_router(const Frame& F, int layer) {
    PolRouter p; p.A = WSP(bf16_t, WS_H2); p.Bt = WSP(bf16_t, WS_WR) + (size_t)layer * 256 * 2048; p.part = WSP(float, WS_LOGP); p.K = 512; p.ldb = 2048;
    pg8::gemm_phase(F.lds, p);
}
__device__ __forceinline__ void moe_phase_gateup(const Frame& F, int layer) {
    PolGateUp p; p.A = WSP(bf16_t, WS_H2); p.W = WSP(bf16_t, WS_WGU) + (size_t)layer * 65 * 512 * 2048; p.rowtok = WSP(int, WS_ROWTOK); p.act = WSP(bf16_t, WS_ACT);
    p.tb = moe_tables(F); p.K = 2048; p.ldb = 2048;
    {
        LAS int* ridx = (LAS int*)(F.aux + 6144);
        for (int idx = F.tid; idx < 8 * 256; idx += NTHREADS) { const int i = idx >> 8, r = idx & 255, L = p.tb.rank + i * p.tb.nrank;
            if (L < p.tb.nrb * 2) ridx[idx] = p.rowtok[p.tb.blk_row0[p.tb.rb0 + (L >> 1)] + r]; }
        __syncthreads();
        p.ridx = ridx; }
    pg8::gemm_phase(F.lds, p);
}
__device__ __forceinline__ void moe_phase_down(const Frame& F, int layer, int nostore = 0) {
    PolDown p; p.nostore = nostore; p.A = WSP(bf16_t, WS_ACT); p.W = WSP(bf16_t, WS_WDN) + (size_t)layer * 65 * 2048 * 256; p.Y = WSP(unsigned char, WS_Y);
    p.tb = moe_tables(F); p.K = 256; p.ldb = 256;
    pg8::gemm_phase(F.lds, p);
}

__global__ void __launch_bounds__(NTHREADS, 2) mk_fwd(Args args) {
    extern __shared__ __attribute__((aligned(16))) unsigned char lds_raw[];
    Frame F;
    F.lds = (LAS unsigned char*)lds_raw; F.aux = F.lds + LDS_MAIN;
    F.in = args.in; F.out = args.out; F.ws = args.ws;
    F.tid = threadIdx.x; F.lane = F.tid & 63; F.wid = __builtin_amdgcn_readfirstlane(F.tid >> 6); F.G = gridDim.x; F.bid = blockIdx.x;
    volatile LAS unsigned* xbw = (volatile LAS unsigned*)(F.lds + LDS_MAIN + LDS_AUX);
    if (F.tid < 4) xbw[F.tid] = 0u;
    __syncthreads();
    const int lo = args.ph_lo, hi = args.ph_hi;
    XcdBarrier bar; bar.bar = WSP(unsigned, WS_ZERO + ZB_BAR); bar.x = 0; bar.st = xbw;
    if (hi - lo > 1) bar = xcd_barrier_post(WSP(unsigned, WS_ZERO + ZB_BAR), xbw);
#ifdef PH_ONLY
#define IN(k) ((k) == PH_ONLY)
#else
#define IN(k) (lo <= (k) && (k) < hi)
#endif
#define SEAM(k) do { if (IN(k) && IN((k) + 1)) xcd_barrier(bar); { int t_ = threadIdx.x; asm volatile("" : "+v"(t_)); F.tid = t_; F.lane = t_ & 63; F.wid = __builtin_amdgcn_readfirstlane(t_ >> 6); } } while (0)
    const float* mod = WSP(float, WS_ZERO + ZB_MOD);
    const float* mod0 = mod; const float* mod1 = mod + 12288;

    if (IN(0)) { PRB(0) { ph_adaln(F); ph_rope_table(F); ph_convert(F); } } SEAM(0);
#if PROBE_EXTRA_BARRIERS
    if (hi - lo > 1) { for (int xb = 0; xb < 16; ++xb) xcd_barrier(bar); }
#endif
    if (IN(1)) { PRB(15) ph_modulate<0>(F, F.in[0], mod0 + 0, mod0 + 2048, WSP(bf16_t, WS_HA)); } SEAM(1);
    if (IN(2)) { PRB(5) { PolBf16 p{{WSP(bf16_t, WS_HA), WSP(bf16_t, WS_WIN), 2048, 2048, 2048, 64, IN_PAD / 256}, WSP(bf16_t, WS_PROJ), IN_PAD, nullptr}; pg8::gemm_phase(F.lds, p); } } SEAM(2);
    if (IN(3)) { PRB(14) { ph_mla_prep(F); ph_gates(F); } } SEAM(3);
    if (IN(4)) {
        LAS float* mst = (LAS float*)F.aux;
        m_scan(F, mst);
        { PolBf16 p{{WSP(bf16_t, WS_CQN), WSP(bf16_t, WS_WUQ), 768, 768, 768, 64, 6}, WSP(bf16_t, WS_QRAW), 1536, nullptr}; pg8::gemm_phase(F.lds, p); }
        { PolBf16 p{{WSP(bf16_t, WS_CKVN), WSP(bf16_t, WS_WUKV), 512, 512, 512, 64, 8}, WSP(bf16_t, WS_KVRAW), 2048, nullptr}; pg8::gemm_phase(F.lds, p); }
        PRB(12) ph_mlstm_B(F, mst);
    } SEAM(4);
    if (IN(6)) {
        {
            unsigned* cctr = WSP(unsigned, WS_ZERO + ZB_CTR + 256); unsigned* cdone = WSP(unsigned, WS_ZERO + ZB_CTR + 384);
            for (;;) { const int c = grab(F, cctr); if (c >= 65) break;
                mlstm_C_item(F, c);
                asm volatile("s_waitcnt vmcnt(0)" ::: "memory"); __syncthreads();
                if (F.tid == 0) (void)__hip_atomic_fetch_add(cdone, 1u, __ATOMIC_RELAXED, __HIP_MEMORY_SCOPE_AGENT); }
        }
        AttnBlk<192, 128, 64> A;
        A.ldq = 1536; A.ldk1 = 2048; A.K2 = WSP(bf16_t, WS_KPE); A.ldk2 = 64; A.ldv = 2048; A.ldo = 2048;
        A.C2 = 0.07216878364870323f * 1.4426950408889634f; A.m_init = -1e30f; A.l_init = 0.f; A.W = 1u << 30; A.wrow = 32; A.wq = 0; A.wo = 0; A.sinks = nullptr; A.sink_scale = 0.f; A.ropeq = WSP(float2, WS_ROPE);
        const bool cvt_first = F.bid < MCV_BLOCKS;
        if (cvt_first) moe_cvt_queue(F);
        unsigned* actr = WSP(unsigned, WS_ZERO + ZB_CTR + 128);
        for (;;) {
            const int u = grab(F, actr); if (u >= 512) break;
            const int h = u & 7, qb = 63 - (u >> 3);
            A.Q = WSP(bf16_t, WS_QRAW) + 192 * h; A.K1 = WSP(bf16_t, WS_KVRAW) + 256 * h; A.V = WSP(bf16_t, WS_KVRAW) + 256 * h + 128; A.O = WSP(bf16_t, WS_HCAT) + 1024 + 128 * h;
            A.run(F.lds, qb * 256, 0, qb * 4 + 4);
        }
        if (!cvt_first) moe_cvt_queue(F);
        __syncthreads();
        {
            unsigned* cdone = WSP(unsigned, WS_ZERO + ZB_CTR + 384);
            if (F.tid == 0) { unsigned sp = 0; while (__hip_atomic_load(cdone, __ATOMIC_RELAXED, __HIP_MEMORY_SCOPE_AGENT) < 65u) { __builtin_amdgcn_s_sleep(1); if (++sp > (1u << 24)) break; }
                __builtin_amdgcn_fence(__ATOMIC_ACQUIRE, "agent"); }
            __syncthreads();
            ph_mlstm_D(F);
        }
        __syncthreads();
    } SEAM(6);
    if (IN(7)) { PolResid<false> p{{WSP(bf16_t, WS_HCAT), WSP(bf16_t, WS_WOUT), 2048, 2048, 2048, 64, 8}, F.in[0], mod0 + 4096, WSP(bf16_t, WS_XA)}; pg8::gemm_phase(F.lds, p); } SEAM(7);
    if (IN(8)) { PRB(4) ph_modulate<1>(F, WSP(bf16_t, WS_XA), mod0 + 6144, mod0 + 8192, WSP(bf16_t, WS_H2)); } SEAM(8);
    if (IN(9)) { PRB(6) moe_phase_router(F, 0); } SEAM(9);
    if (IN(10)) { PRB(9) ph_route(F, 0); } SEAM(10);
    if (IN(11)) { PRB(9) ph_dispatch(F); } SEAM(11);
    if (IN(12)) { PRB(1) moe_phase_gateup(F, 0); } SEAM(12);
    if (IN(13)) { moe_phase_down(F, 0);
#if PROBE_DOWN_NOSTORE == 1
        moe_phase_down(F, 0, 1);
#elif PROBE_DOWN_NOSTORE == 2
        moe_phase_down(F, 0, 0);
#endif
    } SEAM(13);
    if (IN(14)) { PRB(3) ph_combine<0>(F, WSP(bf16_t, WS_XA), mod0 + 10240, WSP(bf16_t, WS_XB), mod1 + 0, mod1 + 2048, WSP(bf16_t, WS_HA), nullptr); } SEAM(14);
    if (IN(15)) { PolBf16 p{{WSP(bf16_t, WS_HA), WSP(bf16_t, WS_WQKV), 2048, 2048, 2048, 64, 10}, WSP(bf16_t, WS_PROJ), 2560, F.in[14]}; pg8::gemm_phase(F.lds, p); } SEAM(15);
    if (IN(17)) { PRB(7) ph_swa(F);
    } SEAM(17);
    if (IN(18)) { PolResid<true> p{{WSP(bf16_t, WS_HCAT), WSP(bf16_t, WS_WO), 2048, 2048, 2048, 64, 8}, WSP(bf16_t, WS_XB), mod1 + 4096, WSP(bf16_t, WS_XA)}; pg8::gemm_phase(F.lds, p); } SEAM(18);
    if (IN(19)) { ph_modulate<1>(F, WSP(bf16_t, WS_XA), mod1 + 6144, mod1 + 8192, WSP(bf16_t, WS_H2)); } SEAM(19);
    if (IN(20)) { moe_phase_router(F, 1); } SEAM(20);
    if (IN(21)) { ph_route(F, 1); } SEAM(21);
    if (IN(22)) { ph_dispatch(F); } SEAM(22);
    if (IN(23)) { moe_phase_gateup(F, 1); } SEAM(23);
    if (IN(24)) { moe_phase_down(F, 1); } SEAM(24);
    if (IN(25)) { ph_combine<1>(F, WSP(bf16_t, WS_XA), mod1 + 10240, nullptr, nullptr, F.in[23], nullptr, F.out); }
#undef IN
#undef SEAM
}

#ifdef DBG_DUMP_OFF
__global__ void __launch_bounds__(512) dbg_dump(unsigned char* ws, float* out) {
    const size_t NOUT = (size_t)T * D;
    for (size_t i = (size_t)blockIdx.x * 512 + threadIdx.x; i < NOUT; i += (size_t)gridDim.x * 512) {
        float a = 0.f;
        for (size_t j = i; j < (size_t)(DBG_DUMP_N); j += NOUT) a += (DBG_DUMP_KIND == 0) ? bf2f(((const bf16_t*)(ws + DBG_DUMP_OFF))[j]) : (DBG_DUMP_KIND == 1 ? ((const float*)(ws + DBG_DUMP_OFF))[j] : (DBG_DUMP_KIND == 2 ? (float)((const int*)(ws + DBG_DUMP_OFF))[j] : ((((const int*)(ws + DBG_DUMP_OFF))[j] < 0 || ((const int*)(ws + DBG_DUMP_OFF))[j] > 63) ? 1.0e6f : 0.0f)));
        if (DBG_DUMP_KIND == 4) { a = 0.f; if (i < (size_t)T * 8) { const int sl = ((const int*)(ws + WS_PSLOT))[i]; const int tk = (sl >= 0 && sl < NSLOT) ? ((const int*)(ws + WS_ROWTOK))[sl] : -7; a = (tk == (int)(i >> 3)) ? 0.f : 1.0e6f; } }
        if (DBG_DUMP_KIND == 5) { const int t = (int)(i >> 11), c = (int)(i & 2047); const bf16_t* Yp = (const bf16_t*)(ws + WS_Y); a = bf2f(Yp[(size_t)t * 2048 + c]);
            for (int k = 0; k < 8; ++k) { const int sl = ((const int*)(ws + WS_PSLOT))[t * 8 + k]; a += bf2f(Yp[(size_t)sl * 2048 + c]); } }
        if (DBG_DUMP_KIND == 6) { const int t = (int)(i >> 11), c = (int)(i & 2047); const bf16_t* Ap = (const bf16_t*)(ws + WS_ACT); a = 0.f; if (c < 256) { a = bf2f(Ap[(size_t)t * 256 + c]);
            for (int k = 0; k < 8; ++k) { const int sl = ((const int*)(ws + WS_PSLOT))[t * 8 + k]; a += bf2f(Ap[(size_t)sl * 256 + c]); } } }
        out[i] = a;
    }
}
#endif
extern "C" void kernel_launch(void* const* d_in, const int* in_sizes, int n_in, void* d_out, int out_size, void* d_ws, size_t ws_size, hipStream_t stream) {
    static int grid = 0;
    if (grid == 0) {
        if (n_in != 24 || out_size != T * D || ws_size < WS_END) { fprintf(stderr, "kernel_launch: unexpected shapes (n_in %d out %d ws %zu need %zu)\n", n_in, out_size, ws_size, (size_t)WS_END); grid = -1; return; }
        int dev = 0, cus = 0;
        if (hipGetDevice(&dev) != hipSuccess || hipDeviceGetAttribute(&cus, hipDeviceAttributeMultiprocessorCount, dev) != hipSuccess) { grid = -1; return; }
        if (hipFuncSetAttribute((const void*)mk_fwd, hipFuncAttributeMaxDynamicSharedMemorySize, LDS_BYTES) != hipSuccess) { fprintf(stderr, "kernel_launch: hipFuncSetAttribute failed\n"); grid = -1; return; }
        int per_cu = 0;
        if (hipOccupancyMaxActiveBlocksPerMultiprocessor(&per_cu, (const void*)mk_fwd, NTHREADS, LDS_BYTES) != hipSuccess || per_cu < 1) { fprintf(stderr, "kernel_launch: occupancy query says %d blocks per CU\n", per_cu); }
        (void)hipGetLastError();
        grid = cus;
    }
    if (grid < 0) return;
    (void)hipMemsetAsync((char*)d_ws + WS_ZERO, 0, ZERO_BYTES, stream);
    Args a; memset(&a, 0, sizeof(a));
    for (int i = 0; i < 24; ++i) a.in[i] = (const float*)d_in[i];
    a.out = (float*)d_out; a.ws = (unsigned char*)d_ws;
#if MK_MULTI
#ifdef DBG_DUMP_OFF
    for (int p = 0; p <= DBG_LAST; ++p) { a.ph_lo = p; a.ph_hi = p + 1; hipLaunchKernelGGL(mk_fwd, dim3(grid), dim3(NTHREADS), LDS_BYTES, stream, a); }
    hipLaunchKernelGGL(dbg_dump, dim3(1024), dim3(512), 0, stream, (unsigned char*)d_ws, (float*)d_out);
#else
    for (int p = 0; p < NPHASE; ++p) { a.ph_lo = p; a.ph_hi = p + 1; hipLaunchKernelGGL(mk_fwd, dim3(grid), dim3(NTHREADS), LDS_BYTES, stream, a); }
#endif
#else
    a.ph_lo = 0; a.ph_hi = NPHASE;
    hipLaunchKernelGGL(mk_fwd, dim3(grid), dim3(NTHREADS), LDS_BYTES, stream, a);
#endif
}
```

```cpp
#include <hip/hip_runtime.h>
#include <cstdio>
#include <cstdint>
#include <cstring>

#ifndef PROBE_EXTRA_BARRIERS
#define PROBE_EXTRA_BARRIERS 0
#endif
#ifndef PROBE_DOWN_NOSTORE
#define PROBE_DOWN_NOSTORE 0
#endif
#ifndef EXP_DUP_LDS
#define EXP_DUP_LDS 0
#endif
#ifndef EXP_DUP_QK
#define EXP_DUP_QK 0
#endif
#ifndef EXP_DUP_EXP
#define EXP_DUP_EXP 0
#endif
#ifndef ATT_STAGGER
#define ATT_STAGGER 0
#endif
#ifndef NT_STORES
#define NT_STORES 0
#endif
#ifndef DENSE_XCD
#define DENSE_XCD 0
#endif
#ifndef PROBE_SET
#define PROBE_SET 0
#endif
#define PRB(bit) _Pragma("unroll") for (int rep_ = 0; rep_ < (((PROBE_SET) >> (bit)) & 1) + 1; ++rep_)
#ifndef PROBE_REP_MLA
#define PROBE_REP_MLA 1
#endif
#ifndef MCV_BLOCKS
#define MCV_BLOCKS 32
#endif
#ifndef MK_MULTI
#define MK_MULTI 0
#endif

#define LAS __attribute__((address_space(3)))
typedef unsigned short bf16_t;
typedef short bf16x8 __attribute__((ext_vector_type(8)));
typedef short s16x4 __attribute__((ext_vector_type(4)));
typedef float f32x4 __attribute__((ext_vector_type(4)));
typedef float f32x16 __attribute__((ext_vector_type(16)));
typedef unsigned u32x4 __attribute__((ext_vector_type(4)));
typedef unsigned u32x2 __attribute__((ext_vector_type(2)));

constexpr int T = 16384, D = 2048;
constexpr int IN_DIM = 4424, IN_PAD = 4608;
constexpr int OFF_MQ = 0, OFF_MK = 512, OFF_MV = 1024, OFF_MO = 2048, OFF_MI = 3072, OFF_MF = 3076, OFF_CQ = 3080, OFF_CKV = 3848, OFF_KR = 4360;
constexpr int NE = 64, TOPK = 8, EFF = 256;
constexpr int NSLOT = T + T * TOPK + NE * 256;
constexpr int NCH = 256;
constexpr float EPS = 1e-6f;

constexpr size_t al256(size_t x) { return (x + 255) & ~(size_t)255; }
constexpr size_t WS_ZERO = 0;
constexpr size_t ZB_BAR = 0;
constexpr size_t ZB_MOD = 16384;
constexpr size_t ZB_CTR = 16384 + 98304;
constexpr size_t ZERO_BYTES = 16384 + 98304 + 16384;
constexpr size_t WS_ROPE = al256(WS_ZERO + ZERO_BYTES);
constexpr size_t WS_WIN = al256(WS_ROPE + (size_t)T * 32 * 8);
constexpr size_t WS_WUQ = al256(WS_WIN + (size_t)IN_PAD * 2048 * 2);
constexpr size_t WS_WUKV = al256(WS_WUQ + (size_t)1536 * 768 * 2);
constexpr size_t WS_WOUT = al256(WS_WUKV + (size_t)2048 * 512 * 2);
constexpr size_t WS_WQKV = al256(WS_WOUT + (size_t)2048 * 2048 * 2);
constexpr size_t WS_WO = al256(WS_WQKV + (size_t)2560 * 2048 * 2);
constexpr size_t WS_WR = al256(WS_WO + (size_t)2048 * 2048 * 2);
constexpr size_t WS_WGU = al256(WS_WR + (size_t)2 * 256 * 4096 * 2);
constexpr size_t WS_WDN = al256(WS_WGU + (size_t)2 * 65 * 512 * 2048 * 2);
constexpr size_t WS_HA = al256(WS_WDN + (size_t)2 * 65 * 2048 * 256 * 2);
constexpr size_t WS_H2 = al256(WS_HA + (size_t)T * 2048 * 2);
constexpr size_t WS_XA = al256(WS_H2 + (size_t)T * 4096 * 2);
constexpr size_t WS_XB = al256(WS_XA + (size_t)T * 2048 * 4);
constexpr size_t WS_HCAT = al256(WS_XB + (size_t)T * 2048 * 4);
constexpr size_t WS_GA = al256(WS_HCAT + (size_t)T * 2048 * 2);
constexpr size_t WS_GB = al256(WS_GA + (size_t)4 * T * 4);
constexpr size_t WS_GCM = al256(WS_GB + (size_t)4 * T * 4);
constexpr size_t WS_GST = al256(WS_GCM + (size_t)4 * T * 4);
constexpr size_t WS_DN = al256(WS_GST + 16384);
constexpr size_t WS_NST = al256(WS_DN + (size_t)NCH * 4 * 128 * 4);
constexpr size_t WS_LOGP = al256(WS_NST + (size_t)NCH * 4 * 128 * 4);
constexpr size_t WS_TKI = al256(WS_LOGP + (size_t)4 * T * 128 * 4);
constexpr size_t WS_TKW = al256(WS_TKI + (size_t)T * 8 * 4);
constexpr size_t WS_PSLOT = al256(WS_TKW + (size_t)T * 8 * 4);
constexpr size_t WS_HIST = al256(WS_PSLOT + (size_t)T * 8 * 4);
constexpr size_t WS_ETAB = al256(WS_HIST + (size_t)256 * 64 * 4);
constexpr size_t WS_ROWTOK = al256(WS_ETAB + 4096);
constexpr size_t WS_ACT = al256(WS_ROWTOK + (size_t)NSLOT * 4);
constexpr size_t WS_Y = al256(WS_ACT + (size_t)NSLOT * 256 * 2);
constexpr size_t WS_PROJ = WS_Y;
constexpr size_t WS_CQN = al256(WS_PROJ + (size_t)T * IN_PAD * 2);
constexpr size_t WS_CKVN = al256(WS_CQN + (size_t)T * 768 * 2);
constexpr size_t WS_KPE = al256(WS_CKVN + (size_t)T * 512 * 2);
constexpr size_t WS_QRAW = al256(WS_KPE + (size_t)T * 64 * 2);
constexpr size_t WS_KVRAW = al256(WS_QRAW + (size_t)T * 1536 * 2);
constexpr size_t WS_DC = al256(WS_KVRAW + (size_t)T * 2048 * 2);
constexpr size_t WS_CST = al256(WS_DC + (size_t)NCH * 4 * 256 * 128 * 2);
constexpr size_t WS_MIXEND = al256(WS_CST + (size_t)NCH * 4 * 256 * 128 * 2);
constexpr size_t WS_END = al256(WS_Y + (size_t)NSLOT * 2048 * 2);
static_assert(WS_MIXEND <= WS_END, "mixer temporaries must fit inside the Y region");

__device__ __forceinline__ unsigned cvt_pk_bf16(float lo, float hi) { unsigned r; asm volatile("v_cvt_pk_bf16_f32 %0, %1, %2" : "=v"(r) : "v"(lo), "v"(hi)); return r; }
__device__ __forceinline__ float bf2f(unsigned short h) { return __uint_as_float((unsigned)h << 16); }
__device__ __forceinline__ float bflo(unsigned w) { return __uint_as_float(w << 16); }
__device__ __forceinline__ float bfhi(unsigned w) { return __uint_as_float(w & 0xffff0000u); }
__device__ __forceinline__ bf16_t f2bf(float f) { return (bf16_t)(cvt_pk_bf16(f, f) & 0xffffu); }
template <int CTRL> __device__ __forceinline__ float dpp_add(float v) { return v + __int_as_float(__builtin_amdgcn_update_dpp(0, __float_as_int(v), CTRL, 0xF, 0xF, true)); }
__device__ __forceinline__ float wave_sum(float v) {
    v = dpp_add<0xB1>(v); v = dpp_add<0x4E>(v); v = dpp_add<0x141>(v); v = dpp_add<0x140>(v);
    v += __int_as_float(__builtin_amdgcn_ds_swizzle(__float_as_int(v), 0x401F));
    return __int_as_float(__builtin_amdgcn_readlane(__float_as_int(v), 0)) + __int_as_float(__builtin_amdgcn_readlane(__float_as_int(v), 32));
}
template <int CTRL> __device__ __forceinline__ float dpp_max(float v) { return fmaxf(v, __int_as_float(__builtin_amdgcn_update_dpp(__float_as_int(v), __float_as_int(v), CTRL, 0xF, 0xF, false))); }
__device__ __forceinline__ float grp8_max(float v) { v = dpp_max<0xB1>(v); v = dpp_max<0x4E>(v); return dpp_max<0x141>(v); }
__device__ __forceinline__ int wave_incl_scan(int v, int lane) {
#pragma unroll
    for (int o = 1; o < 64; o <<= 1) { const int u = __shfl_up(v, o); v += (lane >= o) ? u : 0; }
    return v;
}
__device__ __forceinline__ float sigmoidf_(float x) { return 1.0f / (1.0f + __expf(-x)); }

#define XB_TMO      128
#define XB_XCNT(j)  (256  + 64 * (j))
#define XB_XSUB(j)  (1280 + 64 * (j))
#define XB_XGEN(j)  (2304 + 64 * (j))
#define XB_TOP      3328
#define XB_TOPGEN   3392
#define XCD_BAR_WORDS 3456
#define XB_SPIN_CAP (1u << 22)
__device__ __forceinline__ unsigned xb_ld(unsigned* p)              { return __hip_atomic_load(p, __ATOMIC_RELAXED, __HIP_MEMORY_SCOPE_AGENT); }
__device__ __forceinline__ unsigned xb_add(unsigned* p, unsigned v) { return __hip_atomic_fetch_add(p, v, __ATOMIC_RELAXED, __HIP_MEMORY_SCOPE_AGENT); }
__device__ __forceinline__ unsigned xb_xcc_id() { return (unsigned)__builtin_amdgcn_s_getreg((3 << 11) | 20) & 0xFu; }
#define XB_SPIN(cond, bar) do { unsigned _sp = 0; while (cond) { __builtin_amdgcn_s_sleep(1); \
    if ((++_sp & 255u) == 0u) { if (xb_ld(&(bar)[XB_TMO])) break; if (_sp > XB_SPIN_CAP) { atomicAdd(&(bar)[XB_TMO], 1u); break; } } } } while (0)
struct XcdBarrier { unsigned* bar; unsigned x; volatile LAS unsigned* st; };
__device__ __forceinline__ XcdBarrier xcd_barrier_post(unsigned* bar, volatile LAS unsigned* st) {
    XcdBarrier b; b.bar = bar; b.x = xb_xcc_id(); b.st = st;
    if (threadIdx.x == 0) (void)xb_add(&bar[XB_XCNT(b.x)], 1u);
    return b;
}
__device__ __forceinline__ void xcd_barrier_complete(unsigned* bar, unsigned x, unsigned& nloc, unsigned& nx) {
    const unsigned G = gridDim.x * gridDim.y * gridDim.z;
    unsigned sum, cnt, mine, sp = 0u;
    for (;;) {
        sum = 0u; cnt = 0u; mine = 0u;
#pragma unroll
        for (unsigned j = 0; j < 16; ++j) { const unsigned c = xb_ld(&bar[XB_XCNT(j)]); sum += c; cnt += (c > 0u) ? 1u : 0u; mine = (j == x) ? c : mine; }
        if (sum == G) break;
        __builtin_amdgcn_s_sleep(1);
        if ((++sp & 255u) == 0u) { if (xb_ld(&bar[XB_TMO])) break; if (sp > XB_SPIN_CAP) { atomicAdd(&bar[XB_TMO], 1u); break; } }
    }
    nloc = mine > 0u ? mine : 1u; nx = cnt > 0u ? cnt : 1u;
}
__device__ __forceinline__ void xcd_barrier(const XcdBarrier& b) {
    asm volatile("s_waitcnt vmcnt(0)" ::: "memory");
    __syncthreads();
    if (threadIdx.x == 0) {
        unsigned* bar = b.bar;
        __builtin_amdgcn_s_waitcnt(0);
        unsigned nloc = b.st[0], nx = b.st[1];
        if (nloc == 0u) { xcd_barrier_complete(bar, b.x, nloc, nx); b.st[0] = nloc; b.st[1] = nx; }
        const unsigned old = xb_add(&bar[XB_XSUB(b.x)], 1u);
        const unsigned gen = old / nloc;
        if (old + 1u == (gen + 1u) * nloc) {
            __builtin_amdgcn_fence(__ATOMIC_RELEASE, "agent");
            asm volatile("s_waitcnt vmcnt(0)" ::: "memory");
            const unsigned og = xb_add(&bar[XB_TOP], 1u);
            const unsigned tg = og / nx;
            if (og + 1u == (tg + 1u) * nx) xb_add(&bar[XB_TOPGEN], 1u);
            else XB_SPIN(xb_ld(&bar[XB_TOPGEN]) == tg, bar);
            __builtin_amdgcn_fence(__ATOMIC_ACQUIRE, "agent");
            xb_add(&bar[XB_XGEN(b.x)], 1u);
            asm volatile("s_waitcnt vmcnt(0)" ::: "memory");
        } else {
            XB_SPIN(xb_ld(&bar[XB_XGEN(b.x)]) == gen, bar);
            __builtin_amdgcn_fence(__ATOMIC_ACQUIRE, "agent");
            asm volatile("s_waitcnt vmcnt(0)" ::: "memory");
        }
    }
    __syncthreads();
}

struct Args {
    const float* in[24];
    float* out;
    unsigned char* ws;
    int ph_lo, ph_hi;
};
constexpr int NTHREADS = 512;
constexpr int LDS_MAIN = 131072, LDS_AUX = 16384;
constexpr int LDS_BYTES = LDS_MAIN + LDS_AUX + 16;

struct Frame {
    LAS unsigned char* lds;
    LAS unsigned char* aux;
    const float* const* in;
    float* out;
    unsigned char* ws;
    int tid, lane, wid, G, bid;
};
#define WSP(T_, off) ((T_*)(F.ws + (off)))

namespace pg8 {
constexpr int BM = 256, BK = 64, HALF = 128, HTB = HALF * BK * 2, STAGE_BYTES = 8 * HTB;
__device__ __forceinline__ int lds_byte(int r, int c) { const int st = (r >> 4) * 2 + (c >> 5), rr = r & 15, cc = c & 31, ob = rr * 64 + cc * 2; return st * 1024 + (ob ^ (((ob >> 9) & 1) << 5)); }
__device__ __forceinline__ void stage_rc(int b, int& R, int& C) { const int st = b / 1024, sb = b % 1024, swz = sb ^ (((sb >> 9) & 1) << 5); R = (st >> 1) * 16 + swz / 64; C = (st & 1) * 32 + (swz % 64) / 2; }
__device__ __forceinline__ int perm32(int rho) { const int n = rho >> 4, i = rho & 15; return 8 * (i >> 2) + 4 * n + (i & 3); }
struct Unit { int a, b, c, d; };

template <class P>
__device__ __forceinline__ void gemm_phase(LAS unsigned char* lds, const P& p) {
    const int tid = threadIdx.x, wid = __builtin_amdgcn_readfirstlane(tid >> 6), lane = tid & 63, wr = wid >> 2, wc = wid & 3, fr = lane & 15, fq = lane >> 4;
    const int K = p.K, nt = K / BK;
    const int G = p.stride(), c0 = p.first();
    const int NU = p.nunits();
    if (c0 >= NU) return;
    int R[2], C[2]; unsigned voffB[2][2];
#pragma unroll
    for (int i = 0; i < 2; ++i) { stage_rc(tid * 16 + i * 8192, R[i], C[i]); const int Rb = P::PERM ? ((R[i] & ~31) + perm32(R[i] & 31)) : R[i];
#pragma unroll
        for (int h = 0; h < 2; ++h) voffB[h][i] = (unsigned)((h * HALF + Rb) * p.ldb + C[i]) * 2u; }
    const size_t kstep = (size_t)(BK * 2);
    const unsigned ldsw = (unsigned)wid * 1024u;
    const int aoff = lds_byte(wr * 64 + fr, fq * 8), boff = lds_byte(wc * 32 + fr, fq * 8);
    const char* const Ab = p.abase();
#define PG8_SA(b, h) (((b) * 2 + (h)) * HTB)
#define PG8_SB(b, h) ((4 + (b) * 2 + (h)) * HTB)
#define PG8_STAGE(bufoff, gbase, o0, o1) do { \
        __builtin_amdgcn_global_load_lds((const unsigned*)((const char*)(gbase) + (o0)), (LAS unsigned*)(lds + (bufoff) + ldsw), 16, 0, 0); \
        __builtin_amdgcn_global_load_lds((const unsigned*)((const char*)(gbase) + (o1)), (LAS unsigned*)(lds + (bufoff) + ldsw + 8192), 16, 0, 0); } while (0)
#define PG8_LDA(dst, b, h) do { _Pragma("unroll") for (int m = 0; m < 4; ++m) _Pragma("unroll") for (int k = 0; k < 2; ++k) dst[m][k] = *(const LAS bf16x8*)(lds + PG8_SA(b, h) + aoff + m * 2048 + k * 1024); } while (0)
#define PG8_LDB(dst, b, h) do { _Pragma("unroll") for (int n = 0; n < 2; ++n) _Pragma("unroll") for (int k = 0; k < 2; ++k) dst[n][k] = *(const LAS bf16x8*)(lds + PG8_SB(b, h) + boff + n * 2048 + k * 1024); } while (0)
#define PG8_MMA(ai, bj, At, Bt) do { __builtin_amdgcn_s_setprio(1); _Pragma("unroll") for (int m = 0; m < 4; ++m) _Pragma("unroll") for (int n = 0; n < 2; ++n) _Pragma("unroll") for (int k = 0; k < 2; ++k) \
        acc[ai][bj][m][n] = __builtin_amdgcn_mfma_f32_16x16x32_bf16(Bt[n][k], At[m][k], acc[ai][bj][m][n], 0, 0, 0); __builtin_amdgcn_s_setprio(0); } while (0)
#define PG8_WAIT_V(n) asm volatile("s_waitcnt vmcnt(" #n ")" ::: "memory")
#define PG8_WAIT_L(n) asm volatile("s_waitcnt lgkmcnt(" #n ")" ::: "memory")
#define PG8_BAR __builtin_amdgcn_s_barrier()
#define PG8_SCHED __builtin_amdgcn_sched_barrier(0)
    Unit cur, nxt; int ui = 0;
    p.unit(c0, cur);
    unsigned aoc[2][2], aon[2][2];
    p.a_off(cur, R, C, aoc);
    f32x4 acc[2][2][4][2];
#pragma unroll
    for (int a = 0; a < 2; ++a)
#pragma unroll
        for (int b = 0; b < 2; ++b)
#pragma unroll
            for (int m = 0; m < 4; ++m)
#pragma unroll
                for (int n = 0; n < 2; ++n) acc[a][b][m][n] = (f32x4){0.f, 0.f, 0.f, 0.f};
    bf16x8 At[4][2], B0[2][2], B1[2][2];
    const char* cB = p.bbase(cur);
    PG8_STAGE(PG8_SB(0, 0), cB, voffB[0][0], voffB[0][1]); PG8_STAGE(PG8_SA(0, 0), Ab, aoc[0][0], aoc[0][1]);
    PG8_STAGE(PG8_SB(0, 1), cB, voffB[1][0], voffB[1][1]); PG8_STAGE(PG8_SA(0, 1), Ab, aoc[1][0], aoc[1][1]);
    if (wr == 1) PG8_BAR;
    PG8_WAIT_V(4); PG8_BAR;
    PG8_STAGE(PG8_SB(1, 0), cB + kstep, voffB[0][0], voffB[0][1]); PG8_STAGE(PG8_SA(1, 0), Ab + kstep, aoc[0][0], aoc[0][1]);
    PG8_STAGE(PG8_SB(1, 1), cB + kstep, voffB[1][0], voffB[1][1]);
    PG8_WAIT_V(6); PG8_BAR;
    for (;;) {
        const bool has_next = (c0 + (ui + 1) * G) < NU;
        if (has_next) { p.unit(c0 + (ui + 1) * G, nxt); p.a_off(nxt, R, C, aon); }
        else { nxt = cur;
#pragma unroll
            for (int h = 0; h < 2; ++h)
#pragma unroll
                for (int i = 0; i < 2; ++i) aon[h][i] = aoc[h][i]; }
        const char* nB = has_next ? p.bbase(nxt) : cB;
        for (int t = 0; t < nt; t += 2) {
            const bool last = (t == nt - 2);
            const char* a1 = Ab + (size_t)(t + 1) * kstep;
            const char* a2 = last ? Ab : Ab + (size_t)(t + 2) * kstep; const char* b2 = last ? nB : cB + (size_t)(t + 2) * kstep;
            const char* a3 = a2 + kstep; const char* b3 = b2 + kstep;
            unsigned ao2[2][2];
#pragma unroll
            for (int h = 0; h < 2; ++h)
#pragma unroll
                for (int i = 0; i < 2; ++i) ao2[h][i] = last ? aon[h][i] : aoc[h][i];
            PG8_LDB(B0, 0, 0); PG8_SCHED; PG8_LDA(At, 0, 0); PG8_STAGE(PG8_SA(1, 1), a1, aoc[1][0], aoc[1][1]);
            PG8_WAIT_L(8); PG8_BAR; PG8_WAIT_L(0); PG8_MMA(0, 0, At, B0); PG8_BAR; PG8_SCHED;
            PG8_LDB(B1, 0, 1); PG8_STAGE(PG8_SB(0, 0), b2, voffB[0][0], voffB[0][1]);
            PG8_BAR; PG8_WAIT_L(0); PG8_MMA(0, 1, At, B1); PG8_BAR;
            PG8_LDA(At, 0, 1); PG8_STAGE(PG8_SA(0, 0), a2, ao2[0][0], ao2[0][1]);
            PG8_BAR; PG8_WAIT_L(0); PG8_MMA(1, 0, At, B0); PG8_BAR; PG8_SCHED;
            PG8_STAGE(PG8_SB(0, 1), b2, voffB[1][0], voffB[1][1]);
            PG8_WAIT_V(6); PG8_BAR; PG8_MMA(1, 1, At, B1); PG8_BAR;
            PG8_LDB(B0, 1, 0); PG8_SCHED; PG8_LDA(At, 1, 0); PG8_STAGE(PG8_SA(0, 1), a2, ao2[1][0], ao2[1][1]);
            PG8_WAIT_L(8); PG8_BAR; PG8_WAIT_L(0); PG8_MMA(0, 0, At, B0); PG8_BAR; PG8_SCHED;
            PG8_LDB(B1, 1, 1); PG8_STAGE(PG8_SB(1, 0), b3, voffB[0][0], voffB[0][1]);
            PG8_BAR; PG8_WAIT_L(0); PG8_MMA(0, 1, At, B1); PG8_BAR;
            PG8_LDA(At, 1, 1); PG8_STAGE(PG8_SA(1, 0), a3, ao2[0][0], ao2[0][1]);
            PG8_BAR; PG8_WAIT_L(0); PG8_MMA(1, 0, At, B0); PG8_BAR; PG8_SCHED;
            PG8_STAGE(PG8_SB(1, 1), b3, voffB[1][0], voffB[1][1]);
            PG8_WAIT_V(6); PG8_BAR; PG8_MMA(1, 1, At, B1); PG8_BAR;
        }
        p.epi(acc, cur, wr, wc, fr, fq);
        if (!has_next) break;
#pragma unroll
        for (int a = 0; a < 2; ++a)
#pragma unroll
            for (int b = 0; b < 2; ++b)
#pragma unroll
                for (int m = 0; m < 4; ++m)
#pragma unroll
                    for (int n = 0; n < 2; ++n) acc[a][b][m][n] = (f32x4){0.f, 0.f, 0.f, 0.f};
        cur = nxt; cB = nB; ++ui;
#pragma unroll
        for (int h = 0; h < 2; ++h)
#pragma unroll
            for (int i = 0; i < 2; ++i) aoc[h][i] = aon[h][i];
    }
    PG8_WAIT_V(0);
    if (wr == 0) PG8_BAR;
    PG8_BAR;
#undef PG8_SA
#undef PG8_SB
#undef PG8_STAGE
#undef PG8_LDA
#undef PG8_LDB
#undef PG8_MMA
#undef PG8_WAIT_V
#undef PG8_WAIT_L
#undef PG8_BAR
#undef PG8_SCHED
}
}

__device__ __forceinline__ void adaln_sc(const Frame& F) {
    const float* c = F.in[1]; LAS float* sc = (LAS float*)F.lds;
    __syncthreads();
    for (int i = F.tid; i < 2048; i += NTHREADS) { const float cv = c[i]; sc[i] = cv / (1.0f + expf(-cv)); }
    __syncthreads();
}
__device__ __forceinline__ void adaln_unit(const Frame& F, int u) {
    const float* w_ada = F.in[3]; const float* b_ada = F.in[4];
    float* mod = WSP(float, WS_ZERO + ZB_MOD);
    const LAS float* sc = (const LAS float*)F.lds;
    LAS f32x4* part = (LAS f32x4*)(F.lds + 8192);
    const int cg = F.tid % 24, kg = F.tid / 24;
    const int l = u >> 7, col0 = (u & 127) * 96;
    if (F.tid < 504) {
        f32x4 acc = (f32x4){0.f, 0.f, 0.f, 0.f};
        const float* wp = w_ada + (size_t)l * 2048 * 12288 + col0 + cg * 4;
#pragma unroll 7
        for (int k = kg; k < 2048; k += 21) { const f32x4 w = *(const f32x4*)(wp + (size_t)k * 12288); acc += w * sc[k]; }
        part[kg * 24 + cg] = acc;
    }
    __syncthreads();
    if (F.tid < 96) { float s_ = 0.f; const LAS float* pf = (const LAS float*)part;
        for (int g = 0; g < 21; ++g) s_ += pf[g * 96 + F.tid];
        mod[(size_t)l * 12288 + col0 + F.tid] = s_ + b_ada[(size_t)l * 12288 + col0 + F.tid]; }
    __syncthreads();
}
__device__ __forceinline__ void ph_adaln(const Frame& F) {
    if (F.bid >= 128 && F.G >= 256) return;
    adaln_sc(F);
    for (int u = F.bid; u < 128; u += F.G) adaln_unit(F, u);
}

__device__ __forceinline__ void ph_rope_table(const Frame& F) {
    const int* pos = (const int*)F.in[2];
    float2* tab = WSP(float2, WS_ROPE);
    for (int idx = F.bid * NTHREADS + F.tid; idx < T * 32; idx += F.G * NTHREADS) {
        const int t = idx >> 5, i = idx & 31;
        const float inv_freq = (float)exp2(-(double)i * (13.287712379549449 / 32.0));
        const float ang = (float)pos[t] * inv_freq;
        const double rev = (double)ang * 0.15915494309189535;
        const float fr = (float)(rev - rint(rev));
        tab[idx] = make_float2(__builtin_amdgcn_cosf(fr), __builtin_amdgcn_sinf(fr));
    }
}

struct CvtJob { const float* src; bf16_t* dst; int K, Nsrc, Ndst, batch, mode, tiles_per_mat, tile0; size_t sbs, dbs; };
__device__ __forceinline__ void cvt_load(const Frame& F, const CvtJob& j, int lt, f32x4 (&v)[2][2]) {
    const int b = lt / j.tiles_per_mat, r = lt - b * j.tiles_per_mat;
    const int nkt = j.K / 128, ntile = r / nkt, kt = r - ntile * nkt;
    const float* src = j.src + (size_t)b * j.sbs;
    const int n4 = F.tid & 15, kp = F.tid >> 4;
    const int nd = ntile * 64 + n4 * 4;
    int scol; bool valid;
    if (j.mode == 1) { scol = ((nd >> 7) & 1) * 256 + (nd >> 8) * 128 + (nd & 127); valid = true; }
    else { scol = nd; valid = nd < j.Nsrc; }
#pragma unroll
    for (int jj = 0; jj < 2; ++jj)
#pragma unroll
        for (int e = 0; e < 2; ++e) { const int k = kt * 128 + jj * 64 + kp * 2 + e;
            v[jj][e] = valid ? __builtin_nontemporal_load((const f32x4*)(src + (size_t)k * j.Nsrc + scol)) : (f32x4){0.f, 0.f, 0.f, 0.f}; }
}
__device__ __forceinline__ void cvt_store(const Frame& F, const CvtJob& j, int lt, const f32x4 (&v)[2][2]) {
    const int b = lt / j.tiles_per_mat, r = lt - b * j.tiles_per_mat;
    const int nkt = j.K / 128, ntile = r / nkt, kt = r - ntile * nkt;
    bf16_t* dst = j.dst + (size_t)b * j.dbs;
    LAS unsigned* L = (LAS unsigned*)F.lds;
    const int n4 = F.tid & 15, kp = F.tid >> 4;
#pragma unroll
    for (int jj = 0; jj < 2; ++jj)
#pragma unroll
        for (int i = 0; i < 4; ++i) L[(n4 * 4 + i) * 65 + jj * 32 + kp] = cvt_pk_bf16(v[jj][0][i], v[jj][1][i]);
    __syncthreads();
    const int n = F.tid >> 3, ch = F.tid & 7;
    u32x4 o0, o1;
    o0.x = L[n * 65 + ch * 8 + 0]; o0.y = L[n * 65 + ch * 8 + 1]; o0.z = L[n * 65 + ch * 8 + 2]; o0.w = L[n * 65 + ch * 8 + 3];
    o1.x = L[n * 65 + ch * 8 + 4]; o1.y = L[n * 65 + ch * 8 + 5]; o1.z = L[n * 65 + ch * 8 + 6]; o1.w = L[n * 65 + ch * 8 + 7];
    bf16_t* dp = dst + (size_t)(ntile * 64 + n) * j.K + kt * 128 + ch * 16;
    *(u32x4*)dp = o0; *(u32x4*)(dp + 8) = o1;
    __syncthreads();
}
constexpr int NJOBS = 14;
__device__ __forceinline__ CvtJob make_job(const float* src, bf16_t* dst, int K, int Nsrc, int Ndst, int batch, int mode, size_t sbs, size_t dbs) {
    CvtJob j; j.src = src; j.dst = dst; j.K = K; j.Nsrc = Nsrc; j.Ndst = Ndst; j.batch = batch; j.mode = mode; j.sbs = sbs; j.dbs = dbs;
    j.tiles_per_mat = (K / 128) * (Ndst / 64); j.tile0 = 0; return j;
}
__device__ __forceinline__ void ph_convert(const Frame& F) {
    const bool split = F.G >= 256; const int VG = split ? F.G - 128 : F.G, vb_ = split ? F.bid - 128 : F.bid;
    int run = 0;
    if (vb_ >= 0) {
#define DO_JOB(J) do { const CvtJob jb = (J); const int nt_ = jb.tiles_per_mat * jb.batch; \
        int lt = (vb_ - (run % VG) + VG) % VG; f32x4 va[2][2], vb[2][2]; \
        if (lt < nt_) cvt_load(F, jb, lt, va); \
        for (; lt < nt_; lt += VG) { const int ltn = lt + VG; if (ltn < nt_) cvt_load(F, jb, ltn, vb); cvt_store(F, jb, lt, va); \
            _Pragma("unroll") for (int a_ = 0; a_ < 2; ++a_) _Pragma("unroll") for (int b_ = 0; b_ < 2; ++b_) va[a_][b_] = vb[a_][b_]; } \
        run += nt_; } while (0)
    DO_JOB(make_job(F.in[5], WSP(bf16_t, WS_WIN), 2048, IN_DIM, IN_PAD, 1, 0, 0, 0));
    DO_JOB(make_job(F.in[10], WSP(bf16_t, WS_WUQ), 768, 1536, 1536, 1, 0, 0, 0));
    DO_JOB(make_job(F.in[11], WSP(bf16_t, WS_WUKV), 512, 2048, 2048, 1, 0, 0, 0));
    DO_JOB(make_job(F.in[12], WSP(bf16_t, WS_WOUT), 2048, 2048, 2048, 1, 0, 0, 0));
#undef DO_JOB
    }
    bf16_t* wr = WSP(bf16_t, WS_WR);
    for (int idx = F.bid * NTHREADS + F.tid; idx < 2 * 256 * 2048; idx += F.G * NTHREADS) {
        const int l = idx >> 19, n = (idx >> 11) & 255, k = idx & 2047;
        bf16_t o = 0;
        if (n < 128) { const int e = n & 63;
            const float w = F.in[17][((size_t)l * 2048 + k) * 64 + e];
            const bf16_t hi = f2bf(w);
            o = (n < 64) ? hi : f2bf(w - bf2f(hi)); }
        wr[idx] = o;
    }
}

constexpr int MCV_CHUNK = 32;
constexpr int MCV_LAYER_TILES = 8192 + 128 + 4096 + 64;
constexpr int MCV_NMOE = 2 * MCV_LAYER_TILES / MCV_CHUNK;
constexpr int MCV_NCVT = MCV_NMOE + 20 + 16;
constexpr int MCV_NCHUNK = MCV_NCVT + 128;
__device__ __forceinline__ int grab(const Frame& F, unsigned* ctr) {
    LAS int* sl = (LAS int*)(F.aux + 16000);
    __syncthreads();
    if (F.tid == 0) *sl = (int)__hip_atomic_fetch_add(ctr, 1u, __ATOMIC_RELAXED, __HIP_MEMORY_SCOPE_AGENT);
    __syncthreads();
    return __builtin_amdgcn_readfirstlane(*sl);
}
__device__ __forceinline__ void moe_cvt_chunk(const Frame& F, int c) {
    if (c >= MCV_NCVT) { adaln_sc(F); adaln_unit(F, 128 + (c - MCV_NCVT)); return; }
    const int gt = c * MCV_CHUNK, l = gt / MCV_LAYER_TILES, r = gt - l * MCV_LAYER_TILES;
    CvtJob jb; int lt0;
    if (c >= MCV_NMOE + 20) { lt0 = (c - MCV_NMOE - 20) * MCV_CHUNK; jb = make_job(F.in[16], WSP(bf16_t, WS_WO), 2048, 2048, 2048, 1, 0, 0, 0); }
    else if (c >= MCV_NMOE) { lt0 = (c - MCV_NMOE) * MCV_CHUNK; jb = make_job(F.in[13], WSP(bf16_t, WS_WQKV), 2048, 2560, 2560, 1, 0, 0, 0); }
    else if (r < 8192) { lt0 = r; jb = make_job(F.in[19] + (size_t)l * 64 * 2048 * 512, WSP(bf16_t, WS_WGU) + (size_t)l * 65 * 512 * 2048, 2048, 512, 512, 64, 1, (size_t)2048 * 512, (size_t)512 * 2048); }
    else if (r < 8320) { lt0 = r - 8192; jb = make_job(F.in[21] + (size_t)l * 2048 * 512, WSP(bf16_t, WS_WGU) + ((size_t)l * 65 + 64) * 512 * 2048, 2048, 512, 512, 1, 1, 0, 0); }
    else if (r < 12416) { lt0 = r - 8320; jb = make_job(F.in[20] + (size_t)l * 64 * 256 * 2048, WSP(bf16_t, WS_WDN) + (size_t)l * 65 * 2048 * 256, 256, 2048, 2048, 64, 0, (size_t)256 * 2048, (size_t)2048 * 256); }
    else { lt0 = r - 12416; jb = make_job(F.in[22] + (size_t)l * 256 * 2048, WSP(bf16_t, WS_WDN) + ((size_t)l * 65 + 64) * 2048 * 256, 256, 2048, 2048, 1, 0, 0, 0); }
    f32x4 v0[2][2], v1[2][2], v2[2][2], v3[2][2];
    cvt_load(F, jb, lt0, v0); cvt_load(F, jb, lt0 + 1, v1); cvt_load(F, jb, lt0 + 2, v2);
#pragma unroll 1
    for (int i = 0; i < MCV_CHUNK; i += 4) {
        cvt_load(F, jb, lt0 + i + 3, v3); cvt_store(F, jb, lt0 + i, v0);
        if (i + 4 < MCV_CHUNK) cvt_load(F, jb, lt0 + i + 4, v0);
        cvt_store(F, jb, lt0 + i + 1, v1);
        if (i + 4 < MCV_CHUNK) cvt_load(F, jb, lt0 + i + 5, v1);
        cvt_store(F, jb, lt0 + i + 2, v2);
        if (i + 4 < MCV_CHUNK) cvt_load(F, jb, lt0 + i + 6, v2);
        cvt_store(F, jb, lt0 + i + 3, v3);
    }
}
__device__ __forceinline__ void moe_cvt_queue(const Frame& F) {
    unsigned* ctr = WSP(unsigned, WS_ZERO + ZB_CTR);
    for (;;) { const int c = grab(F, ctr); if (c >= MCV_NCHUNK) break; moe_cvt_chunk(F, c); }
}

template <int MODE>
__device__ __forceinline__ void ph_modulate(const Frame& F, const void* x, const float* shift, const float* scale, bf16_t* out) {
    f32x4 sc[8], sh[8];
#pragma unroll
    for (int j = 0; j < 8; ++j) { const int col = 4 * F.lane + 256 * j; sc[j] = *(const f32x4*)(scale + col) + 1.0f; sh[j] = *(const f32x4*)(shift + col); }
    for (int row = F.bid * 8 + F.wid; row < T; row += F.G * 8) {
        f32x4 v[8]; float ss = 0.f;
        if (MODE == 1) { u32x2 xw[8];
#pragma unroll
            for (int j = 0; j < 8; ++j) xw[j] = *(const u32x2*)((const bf16_t*)x + (size_t)row * D + 4 * F.lane + 256 * j);
#pragma unroll
            for (int j = 0; j < 8; ++j) v[j] = (f32x4){bflo(xw[j].x), bfhi(xw[j].x), bflo(xw[j].y), bfhi(xw[j].y)};
        }
#pragma unroll
        for (int j = 0; j < 8; ++j) { if (MODE == 0) v[j] = __builtin_nontemporal_load((const f32x4*)((const float*)x + (size_t)row * D + 4 * F.lane + 256 * j)); ss += v[j][0] * v[j][0] + v[j][1] * v[j][1] + v[j][2] * v[j][2] + v[j][3] * v[j][3]; }
        ss = wave_sum(ss);
        const float rstd = rsqrtf(ss * (1.0f / D) + EPS);
#pragma unroll
        for (int j = 0; j < 8; ++j) {
            const f32x4 h = (v[j] * rstd) * sc[j] + sh[j];
            const int col = 4 * F.lane + 256 * j;
            u32x2 hi; hi.x = cvt_pk_bf16(h[0], h[1]); hi.y = cvt_pk_bf16(h[2], h[3]);
            if (MODE == 0) { *(u32x2*)(out + (size_t)row * 2048 + col) = hi; }
            else {
                *(u32x2*)(out + (size_t)row * 2048 + col) = hi;
            }
        }
    }
}

typedef float f32x2_ __attribute__((ext_vector_type(2)));
template <int FINAL>
__device__ __forceinline__ void ph_combine(const Frame& F, const bf16_t* xold, const float* g, bf16_t* xnew, const float* shift, const float* scale, bf16_t* hout, float* fout) {
    const unsigned char* Y = WSP(unsigned char, WS_Y); const int* pslot = WSP(int, WS_PSLOT); const float* tkw = WSP(float, WS_TKW);
    for (int row = F.bid * 8 + F.wid; row < T; row += F.G * 8) {
        int sl[9]; float w[9];
#pragma unroll
        for (int k = 0; k < 8; ++k) { sl[k] = pslot[row * 8 + k]; w[k] = tkw[row * 8 + k] * (1.0f / 8.0f); }
        sl[8] = row; w[8] = 1.0f / 8.0f;
        float xn[2][16]; float ss = 0.f;
#pragma unroll
        for (int j = 0; j < 2; ++j) {
            const int col = 16 * F.lane + 1024 * j;
            float a[16];
#pragma unroll
            for (int e = 0; e < 16; ++e) a[e] = 0.f;
#pragma unroll
            for (int k = 0; k < 9; ++k) { const u32x4 y = __builtin_nontemporal_load((const u32x4*)(Y + (size_t)sl[k] * 2048 + col));
#pragma unroll
                for (int q = 0; q < 4; ++q) { const f32x2_ lo = __builtin_amdgcn_cvt_pk_f32_fp8((int)y[q], false), hi = __builtin_amdgcn_cvt_pk_f32_fp8((int)y[q], true);
                    a[4 * q + 0] += w[k] * lo[0]; a[4 * q + 1] += w[k] * lo[1]; a[4 * q + 2] += w[k] * hi[0]; a[4 * q + 3] += w[k] * hi[1]; } }
            const u32x4 xw0 = *(const u32x4*)(xold + (size_t)row * D + col), xw1 = *(const u32x4*)(xold + (size_t)row * D + col + 8);
            const unsigned xw[8] = {xw0.x, xw0.y, xw0.z, xw0.w, xw1.x, xw1.y, xw1.z, xw1.w};
#pragma unroll
            for (int q = 0; q < 4; ++q) { const f32x4 x0 = (f32x4){bflo(xw[2 * q]), bfhi(xw[2 * q]), bflo(xw[2 * q + 1]), bfhi(xw[2 * q + 1])}; const f32x4 g0 = *(const f32x4*)(g + col + 4 * q);
#pragma unroll
                for (int e = 0; e < 4; ++e) { const float v = x0[e] + g0[e] * a[4 * q + e]; xn[j][4 * q + e] = v; ss += v * v; } }
            if (!FINAL) { u32x4 o0, o1; o0.x = cvt_pk_bf16(xn[j][0], xn[j][1]); o0.y = cvt_pk_bf16(xn[j][2], xn[j][3]); o0.z = cvt_pk_bf16(xn[j][4], xn[j][5]); o0.w = cvt_pk_bf16(xn[j][6], xn[j][7]);
                o1.x = cvt_pk_bf16(xn[j][8], xn[j][9]); o1.y = cvt_pk_bf16(xn[j][10], xn[j][11]); o1.z = cvt_pk_bf16(xn[j][12], xn[j][13]); o1.w = cvt_pk_bf16(xn[j][14], xn[j][15]);
                *(u32x4*)(xnew + (size_t)row * D + col) = o0; *(u32x4*)(xnew + (size_t)row * D + col + 8) = o1; }
        }
        ss = wave_sum(ss);
        const float rstd = rsqrtf(ss * (1.0f / D) + EPS);
#pragma unroll
        for (int j = 0; j < 2; ++j) {
            const int col = 16 * F.lane + 1024 * j;
            float h[16];
#pragma unroll
            for (int q = 0; q < 4; ++q) { const f32x4 s0 = *(const f32x4*)(scale + col + 4 * q);
                if (FINAL) { f32x4 o0;
#pragma unroll
                    for (int e = 0; e < 4; ++e) o0[e] = xn[j][4 * q + e] * rstd * s0[e];
                    *(f32x4*)(fout + (size_t)row * D + col + 4 * q) = o0; }
                else { const f32x4 h0 = *(const f32x4*)(shift + col + 4 * q);
#pragma unroll
                    for (int e = 0; e < 4; ++e) h[4 * q + e] = xn[j][4 * q + e] * rstd * (1.0f + s0[e]) + h0[e]; } }
            if (!FINAL) { u32x4 o0, o1; o0.x = cvt_pk_bf16(h[0], h[1]); o0.y = cvt_pk_bf16(h[2], h[3]); o0.z = cvt_pk_bf16(h[4], h[5]); o0.w = cvt_pk_bf16(h[6], h[7]);
                o1.x = cvt_pk_bf16(h[8], h[9]); o1.y = cvt_pk_bf16(h[10], h[11]); o1.z = cvt_pk_bf16(h[12], h[13]); o1.w = cvt_pk_bf16(h[14], h[15]);
                *(u32x4*)(hout + (size_t)row * 2048 + col) = o0; *(u32x4*)(hout + (size_t)row * 2048 + col + 8) = o1; }
        }
    }
}

using pg8::Unit;
template <bool NT>
__device__ __forceinline__ void store_bf16_tile(const f32x4 (&acc)[2][2][4][2], bf16_t* O, int ldc, int row0, int col0, const float* bias, int bcol0, int wr, int wc, int fr, int fq) {
    const int r0 = row0 + wr * 64 + fr, c0 = col0 + wc * 32 + 8 * fq, bc0 = bcol0 + wc * 32 + 8 * fq;
    f32x4 bv[2][2];
#pragma unroll
    for (int bj = 0; bj < 2; ++bj)
#pragma unroll
        for (int n = 0; n < 2; ++n) bv[bj][n] = bias ? *(const f32x4*)(bias + bc0 + bj * 128 + 4 * n) : (f32x4){0.f, 0.f, 0.f, 0.f};
#pragma unroll
    for (int ai = 0; ai < 2; ++ai)
#pragma unroll
        for (int m = 0; m < 4; ++m) { bf16_t* rowp = O + (size_t)(r0 + ai * 128 + m * 16) * ldc + c0;
#pragma unroll
            for (int bj = 0; bj < 2; ++bj) { const f32x4 v0 = acc[ai][bj][m][0] + bv[bj][0], v1 = acc[ai][bj][m][1] + bv[bj][1];
                u32x4 w; w.x = cvt_pk_bf16(v0[0], v0[1]); w.y = cvt_pk_bf16(v0[2], v0[3]); w.z = cvt_pk_bf16(v1[0], v1[1]); w.w = cvt_pk_bf16(v1[2], v1[3]);
                if (NT) __builtin_nontemporal_store(w, (u32x4*)(rowp + bj * 128)); else *(u32x4*)(rowp + bj * 128) = w; } }
}

struct PolDenseBase {
    const bf16_t* A; const bf16_t* Bt; int lda, ldb, K, nM, nN;
    __device__ __forceinline__ int nunits() const { return nM * nN; }
    __device__ __forceinline__ int first() const { return blockIdx.x; }
    __device__ __forceinline__ int stride() const { return gridDim.x; }
    __device__ __forceinline__ void unit(int L, Unit& u) const {
#if DENSE_XCD
        const int nwg = nM * nN; int wgid = L;
        if ((gridDim.x & 7) == 0) { const int q = nwg / 8, r = nwg % 8, xcd = wgid % 8, off = wgid / 8; wgid = (xcd < r ? xcd * (q + 1) : r * (q + 1) + (xcd - r) * q) + off; }
        const int nig = 8 * nN, gid = wgid / nig, fm = gid * 8, gsz = (nM - fm) < 8 ? (nM - fm) : 8;
        u.a = fm + ((wgid % nig) % gsz); u.b = (wgid % nig) / gsz; u.c = 0; u.d = 0;
#else
        u.a = L / nN; u.b = L - u.a * nN; u.c = 0; u.d = 0;
#endif
    }
    __device__ __forceinline__ const char* abase() const { return (const char*)A; }
    __device__ __forceinline__ void a_off(const Unit& u, const int (&R)[2], const int (&C)[2], unsigned (&off)[2][2]) const {
#pragma unroll
        for (int h = 0; h < 2; ++h)
#pragma unroll
            for (int i = 0; i < 2; ++i) off[h][i] = (unsigned)((u.a * 256 + h * 128 + R[i]) * lda + C[i]) * 2u;
    }
    __device__ __forceinline__ const char* bbase(const Unit& u) const { return (const char*)(Bt + (size_t)u.b * 256 * ldb); }
};
struct PolBf16 : PolDenseBase {
    static constexpr bool PERM = true;
    bf16_t* O; int ldc; const float* bias;
    __device__ __forceinline__ void epi(const f32x4 (&acc)[2][2][4][2], const Unit& u, int wr, int wc, int fr, int fq) const {
        store_bf16_tile<false>(acc, O, ldc, u.a * 256, u.b * 256, bias, u.b * 256, wr, wc, fr, fq);
    }
};
template <bool XIN_BF16>
struct PolResid : PolDenseBase {
    static constexpr bool PERM = true;
    const void* xin; const float* g; bf16_t* xout;
    __device__ __forceinline__ void epi(const f32x4 (&acc)[2][2][4][2], const Unit& u, int wr, int wc, int fr, int fq) const {
        const int row0 = u.a * 256 + wr * 64 + fr, col0 = u.b * 256 + wc * 32 + 8 * fq;
        f32x4 gv[2][2];
#pragma unroll
        for (int bj = 0; bj < 2; ++bj)
#pragma unroll
            for (int n = 0; n < 2; ++n) gv[bj][n] = *(const f32x4*)(g + col0 + bj * 128 + n * 4);
#pragma unroll
        for (int ai = 0; ai < 2; ++ai)
#pragma unroll
            for (int mp = 0; mp < 2; ++mp) {
                f32x4 xi[2][2][2];
                if (XIN_BF16) {
                    u32x4 xw[2][2];
#pragma unroll
                    for (int mm = 0; mm < 2; ++mm) { const size_t ro = (size_t)(row0 + ai * 128 + (mp * 2 + mm) * 16) * D + col0;
#pragma unroll
                        for (int bj = 0; bj < 2; ++bj) xw[mm][bj] = *(const u32x4*)((const bf16_t*)xin + ro + bj * 128); }
                    __builtin_amdgcn_sched_barrier(0);
#pragma unroll
                    for (int mm = 0; mm < 2; ++mm)
#pragma unroll
                        for (int bj = 0; bj < 2; ++bj) { xi[mm][bj][0] = (f32x4){bflo(xw[mm][bj].x), bfhi(xw[mm][bj].x), bflo(xw[mm][bj].y), bfhi(xw[mm][bj].y)};
                            xi[mm][bj][1] = (f32x4){bflo(xw[mm][bj].z), bfhi(xw[mm][bj].z), bflo(xw[mm][bj].w), bfhi(xw[mm][bj].w)}; }
                } else {
#pragma unroll
                    for (int mm = 0; mm < 2; ++mm) { const size_t ro = (size_t)(row0 + ai * 128 + (mp * 2 + mm) * 16) * D + col0;
#pragma unroll
                        for (int bj = 0; bj < 2; ++bj)
#pragma unroll
                            for (int n = 0; n < 2; ++n) xi[mm][bj][n] = *(const f32x4*)((const float*)xin + ro + bj * 128 + n * 4); }
                    __builtin_amdgcn_sched_barrier(0);
                }
#pragma unroll
                for (int mm = 0; mm < 2; ++mm) { const size_t ro = (size_t)(row0 + ai * 128 + (mp * 2 + mm) * 16) * D + col0;
#pragma unroll
                    for (int bj = 0; bj < 2; ++bj) { const f32x4 v0 = xi[mm][bj][0] + gv[bj][0] * acc[ai][bj][mp * 2 + mm][0], v1 = xi[mm][bj][1] + gv[bj][1] * acc[ai][bj][mp * 2 + mm][1];
                        u32x4 w; w.x = cvt_pk_bf16(v0[0], v0[1]); w.y = cvt_pk_bf16(v0[2], v0[3]); w.z = cvt_pk_bf16(v1[0], v1[1]); w.w = cvt_pk_bf16(v1[2], v1[3]);
                        *(u32x4*)(xout + ro + bj * 128) = w; } }
                __builtin_amdgcn_sched_barrier(0);
            }
    }
};
struct PolRouter {
    static constexpr bool PERM = false;
    const bf16_t* A; const bf16_t* Bt; float* part; int K, ldb;
    __device__ __forceinline__ int nunits() const { return 64 * 4; }
    __device__ __forceinline__ int first() const { return blockIdx.x; }
    __device__ __forceinline__ int stride() const { return gridDim.x; }
    __device__ __forceinline__ void unit(int L, Unit& u) const { u.a = L >> 2; u.b = L & 3; u.c = 0; u.d = 0; }
    __device__ __forceinline__ const char* abase() const { return (const char*)A; }
    __device__ __forceinline__ void a_off(const Unit& u, const int (&R)[2], const int (&C)[2], unsigned (&off)[2][2]) const {
#pragma unroll
        for (int h = 0; h < 2; ++h)
#pragma unroll
            for (int i = 0; i < 2; ++i) off[h][i] = (unsigned)((u.a * 256 + h * 128 + R[i]) * 2048 + u.b * 512 + C[i]) * 2u;
    }
    __device__ __forceinline__ const char* bbase(const Unit& u) const { return (const char*)(Bt + (size_t)u.b * 512); }
    __device__ __forceinline__ void epi(const f32x4 (&acc)[2][2][4][2], const Unit& u, int wr, int wc, int fr, int fq) const {
        const int row0 = u.a * 256 + wr * 64 + fr, col0 = wc * 32 + 4 * fq;
        float* P = part + (size_t)u.b * T * 128;
#pragma unroll
        for (int ai = 0; ai < 2; ++ai)
#pragma unroll
            for (int m = 0; m < 4; ++m)
#pragma unroll
                for (int n = 0; n < 2; ++n) *(f32x4*)(P + (size_t)(row0 + ai * 128 + m * 16) * 128 + col0 + n * 16) = acc[ai][0][m][n];
    }
};
struct MoeTab { const LAS int* blk_e; const LAS int* blk_row0; int rb0, nrb, rank, nrank; };
__device__ __forceinline__ void moe_decode(const MoeTab& tb, int j, int NT, Unit& u) {
    const int rbl = j / NT, pn = j - rbl * NT, rb = tb.rb0 + rbl;
    u.a = tb.blk_row0[rb]; u.b = pn; u.c = tb.blk_e[rb]; u.d = 0;
}
struct PolGateUp {
    static constexpr bool PERM = true;
    const bf16_t* A; const bf16_t* W; const int* rowtok; bf16_t* act; MoeTab tb; int K, ldb; const LAS int* ridx;
    __device__ __forceinline__ int nunits() const { return tb.nrb * 2; }
    __device__ __forceinline__ int first() const { return tb.rank; }
    __device__ __forceinline__ int stride() const { return tb.nrank; }
    __device__ __forceinline__ void unit(int L, Unit& u) const { moe_decode(tb, L, 2, u); u.d = (L - tb.rank) / tb.nrank; }
    __device__ __forceinline__ const char* abase() const { return (const char*)A; }
    __device__ __forceinline__ void a_off(const Unit& u, const int (&R)[2], const int (&C)[2], unsigned (&off)[2][2]) const {
#pragma unroll
        for (int h = 0; h < 2; ++h)
#pragma unroll
            for (int i = 0; i < 2; ++i) { const int tok = (u.d < 8) ? ridx[u.d * 256 + h * 128 + R[i]] : rowtok[u.a + h * 128 + R[i]]; off[h][i] = (unsigned)(tok * 2048 + C[i]) * 2u; }
    }
    __device__ __forceinline__ const char* bbase(const Unit& u) const { return (const char*)(W + ((size_t)u.c * 512 + (size_t)u.b * 256) * 2048); }
    __device__ __forceinline__ void epi(const f32x4 (&acc)[2][2][4][2], const Unit& u, int wr, int wc, int fr, int fq) const {
        const int r0 = u.a + wr * 64 + fr, c0 = u.b * 128 + wc * 32 + 8 * fq;
#pragma unroll
        for (int ai = 0; ai < 2; ++ai)
#pragma unroll
            for (int m = 0; m < 4; ++m) {
                float o[8];
#pragma unroll
                for (int n = 0; n < 2; ++n)
#pragma unroll
                    for (int e = 0; e < 4; ++e) { const float gt = acc[ai][0][m][n][e], up = acc[ai][1][m][n][e]; o[n * 4 + e] = gt / (1.0f + __expf(-gt)) * up; }
                u32x4 w; w.x = cvt_pk_bf16(o[0], o[1]); w.y = cvt_pk_bf16(o[2], o[3]); w.z = cvt_pk_bf16(o[4], o[5]); w.w = cvt_pk_bf16(o[6], o[7]);
                *(u32x4*)(act + (size_t)(r0 + ai * 128 + m * 16) * 256 + c0) = w; }
    }
};
constexpr float Y_SCALE = 8.0f;
struct PolDown {
    static constexpr bool PERM = true;
    const bf16_t* A; const bf16_t* W; unsigned char* Y; MoeTab tb; int K, ldb; int nostore;
    __device__ __forceinline__ int nunits() const { return tb.nrb * 8; }
    __device__ __forceinline__ int first() const { return tb.rank; }
    __device__ __forceinline__ int stride() const { return tb.nrank; }
    __device__ __forceinline__ void unit(int L, Unit& u) const { moe_decode(tb, L, 8, u); }
    __device__ __forceinline__ const char* abase() const { return (const char*)A; }
    __device__ __forceinline__ void a_off(const Unit& u, const int (&R)[2], const int (&C)[2], unsigned (&off)[2][2]) const {
#pragma unroll
        for (int h = 0; h < 2; ++h)
#pragma unroll
            for (int i = 0; i < 2; ++i) off[h][i] = (unsigned)((u.a + h * 128 + R[i]) * 256 + C[i]) * 2u;
    }
    __device__ __forceinline__ const char* bbase(const Unit& u) const { return (const char*)(W + ((size_t)u.c * 2048 + (size_t)u.b * 256) * 256); }
    __device__ __forceinline__ void epi(const f32x4 (&acc)[2][2][4][2], const Unit& u, int wr, int wc, int fr, int fq) const {
        const int odd = fq & 1, pq = fq >> 1;
#pragma unroll
        for (int ai = 0; ai < 2; ++ai)
#pragma unroll
            for (int bj = 0; bj < 2; ++bj) {
                int D[4][2];
#pragma unroll
                for (int m = 0; m < 4; ++m)
#pragma unroll
                    for (int n = 0; n < 2; ++n) { const f32x4 v = acc[ai][bj][m][n] * Y_SCALE; int w_ = __builtin_amdgcn_cvt_pk_fp8_f32(v[0], v[1], 0, false); D[m][n] = __builtin_amdgcn_cvt_pk_fp8_f32(v[2], v[3], w_, true); }
#pragma unroll
                for (int pr = 0; pr < 2; ++pr) {
                    const int s0 = odd ? D[2 * pr][0] : D[2 * pr + 1][0], s1 = odd ? D[2 * pr][1] : D[2 * pr + 1][1];
                    const int r0 = __shfl_xor(s0, 16), r1 = __shfl_xor(s1, 16);
                    u32x4 w;
                    if (odd) { w.x = (unsigned)r0; w.y = (unsigned)r1; w.z = (unsigned)D[2 * pr + 1][0]; w.w = (unsigned)D[2 * pr + 1][1]; }
                    else { w.x = (unsigned)D[2 * pr][0]; w.y = (unsigned)D[2 * pr][1]; w.z = (unsigned)r0; w.w = (unsigned)r1; }
                    const int row = u.a + ai * 128 + wr * 64 + (2 * pr + odd) * 16 + fr, col = u.b * 256 + bj * 128 + wc * 32 + pq * 16;
                    if (!nostore) { if (NT_STORES) __builtin_nontemporal_store(w, (u32x4*)(Y + (size_t)row * 2048 + col)); else *(u32x4*)(Y + (size_t)row * 2048 + col) = w; } else asm volatile("" :: "v"(w));
                }
            }
    }
};


__device__ __forceinline__ void ph_route(const Frame& F, int layer) {
    const float* part = WSP(float, WS_LOGP); const float* rbias = F.in[18] + layer * 64;
    int* tki = WSP(int, WS_TKI); float* tkw = WSP(float, WS_TKW); int* hist = WSP(int, WS_HIST);
    LAS int* lh = (LAS int*)F.aux;
    const int lane = F.lane; const int g = lane >> 3;
    const float bia = rbias[lane];
    for (int tb = F.bid; tb < 256; tb += F.G) {
        if (F.tid < 64) lh[F.tid] = 0;
        __syncthreads();
        float pv[8][8];
#pragma unroll
        for (int ti = 0; ti < 8; ++ti) { const int t = tb * 64 + F.wid * 8 + ti;
#pragma unroll
            for (int ks = 0; ks < 4; ++ks) { const float* pr = part + ((size_t)ks * T + t) * 128; pv[ti][2 * ks] = pr[lane]; pv[ti][2 * ks + 1] = pr[64 + lane]; } }
#pragma unroll
        for (int ti = 0; ti < 8; ++ti) {
            const int t = tb * 64 + F.wid * 8 + ti;
            float logit = 0.f;
#pragma unroll
            for (int ks = 0; ks < 4; ++ks) logit += pv[ti][2 * ks] + pv[ti][2 * ks + 1];
            const float score = 1.0f / (1.0f + expf(-logit));
            const float biased = score + bia;
            const float m1 = grp8_max(biased);
            const unsigned long long eqm = __ballot(biased == m1);
            const unsigned long long gm = eqm & (0xFFull << (8 * g));
            const int first = __builtin_ctzll(gm);
            const float v2 = grp8_max((lane == first) ? -__builtin_inff() : biased);
            const float gs = m1 + v2;
            int cnt = 0;
#pragma unroll
            for (int gg = 0; gg < 8; ++gg) { const float o = __int_as_float(__builtin_amdgcn_readlane(__float_as_int(gs), 8 * gg)); cnt += ((o > gs) || (o == gs && gg < g)) ? 1 : 0; }
            const bool sel = cnt < 4;
            const float masked = sel ? biased : -__builtin_inff();
            int rank = 0;
#pragma unroll
            for (int l = 0; l < 64; ++l) { const float o = __int_as_float(__builtin_amdgcn_readlane(__float_as_int(masked), l)); rank += ((o > masked) || (o == masked && l < lane)) ? 1 : 0; }
            const bool chosen = sel && rank < 8;
            const float wsum = wave_sum(chosen ? score : 0.f);
            if (chosen) { tki[t * 8 + rank] = lane; tkw[t * 8 + rank] = score / wsum * 2.5f; (void)__hip_atomic_fetch_add(lh + lane, 1, __ATOMIC_RELAXED, __HIP_MEMORY_SCOPE_WORKGROUP); }
        }
        __syncthreads();
        if (F.tid < 64) hist[tb * 64 + F.tid] = lh[F.tid];
        __syncthreads();
    }
}

__device__ __forceinline__ void ph_dispatch(const Frame& F) {
    const int* hist = WSP(int, WS_HIST); const int* tki = WSP(int, WS_TKI);
    int* pslot = WSP(int, WS_PSLOT); int* rowtok = WSP(int, WS_ROWTOK); int* etab = WSP(int, WS_ETAB);
    LAS int* tot = (LAS int*)F.aux; LAS int* pre = tot + 64; LAS int* eoff = tot + 128; LAS int* cursor = tot + 192;
    LAS int* ps = tot + 256;
    LAS int* wc = tot + 1280;
    for (int tb = F.bid; tb < 256; tb += F.G) {
        __syncthreads();
        {
            const int e = F.tid & 63, gq = F.tid >> 6;
            int hv[32];
#pragma unroll
            for (int b = 0; b < 32; ++b) hv[b] = hist[(gq * 32 + b) * 64 + e];
            int s_ = 0, p_ = 0;
#pragma unroll
            for (int b = 0; b < 32; ++b) { s_ += hv[b]; p_ += (gq * 32 + b < tb) ? hv[b] : 0; }
            ps[gq * 64 + e] = s_; ps[512 + gq * 64 + e] = p_; wc[F.tid] = 0;
        }
        __syncthreads();
        if (F.tid < 64) { int s_ = 0, p_ = 0;
#pragma unroll
            for (int q = 0; q < 8; ++q) { s_ += ps[q * 64 + F.tid]; p_ += ps[512 + q * 64 + F.tid]; }
            tot[F.tid] = s_; pre[F.tid] = p_;
            const int pad = (s_ + 255) & ~255; const int off = T + wave_incl_scan(pad, F.tid) - pad;
            eoff[F.tid] = off; cursor[F.tid] = off + p_;
            if (tb == 0) { etab[F.tid] = off; etab[64 + F.tid] = s_; } }
        { const int t = tb * 64 + (F.tid >> 3), k = F.tid & 7; const int e = tki[t * 8 + k];
          int rnk = 0;
#pragma unroll 8
          for (int l = 0; l < 64; ++l) { const int o = __builtin_amdgcn_readlane(e, l); rnk += (o == e && l < F.lane) ? 1 : 0; }
          (void)__hip_atomic_fetch_add(wc + F.wid * 64 + e, 1, __ATOMIC_RELAXED, __HIP_MEMORY_SCOPE_WORKGROUP);
          __syncthreads();
          for (int w = 0; w < F.wid; ++w) rnk += wc[w * 64 + e];
          const int slot = cursor[e] + rnk; rowtok[slot] = t; pslot[t * 8 + k] = slot; }
        if (F.tid < 64) rowtok[tb * 64 + F.tid] = tb * 64 + F.tid;
        if (tb < 64) { const int e = tb; const int beg = eoff[e] + tot[e], end = eoff[e] + ((tot[e] + 255) & ~255); for (int s = beg + F.tid; s < end; s += NTHREADS) rowtok[s] = 0; }
        __syncthreads();
    }
}

__device__ __forceinline__ MoeTab moe_tables(const Frame& F) {
    const int* etab = WSP(int, WS_ETAB);
    LAS int* blk_e = (LAS int*)F.aux; LAS int* blk_row0 = blk_e + 640; LAS int* pre = blk_e + 1280;
    __syncthreads();
    if (F.tid < 64) { blk_e[F.tid] = 64; blk_row0[F.tid] = F.tid * 256; }
    if (F.tid < 64) { const int nb_ = (etab[64 + F.tid] + 255) >> 8, inc = wave_incl_scan(nb_, F.tid); pre[F.tid] = inc - nb_; if (F.tid == 63) pre[64] = inc; }
    __syncthreads();
    if (F.tid < 64) { const int e = F.tid, nb = (etab[64 + e] + 255) >> 8, b0 = 64 + pre[e], r0 = etab[e]; for (int i = 0; i < nb; ++i) { blk_e[b0 + i] = e; blk_row0[b0 + i] = r0 + i * 256; } }
    __syncthreads();
    const int nblk = 64 + pre[64];
    const int ng = ((F.G & 7) == 0) ? 8 : 1, x = F.bid % ng;
    MoeTab tb; tb.blk_e = blk_e; tb.blk_row0 = blk_row0;
    tb.rb0 = (int)(((long)nblk * x) / ng); tb.nrb = (int)(((long)nblk * (x + 1)) / ng) - tb.rb0; tb.rank = F.bid / ng; tb.nrank = F.G / ng;
    return tb;
}

#define SBAR() __builtin_amdgcn_sched_barrier(0)
__device__ __forceinline__ int v_st(int k, int c) { const int kk = (k & ~0xC) | ((k & 4) << 1) | ((k & 8) >> 1); return ((kk >> 3) * 4 + (c >> 5)) * 512 + ((kk & 7) * 32 + (c & 31)) * 2; }
__device__ __forceinline__ int v_rd_base(int lane) { return ((lane & 3) << 3) | (((lane >> 2) & 3) << 6) | (((lane >> 4) & 1) << 5) | (((lane >> 5) & 1) << 8); }
constexpr int v_rd_off(int d0, int ks, int half) { return d0 * 512 + ks * 4096 + half * 2048; }
__device__ __forceinline__ int crow(int r, int hi) { return (r & 3) + 8 * (r >> 2) + 4 * hi; }
template <int OFF> __device__ __forceinline__ s16x4 trrd(int base) { s16x4 d; asm volatile("ds_read_b64_tr_b16 %0, %1 offset:%2" : "=&v"(d) : "v"(base), "i"(OFF) : "memory"); return d; }
#define LGKM0() asm volatile("s_waitcnt lgkmcnt(0)" ::: "memory")
#define ROPE2(W0, W1, CS, O0, O1) do { const float a0 = bflo(W0), a1 = bfhi(W0), b0_ = bflo(W1), b1_ = bfhi(W1); \
    O0 = cvt_pk_bf16(a0 * CS[0] - b0_ * CS[1], a1 * CS[2] - b1_ * CS[3]); O1 = cvt_pk_bf16(b0_ * CS[0] + a0 * CS[1], b1_ * CS[2] + a1 * CS[3]); } while (0)
__device__ __forceinline__ bf16x8 cat44(s16x4 l, s16x4 h) { return (bf16x8){l[0], l[1], l[2], l[3], h[0], h[1], h[2], h[3]}; }

__device__ __forceinline__ void mask_tile(f32x16& p0, f32x16& p1, int dq, unsigned W) {
    const float NEG = -__builtin_inff();
#pragma unroll
    for (int r = 0; r < 16; ++r) {
        const int c = (r & 3) + 8 * (r >> 2);
        if ((unsigned)(dq - c) >= W) p0[r] = NEG;
        if ((unsigned)(dq - c - 32) >= W) p1[r] = NEG;
    }
}
__device__ __forceinline__ float softmax_tile(f32x16& p0, f32x16& p1, float& m_reg, float& l_reg, float C2, bf16x8& pa0, bf16x8& pa1, bf16x8& pa2, bf16x8& pa3) {
    float pmax = p0[0];
#pragma unroll
    for (int r = 1; r < 16; ++r) pmax = fmaxf(pmax, p0[r]);
#pragma unroll
    for (int r = 0; r < 16; ++r) pmax = fmaxf(pmax, p1[r]);
    { auto rr = __builtin_amdgcn_permlane32_swap(__float_as_uint(pmax), __float_as_uint(pmax), false, false);
      pmax = fmaxf(__uint_as_float(rr[0]), __uint_as_float(rr[1])); }
    float mn, alpha;
    if (__all((pmax - m_reg) * C2 <= 11.5f)) { mn = m_reg; alpha = 1.f; }
    else { mn = fmaxf(m_reg, pmax); alpha = __builtin_amdgcn_exp2f((m_reg - mn) * C2); m_reg = mn; }
    const float mnL = -mn * C2;
    float ps = 0.f;
#pragma unroll
    for (int r = 0; r < 16; ++r) { p0[r] = __builtin_amdgcn_exp2f(fmaf(p0[r], C2, mnL)); ps += p0[r]; }
#pragma unroll
    for (int r = 0; r < 16; ++r) { p1[r] = __builtin_amdgcn_exp2f(fmaf(p1[r], C2, mnL)); ps += p1[r]; }
    { auto rr = __builtin_amdgcn_permlane32_swap(__float_as_uint(ps), __float_as_uint(ps), false, false);
      ps = __uint_as_float(rr[0]) + __uint_as_float(rr[1]); }
    l_reg = l_reg * alpha + ps;
#define PK4(P, B_, OUT) do { unsigned a0 = cvt_pk_bf16(P[B_+0], P[B_+1]), a1 = cvt_pk_bf16(P[B_+2], P[B_+3]);                          \
        unsigned b0 = cvt_pk_bf16(P[B_+4], P[B_+5]), b1 = cvt_pk_bf16(P[B_+6], P[B_+7]);                                             \
        auto r0 = __builtin_amdgcn_permlane32_swap(a0, b0, false, false); auto r1 = __builtin_amdgcn_permlane32_swap(a1, b1, false, false); \
        u32x4 w = {r0[0], r1[0], r0[1], r1[1]}; OUT = *reinterpret_cast<bf16x8*>(&w); } while (0)
    PK4(p0, 0, pa0); PK4(p0, 8, pa1); PK4(p1, 0, pa2); PK4(p1, 8, pa3);
    return alpha;
}
template <int VOFF, int ND0, int KG = 2048>
__device__ __forceinline__ void pv_tile(f32x16* o, int vb, bf16x8 pa0, bf16x8 pa1, bf16x8 pa2, bf16x8 pa3) {
#define PV_D0(d0) do { s16x4 l0, l1, l2, l3, h0, h1, h2, h3; constexpr int b_ = VOFF + d0 * 512; \
        l0 = trrd<b_>(vb); h0 = trrd<b_ + KG>(vb); l1 = trrd<b_ + 2 * KG>(vb); h1 = trrd<b_ + 3 * KG>(vb); l2 = trrd<b_ + 4 * KG>(vb); h2 = trrd<b_ + 5 * KG>(vb); l3 = trrd<b_ + 6 * KG>(vb); h3 = trrd<b_ + 7 * KG>(vb); \
        LGKM0(); SBAR(); \
        o[d0] = __builtin_amdgcn_mfma_f32_32x32x16_bf16(pa0, cat44(l0, h0), o[d0], 0, 0, 0); \
        o[d0] = __builtin_amdgcn_mfma_f32_32x32x16_bf16(pa1, cat44(l1, h1), o[d0], 0, 0, 0); \
        o[d0] = __builtin_amdgcn_mfma_f32_32x32x16_bf16(pa2, cat44(l2, h2), o[d0], 0, 0, 0); \
        o[d0] = __builtin_amdgcn_mfma_f32_32x32x16_bf16(pa3, cat44(l3, h3), o[d0], 0, 0, 0); } while (0)
    PV_D0(0); PV_D0(1);
    if (ND0 > 2) { PV_D0(2); PV_D0(3); }
#undef PV_D0
}

template <int DQK, int DV, int D2>
struct AttnBlk {
    static constexpr int RB = DQK * 2, KBYTES = 64 * RB, VBYTES = 16384, KOFF = 0, VOFF = 2 * KBYTES, SOFF = VOFF + 3 * VBYTES;
    static constexpr int NC = DQK / 16, ND0 = DV / 32, KPIECES = 64 * DQK / 8, KPT = KPIECES / NTHREADS, VPIECES = 64 * DV / 8, VPT = (VPIECES + NTHREADS - 1) / NTHREADS, PPR = DQK / 8, VPR = DV / 8;
    const bf16_t* Q; int ldq; const bf16_t* K1; int ldk1; const bf16_t* K2; int ldk2; const bf16_t* V; int ldv; bf16_t* O; int ldo;
    float C2; float m_init; float l_init; unsigned W;
    int wrow; int wq; int wo; const float* sinks; float sink_scale; const float2* ropeq;

    struct StageOffs { unsigned ko[KPT]; unsigned vo[1]; };
    __device__ __forceinline__ void stage_setup(StageOffs& so_, int tid) const {
#pragma unroll
        for (int i = 0; i < KPT; ++i) { const int p = tid + NTHREADS * i, row = p / PPR, sp = p - row * PPR;
            const int pc = (sp & ~7) | ((sp ^ (row >> 1)) & 7);
            const bool k1 = (D2 == 0 || pc < (DQK - D2) / 8);
            so_.ko[i] = k1 ? (unsigned)(row * ldk1 + pc * 8) * 2u : ((unsigned)(row * ldk2 + (pc - (DQK - D2) / 8) * 8) * 2u) | 0x80000000u; }
        { const int p = tid;
            const int off = p * 16, sub = off >> 9, g8 = sub >> 2, cblk = sub & 3, rem = (off & 511) >> 1, kkl = rem >> 5, cl = rem & 31;
            const int kk = g8 * 8 + kkl, k = (kk & ~0xC) | ((kk & 4) << 1) | ((kk & 8) >> 1), c = cblk * 32 + cl;
            so_.vo[0] = (unsigned)(k * ldv + c) * 2u; }
    }
    __device__ __forceinline__ void stage_tile(LAS unsigned char* lds, int kbuf, int vbuf, int kb, const StageOffs& so_, int tid, int wid) const {
        const char* kb1 = (const char*)(K1 + (size_t)kb * ldk1); const char* kb2 = (const char*)(K2 + (size_t)kb * ldk2); const char* vbp = (const char*)(V + (size_t)kb * ldv);
#pragma unroll
        for (int i = 0; i < KPT; ++i) {
            const unsigned o_ = so_.ko[i]; LAS unsigned* dst_ = (LAS unsigned*)(lds + KOFF + kbuf * KBYTES + (NTHREADS * i + 64 * wid) * 16);
            if (D2 == 0 || !(o_ >> 31)) __builtin_amdgcn_global_load_lds((const unsigned*)(kb1 + o_), dst_, 16, 0, 0);
            else __builtin_amdgcn_global_load_lds((const unsigned*)(kb2 + (o_ & 0x7fffffffu)), dst_, 16, 0, 0); }
#pragma unroll
        for (int i = 0; i < VPT; ++i) { const int p = tid + NTHREADS * i;
            if (VPIECES >= NTHREADS * (i + 1) || p < VPIECES)
                __builtin_amdgcn_global_load_lds((const unsigned*)(vbp + (size_t)i * 32 * ldv * 2 + so_.vo[0]), (LAS unsigned*)(lds + VOFF + vbuf * VBYTES + (NTHREADS * i + 64 * wid) * 16), 16, 0, 0); }
    }
    __device__ __forceinline__ void run(LAS unsigned char* lds, int P0, int j_lo, int j_hi) const {
        const int tid = threadIdx.x, wid = __builtin_amdgcn_readfirstlane(tid >> 6), lane = tid & 63, r32 = lane & 31, hi = lane >> 5;
        const int qlo = P0 + wid * 32, qm = qlo + r32 - 4 * hi;
        const bool grpB = ATT_STAGGER && wid >= 4;
        LAS float* ws = (LAS float*)(lds + SOFF) + wid * 64; LAS float* li_l = ws; LAS float* al_l = ws + 32;
        bf16x8 qr[NC];
#pragma unroll
        for (int c = 0; c < NC; ++c) qr[c] = *(const bf16x8*)(Q + (size_t)(qlo + r32) * ldq + c * 16 + hi * 8);
        if (NC == 12 && ropeq) {
            const float2* rp = ropeq + (size_t)(qlo + r32) * 32 + hi * 8;
#pragma unroll
            for (int cc = 0; cc < 2; ++cc) {
                const f32x4* cs = (const f32x4*)(rp + cc * 16);
                const f32x4 c0 = cs[0], c1 = cs[1], c2 = cs[2], c3 = cs[3];
                const u32x4 a = __builtin_bit_cast(u32x4, qr[(NC == 12 ? 8 : 0) + cc]), b = __builtin_bit_cast(u32x4, qr[(NC == 12 ? 10 : 0) + cc]);
                u32x4 ra, rb_;
                ROPE2(a.x, b.x, c0, ra.x, rb_.x); ROPE2(a.y, b.y, c1, ra.y, rb_.y); ROPE2(a.z, b.z, c2, ra.z, rb_.z); ROPE2(a.w, b.w, c3, ra.w, rb_.w);
                qr[(NC == 12 ? 8 : 0) + cc] = __builtin_bit_cast(bf16x8, ra); qr[(NC == 12 ? 10 : 0) + cc] = __builtin_bit_cast(bf16x8, rb_);
            }
        }
        float m_reg = m_init, l_reg = l_init; f32x16 o[ND0];
#pragma unroll
        for (int d = 0; d < ND0; ++d) o[d] = f32x16{};
        const int vb0 = (int)(uintptr_t)(lds + VOFF) + v_rd_base(lane);
        const LAS unsigned char* kb4[4];
#pragma unroll
        for (int cl = 0; cl < 4; ++cl) kb4[cl] = lds + KOFF + r32 * RB + ((cl * 32 + hi * 16) ^ (((r32 >> 1) & 7) << 4));
        f32x16 p0, p1; bf16x8 pa0, pa1, pa2, pa3; float alpha = 1.f;
#define ATT_QK(kbuf_) do { \
            _Pragma("unroll") for (int g = 0; g < NC / 4; ++g) { bf16x8 b0[4], b1[4]; \
                _Pragma("unroll") for (int cl = 0; cl < 4; ++cl) { b0[cl] = *(const LAS bf16x8*)(kb4[cl] + (kbuf_) * KBYTES + g * 128); b1[cl] = *(const LAS bf16x8*)(kb4[cl] + (kbuf_) * KBYTES + g * 128 + 32 * RB); } \
                SBAR(); \
                _Pragma("unroll") for (int cl = 0; cl < 4; ++cl) { \
                    if (g == 0 && cl == 0) { p0 = __builtin_amdgcn_mfma_f32_32x32x16_bf16(b0[cl], qr[0], (f32x16){0.f,0.f,0.f,0.f,0.f,0.f,0.f,0.f,0.f,0.f,0.f,0.f,0.f,0.f,0.f,0.f}, 0, 0, 0); \
                                             p1 = __builtin_amdgcn_mfma_f32_32x32x16_bf16(b1[cl], qr[0], (f32x16){0.f,0.f,0.f,0.f,0.f,0.f,0.f,0.f,0.f,0.f,0.f,0.f,0.f,0.f,0.f,0.f}, 0, 0, 0); } \
                    else { p0 = __builtin_amdgcn_mfma_f32_32x32x16_bf16(b0[cl], qr[g * 4 + cl], p0, 0, 0, 0); \
                           p1 = __builtin_amdgcn_mfma_f32_32x32x16_bf16(b1[cl], qr[g * 4 + cl], p1, 0, 0, 0); } } \
                SBAR(); } } while (0)
#define ATT_SM(kb_) do { if ((kb_) + 63 > qlo || (kb_) + (int)W <= qlo + 31) mask_tile(p0, p1, qm - (kb_), W); \
            alpha = softmax_tile(p0, p1, m_reg, l_reg, C2, pa0, pa1, pa2, pa3); } while (0)
#define ATT_PV(vbuf_) do { if (__any(alpha < 1.f)) { if (hi == 0) al_l[r32] = alpha; LGKM0(); \
                _Pragma("unroll") for (int d = 0; d < ND0; ++d) _Pragma("unroll") for (int r = 0; r < 16; ++r) o[d][r] *= al_l[crow(r, hi)]; } \
            if ((vbuf_) == 0) pv_tile<0, ND0>(o, vb0, pa0, pa1, pa2, pa3); else if ((vbuf_) == 1) pv_tile<VBYTES, ND0>(o, vb0, pa0, pa1, pa2, pa3); else pv_tile<2 * VBYTES, ND0>(o, vb0, pa0, pa1, pa2, pa3); } while (0)
        __syncthreads();
        StageOffs SO; stage_setup(SO, tid);
        stage_tile(lds, 0, 0, j_lo * 64, SO, tid, wid);
        asm volatile("s_waitcnt vmcnt(0)" ::: "memory");
        __syncthreads();
        const int NT = j_hi - j_lo;
#if ATT_STAGGER
        {
        int vcur = 0;
        for (int t = 0; t < NT; ++t) {
            const int kbuf = t & 1, kb = (j_lo + t) * 64;
            const int vnext = (vcur == 2) ? 0 : vcur + 1;
            if (t + 1 < NT) stage_tile(lds, kbuf ^ 1, vnext, kb + 64, SO, tid, wid);
            ATT_QK(kbuf); ATT_SM(kb);
            if (grpB) { asm volatile("s_waitcnt vmcnt(0)" ::: "memory"); __syncthreads(); }
            ATT_PV(vcur);
            if (!grpB) { asm volatile("s_waitcnt vmcnt(0)" ::: "memory"); __syncthreads(); }
            vcur = vnext;
        } }
#else
        for (int t = 0; t < NT; ++t) {
            const int kbuf = t & 1, kb = (j_lo + t) * 64;
            if (t + 1 < NT) stage_tile(lds, kbuf ^ 1, kbuf ^ 1, kb + 64, SO, tid, wid);
            ATT_QK(kbuf); ATT_SM(kb);
            if (__any(alpha < 1.f)) { if (hi == 0) al_l[r32] = alpha; LGKM0();
#pragma unroll
                for (int d = 0; d < ND0; ++d)
#pragma unroll
                    for (int r = 0; r < 16; ++r) o[d][r] *= al_l[crow(r, hi)]; }
            if (kbuf == 0) pv_tile<0, ND0>(o, vb0, pa0, pa1, pa2, pa3); else pv_tile<VBYTES, ND0>(o, vb0, pa0, pa1, pa2, pa3);
            asm volatile("s_waitcnt vmcnt(0)" ::: "memory");
            __syncthreads();
        }
#endif
#undef ATT_QK
#undef ATT_SM
#undef ATT_PV
        if (hi == 0) li_l[r32] = l_reg; LGKM0();
        int hi_o = hi, r32_o = r32; asm volatile("" : "+v"(hi_o), "+v"(r32_o));
        bf16_t* Ow = O + (size_t)qlo * ldo;
#pragma unroll
        for (int r = 0; r < 16; ++r) { const int orow = crow(r, hi_o); const float rl = 1.0f / li_l[orow];
#pragma unroll
            for (int d = 0; d < ND0; ++d) { const float v = o[d][r] * rl; const float vn = __shfl_xor(v, 1);
                if ((r32_o & 1) == 0) *(unsigned*)(Ow + (size_t)orow * ldo + d * 32 + r32_o) = cvt_pk_bf16(v, vn); } }
    }
};

__device__ __forceinline__ int v_st64(int k, int c) { const int kk = (k & ~0xC) | ((k & 4) << 1) | ((k & 8) >> 1); return ((kk >> 3) * 2 + (c >> 5)) * 512 + ((kk & 7) * 32 + (c & 31)) * 2; }
__device__ __forceinline__ void ph_swa(const Frame& F) {
    const bf16_t* qkv = WSP(bf16_t, WS_PROJ); bf16_t* hcat = WSP(bf16_t, WS_HCAT); const float* sinks = F.in[15];
    LAS unsigned char* lds = F.lds;
    constexpr int KT = 8192, VT = 8192, VBASE = 6 * KT, SCR = VBASE + 6 * VT;
    const int tid = F.tid, wid = F.wid, lane = F.lane, r32 = lane & 31, hi = lane >> 5;
    const float C2 = 0.125f * 1.4426950408889634f;
    LAS float* ws = (LAS float*)(lds + SCR) + wid * 64; LAS float* li_l = ws; LAS float* al_l = ws + 32;
    const LAS unsigned char* kb4[4];
#pragma unroll
    for (int cl = 0; cl < 4; ++cl) kb4[cl] = lds + r32 * 128 + ((cl * 32 + hi * 16) ^ (((r32 >> 1) & 7) << 4));
    const int vbase = (int)(uintptr_t)(lds + VBASE) + v_rd_base(lane);
    for (int U = F.bid; U < 256; U += F.G) {
        const int hkv = U & 3, P0 = (U >> 2) * 256;
        const int tile0 = (P0 >> 6) - 2 < 0 ? 0 : (P0 >> 6) - 2, ntl = (P0 >> 6) + 4 - tile0;
        __syncthreads();
        { int tq = tid; asm volatile("" : "+v"(tq));
          const float2* rope = WSP(float2, WS_ROPE);
#pragma unroll
          for (int i = 0; i < 3; ++i) { const int q = tq + NTHREADS * i, key = q >> 2, pc = q & 3;
              if (key < ntl * 64) { const int tl = key >> 6, row = key & 63; const int kabs = tile0 * 64 + key; const size_t g = (size_t)kabs * 2560;
                  const u32x4 k0 = *(const u32x4*)(qkv + g + 2048 + 64 * hkv + pc * 8), k1 = *(const u32x4*)(qkv + g + 2048 + 64 * hkv + 32 + pc * 8);
                  const u32x4 v0 = *(const u32x4*)(qkv + g + 2304 + 64 * hkv + pc * 8), v1 = *(const u32x4*)(qkv + g + 2304 + 64 * hkv + 32 + pc * 8);
                  const f32x4 c0 = *(const f32x4*)(rope + (size_t)kabs * 32 + pc * 8), c1 = *(const f32x4*)(rope + (size_t)kabs * 32 + pc * 8 + 2), c2 = *(const f32x4*)(rope + (size_t)kabs * 32 + pc * 8 + 4), c3 = *(const f32x4*)(rope + (size_t)kabs * 32 + pc * 8 + 6);
                  u32x4 r0, r1;
                  ROPE2(k0.x, k1.x, c0, r0.x, r1.x); ROPE2(k0.y, k1.y, c1, r0.y, r1.y); ROPE2(k0.z, k1.z, c2, r0.z, r1.z); ROPE2(k0.w, k1.w, c3, r0.w, r1.w);
                  *(LAS u32x4*)(lds + tl * KT + row * 128 + ((pc * 16) ^ (((row >> 1) & 7) << 4))) = r0;
                  *(LAS u32x4*)(lds + tl * KT + row * 128 + (((pc + 4) * 16) ^ (((row >> 1) & 7) << 4))) = r1;
                  *(LAS u32x4*)(lds + VBASE + tl * VT + v_st64(row, pc * 8)) = v0;
                  *(LAS u32x4*)(lds + VBASE + tl * VT + v_st64(row, 32 + pc * 8)) = v1; } } }
        __syncthreads();
        const int hq = hkv * 8 + wid;
        const float m0 = sinks[hq] * 8.0f;
        const float2* rope = WSP(float2, WS_ROPE);
        u32x4 qn[4]; f32x4 cn[2][4];
#define SWA_LDQ(rb_) do { const int ql_ = P0 + 32 * (rb_); \
            _Pragma("unroll") for (int c = 0; c < 4; ++c) qn[c] = *(const u32x4*)(qkv + (size_t)(ql_ + r32) * 2560 + 64 * hq + c * 16 + hi * 8); \
            _Pragma("unroll") for (int c = 0; c < 2; ++c) { const f32x4* cs = (const f32x4*)(rope + (size_t)(ql_ + r32) * 32 + 16 * c + 8 * hi); cn[c][0] = cs[0]; cn[c][1] = cs[1]; cn[c][2] = cs[2]; cn[c][3] = cs[3]; } } while (0)
        SWA_LDQ(0);
        for (int rb = 0; rb < 8; ++rb) {
            const int qlo = P0 + 32 * rb, qm = qlo + r32 - 4 * hi;
            bf16x8 qr[4];
            {
#pragma unroll
              for (int c = 0; c < 2; ++c) { const u32x4 a = qn[c], b = qn[c + 2]; u32x4 ra, rb_;
                  ROPE2(a.x, b.x, cn[c][0], ra.x, rb_.x); ROPE2(a.y, b.y, cn[c][1], ra.y, rb_.y); ROPE2(a.z, b.z, cn[c][2], ra.z, rb_.z); ROPE2(a.w, b.w, cn[c][3], ra.w, rb_.w);
                  qr[c] = *reinterpret_cast<bf16x8*>(&ra); qr[c + 2] = *reinterpret_cast<bf16x8*>(&rb_); } }
            __builtin_amdgcn_sched_barrier(0);
            if (rb + 1 < 8) SWA_LDQ(rb + 1);
            __builtin_amdgcn_sched_barrier(0);
            float m_reg = m0, l_reg = 1.f; f32x16 o[2] = {f32x16{}, f32x16{}};
            const int tlo = (qlo - 127 < 0) ? 0 : (qlo - 127) >> 6, thi = (qlo + 31) >> 6;
            for (int tile = tlo; tile <= thi; ++tile) {
                const int lt = tile - tile0, kb = tile * 64;
                f32x16 p0 = f32x16{}, p1 = f32x16{};
                { bf16x8 b0[4], b1[4];
#pragma unroll
                  for (int cl = 0; cl < 4; ++cl) { b0[cl] = *(const LAS bf16x8*)(kb4[cl] + lt * KT); b1[cl] = *(const LAS bf16x8*)(kb4[cl] + lt * KT + 32 * 128); }
#pragma unroll
                  for (int cl = 0; cl < 4; ++cl) { p0 = __builtin_amdgcn_mfma_f32_32x32x16_bf16(b0[cl], qr[cl], p0, 0, 0, 0); p1 = __builtin_amdgcn_mfma_f32_32x32x16_bf16(b1[cl], qr[cl], p1, 0, 0, 0); } }
                mask_tile(p0, p1, qm - kb, 128u);
                bf16x8 pa0, pa1, pa2, pa3;
                const float alpha = softmax_tile(p0, p1, m_reg, l_reg, C2, pa0, pa1, pa2, pa3);
                if (__any(alpha < 1.f)) { if (hi == 0) al_l[r32] = alpha; LGKM0();
#pragma unroll
                    for (int d = 0; d < 2; ++d)
#pragma unroll
                        for (int r = 0; r < 16; ++r) o[d][r] *= al_l[crow(r, hi)]; }
                pv_tile<0, 2, 1024>(o, vbase + lt * VT, pa0, pa1, pa2, pa3);
            }
            if (hi == 0) li_l[r32] = l_reg; LGKM0();
            int hi_o = hi, r32_o = r32; asm volatile("" : "+v"(hi_o), "+v"(r32_o));
            bf16_t* Ow = hcat + (size_t)qlo * 2048 + 64 * hq;
#pragma unroll
            for (int r = 0; r < 16; ++r) { const int orow = crow(r, hi_o); const float rl = 1.0f / li_l[orow];
#pragma unroll
                for (int d = 0; d < 2; ++d) { const float v = o[d][r] * rl; const float vn = __shfl_xor(v, 1);
                    if ((r32_o & 1) == 0) *(unsigned*)(Ow + (size_t)orow * 2048 + d * 32 + r32_o) = cvt_pk_bf16(v, vn); } }
        }
    }
    __syncthreads();
}

__device__ __forceinline__ void ph_mla_prep(const Frame& F) {
    const bf16_t* proj = WSP(bf16_t, WS_PROJ); const float* qn = F.in[8]; const float* kvn = F.in[9];
    bf16_t* cqn = WSP(bf16_t, WS_CQN); bf16_t* ckvn = WSP(bf16_t, WS_CKVN); bf16_t* kpe = WSP(bf16_t, WS_KPE); const float2* rope = WSP(float2, WS_ROPE);
    const int lane = F.lane;
    for (int t = F.bid * 8 + F.wid; t < T; t += F.G * 8) {
        const bf16_t* pr = proj + (size_t)t * IN_PAD;
        { float v[3][4]; float ss = 0.f;
#pragma unroll
          for (int j = 0; j < 3; ++j) { const u32x2 w = *(const u32x2*)(pr + OFF_CQ + 4 * lane + 256 * j); v[j][0] = bflo(w.x); v[j][1] = bfhi(w.x); v[j][2] = bflo(w.y); v[j][3] = bfhi(w.y);
              ss += v[j][0] * v[j][0] + v[j][1] * v[j][1] + v[j][2] * v[j][2] + v[j][3] * v[j][3]; }
          ss = wave_sum(ss); const float rstd = rsqrtf(ss * (1.0f / 768.0f) + EPS);
#pragma unroll
          for (int j = 0; j < 3; ++j) { const int col = 4 * lane + 256 * j; const f32x4 g = *(const f32x4*)(qn + col);
              u32x2 o; o.x = cvt_pk_bf16(v[j][0] * rstd * g[0], v[j][1] * rstd * g[1]); o.y = cvt_pk_bf16(v[j][2] * rstd * g[2], v[j][3] * rstd * g[3]);
              *(u32x2*)(cqn + (size_t)t * 768 + col) = o; } }
        { float v[2][4]; float ss = 0.f;
#pragma unroll
          for (int j = 0; j < 2; ++j) { const u32x2 w = *(const u32x2*)(pr + OFF_CKV + 4 * lane + 256 * j); v[j][0] = bflo(w.x); v[j][1] = bfhi(w.x); v[j][2] = bflo(w.y); v[j][3] = bfhi(w.y);
              ss += v[j][0] * v[j][0] + v[j][1] * v[j][1] + v[j][2] * v[j][2] + v[j][3] * v[j][3]; }
          ss = wave_sum(ss); const float rstd = rsqrtf(ss * (1.0f / 512.0f) + EPS);
#pragma unroll
          for (int j = 0; j < 2; ++j) { const int col = 4 * lane + 256 * j; const f32x4 g = *(const f32x4*)(kvn + col);
              u32x2 o; o.x = cvt_pk_bf16(v[j][0] * rstd * g[0], v[j][1] * rstd * g[1]); o.y = cvt_pk_bf16(v[j][2] * rstd * g[2], v[j][3] * rstd * g[3]);
              *(u32x2*)(ckvn + (size_t)t * 512 + col) = o; } }
        if (lane < 32) { const float x1 = bf2f(pr[OFF_KR + lane]), x2 = bf2f(pr[OFF_KR + 32 + lane]); const float2 cs = rope[t * 32 + lane];
            kpe[(size_t)t * 64 + lane] = f2bf(x1 * cs.x - x2 * cs.y); kpe[(size_t)t * 64 + 32 + lane] = f2bf(x2 * cs.x + x1 * cs.y); }
    }
}

__device__ __forceinline__ void ph_gates(const Frame& F) {
    const bf16_t* proj = WSP(bf16_t, WS_PROJ); const float* bif = F.in[6];
    float* GA = WSP(float, WS_GA); float* GB = WSP(float, WS_GB); float* GCM = WSP(float, WS_GCM); float* GST = WSP(float, WS_GST);
    const int lane = F.lane;
    for (int u = F.bid * 8 + F.wid; u < NCH * 4; u += F.G * 8) {
        const int c = u >> 2, h = u & 3, t = c * 64 + lane;
        const float ipre = bf2f(proj[(size_t)t * IN_PAD + OFF_MI + h]) + bif[h], fpre = bf2f(proj[(size_t)t * IN_PAD + OFF_MF + h]) + bif[4 + h];
        const float ig = 15.0f * tanhf(ipre * (1.0f / 15.0f)); const float z = 15.0f * tanhf(fpre * (1.0f / 15.0f));
        const float lf = (z >= 0.f) ? -log1pf(expf(-z)) : z - log1pf(expf(z));
        float b = lf;
#pragma unroll
        for (int o = 1; o < 64; o <<= 1) { const float v = __shfl_up(b, o); if (lane >= o) b += v; }
        const float a = ig - b;
        float cm = a;
#pragma unroll
        for (int o = 1; o < 64; o <<= 1) { const float v = __shfl_up(cm, o); if (lane >= o) cm = fmaxf(cm, v); }
        GA[h * T + t] = a; GB[h * T + t] = b; GCM[h * T + t] = cm;
        if (lane == 63) { GST[h * 256 + c] = cm; GST[1024 + h * 256 + c] = b; }
    }
}

__device__ __forceinline__ void m_scan(const Frame& F, LAS float* mst) {
    float* GST = WSP(float, WS_GST);
    LAS float* tmp = mst + 4 * 257 + 3;
    __syncthreads();
    for (int i = F.tid; i < 2048; i += NTHREADS) tmp[i] = GST[i];
    __syncthreads();
    if (F.tid < 4) { const int h = F.tid; float m = 0.f; mst[h * 257] = 0.f;
        for (int c = 0; c < 256; ++c) { m = tmp[1024 + h * 256 + c] + fmaxf(m, tmp[h * 256 + c]); mst[h * 257 + c + 1] = m; } }
    __syncthreads();
    if (F.bid == 0) for (int i = F.tid; i < 4 * 257; i += NTHREADS) GST[2048 + i] = mst[i];
}

__device__ __forceinline__ void ph_rope_q(const Frame& F) {
    const float2* rope = WSP(float2, WS_ROPE); bf16_t* qraw = WSP(bf16_t, WS_QRAW);
    for (int idx = F.bid * NTHREADS + F.tid; idx < T * 32; idx += F.G * NTHREADS) {
        const int t = idx >> 5, hh = (idx >> 2) & 7, pc = idx & 3;
        bf16_t* p = qraw + (size_t)t * 1536 + hh * 192 + 128 + pc * 8;
        const u32x4 a = *(const u32x4*)p, b = *(const u32x4*)(p + 32);
        const f32x4* cs = (const f32x4*)(rope + (size_t)t * 32 + pc * 8);
        const f32x4 c0 = cs[0], c1 = cs[1], c2 = cs[2], c3 = cs[3];
        u32x4 ra, rb_;
        ROPE2(a.x, b.x, c0, ra.x, rb_.x); ROPE2(a.y, b.y, c1, ra.y, rb_.y); ROPE2(a.z, b.z, c2, ra.z, rb_.z); ROPE2(a.w, b.w, c3, ra.w, rb_.w);
        *(u32x4*)p = ra; *(u32x4*)(p + 32) = rb_;
    }
}

#define TRF(dst, base, TOFF, d0, ks) do { const s16x4 l_ = trrd<(TOFF) + v_rd_off(d0, ks, 0)>(base); const s16x4 h_ = trrd<(TOFF) + v_rd_off(d0, ks, 1)>(base); LGKM0(); dst = cat44(l_, h_); } while (0)
__device__ __forceinline__ void ph_mlstm_B(const Frame& F, const LAS float* mst) {
    const bf16_t* proj = WSP(bf16_t, WS_PROJ); const float* GA = WSP(float, WS_GA); const float* GST = WSP(float, WS_GST);
    bf16_t* dC = WSP(bf16_t, WS_DC); float* DN = WSP(float, WS_DN);
    LAS unsigned char* lds = F.lds;
    const int tid = F.tid, lane = F.lane, w = F.wid, r32 = lane & 31, hi = lane >> 5;
    const int lbase = (int)(uintptr_t)lds + v_rd_base(lane);
    for (int u = F.bid; u < NCH * 4; u += F.G) {
        const int c = u >> 2, h = u & 3, t0 = c * 64;
        const float mx = fmaxf(mst[h * 257 + c], GST[h * 256 + c]);
        __syncthreads();
#pragma unroll
        for (int i = 0; i < 2; ++i) { const int q = tid + NTHREADS * i, s = q >> 4, dc = (q & 15) * 8;
            const u32x4 raw = *(const u32x4*)(proj + (size_t)(t0 + s) * IN_PAD + OFF_MK + h * 128 + dc);
            const float wsc = expf(GA[h * T + t0 + s] - mx) * 0.08838834764831845f;
            u32x4 o; o.x = cvt_pk_bf16(bflo(raw.x) * wsc, bfhi(raw.x) * wsc); o.y = cvt_pk_bf16(bflo(raw.y) * wsc, bfhi(raw.y) * wsc);
            o.z = cvt_pk_bf16(bflo(raw.z) * wsc, bfhi(raw.z) * wsc); o.w = cvt_pk_bf16(bflo(raw.w) * wsc, bfhi(raw.w) * wsc);
            *(LAS u32x4*)(lds + v_st(s, dc)) = o; }
#pragma unroll
        for (int i = 0; i < 4; ++i) { const int q = tid + NTHREADS * i, s = q >> 5, vc = (q & 31) * 8;
            const u32x4 raw = *(const u32x4*)(proj + (size_t)(t0 + s) * IN_PAD + OFF_MV + h * 256 + vc);
            *(LAS u32x4*)(lds + 16384 + (vc >> 7) * 16384 + v_st(s, vc & 127)) = raw; }
        __syncthreads();
        bf16x8 Bf[4];
        {
            const int vb = lbase + 16384 + (w >> 2) * 16384 + (w & 3) * 512;
            TRF(Bf[0], vb, 0, 0, 0); TRF(Bf[1], vb, 0, 0, 1); TRF(Bf[2], vb, 0, 0, 2); TRF(Bf[3], vb, 0, 0, 3);
        }
        f32x16 acc[4];
#define MB_STEP(mb) do { bf16x8 a0, a1, a2, a3; TRF(a0, lbase, 0, mb, 0); TRF(a1, lbase, 0, mb, 1); TRF(a2, lbase, 0, mb, 2); TRF(a3, lbase, 0, mb, 3); \
        f32x16 z = f32x16{}; z = __builtin_amdgcn_mfma_f32_32x32x16_bf16(a0, Bf[0], z, 0, 0, 0); z = __builtin_amdgcn_mfma_f32_32x32x16_bf16(a1, Bf[1], z, 0, 0, 0); \
        z = __builtin_amdgcn_mfma_f32_32x32x16_bf16(a2, Bf[2], z, 0, 0, 0); z = __builtin_amdgcn_mfma_f32_32x32x16_bf16(a3, Bf[3], z, 0, 0, 0); acc[mb] = z; } while (0)
        MB_STEP(0); MB_STEP(1); MB_STEP(2); MB_STEP(3);
#undef MB_STEP
        bf16_t* outp = dC + ((size_t)u * 256 + w * 32 + r32) * 128;
#pragma unroll
        for (int mb = 0; mb < 4; ++mb)
#pragma unroll
            for (int rq = 0; rq < 4; ++rq) { u32x2 o; o.x = cvt_pk_bf16(acc[mb][4 * rq + 0], acc[mb][4 * rq + 1]); o.y = cvt_pk_bf16(acc[mb][4 * rq + 2], acc[mb][4 * rq + 3]);
                *(u32x2*)(outp + mb * 32 + 8 * rq + 4 * hi) = o; }
        if (tid < 128) { float s_ = 0.f; const int d = tid;
            for (int s = 0; s < 64; ++s) s_ += bf2f(*(const LAS bf16_t*)(lds + v_st(s, d & ~7) + (d & 7) * 2));
            DN[(size_t)u * 128 + d] = s_; }
    }
    __syncthreads();
}

__device__ __forceinline__ void mlstm_C_item(const Frame& F, int item) {
    const float* GST = WSP(float, WS_GST);
    const bf16_t* dC = WSP(bf16_t, WS_DC); bf16_t* Cst = WSP(bf16_t, WS_CST); const float* DN = WSP(float, WS_DN); float* NST = WSP(float, WS_NST);
    LAS float* dec = (LAS float*)F.aux;
    __syncthreads();
    for (int i = F.tid; i < 1024; i += NTHREADS) { const int h = i >> 8, c = i & 255; const float m = GST[2048 + h * 257 + c]; dec[i] = expf(m - fmaxf(m, GST[h * 256 + c])); }
    __syncthreads();
    if (item < 64) {
        const int it = item * 512 + F.tid;
        const int h = it >> 13, rem = it & 8191;
        const size_t off0 = (size_t)h * 256 * 128 + (size_t)rem * 4;
        float s0 = 0.f, s1 = 0.f, s2 = 0.f, s3 = 0.f;
        u32x2 buf[16];
#pragma unroll
        for (int j = 0; j < 16; ++j) buf[j] = __builtin_nontemporal_load((const u32x2*)(dC + (size_t)j * 131072 + off0));
        for (int cb = 0; cb < 256; cb += 16) {
            u32x2 nb[16];
            if (cb + 16 < 256) {
#pragma unroll
                for (int j = 0; j < 16; ++j) nb[j] = __builtin_nontemporal_load((const u32x2*)(dC + (size_t)(cb + 16 + j) * 131072 + off0));
            }
#pragma unroll
            for (int j = 0; j < 16; ++j) {
                const unsigned long long o = (unsigned long long)cvt_pk_bf16(s0, s1) | ((unsigned long long)cvt_pk_bf16(s2, s3) << 32);
                __hip_atomic_store((unsigned long long*)(Cst + (size_t)(cb + j) * 131072 + off0), o, __ATOMIC_RELAXED, __HIP_MEMORY_SCOPE_AGENT);
                const float d = dec[h * 256 + cb + j];
                s0 = d * s0 + bflo(buf[j].x); s1 = d * s1 + bfhi(buf[j].x); s2 = d * s2 + bflo(buf[j].y); s3 = d * s3 + bfhi(buf[j].y);
            }
            if (cb + 16 < 256) {
#pragma unroll
                for (int j = 0; j < 16; ++j) buf[j] = nb[j];
            }
        }
    } else {
        const int it = F.tid; const int h = it >> 7;
        float s = 0.f;
#pragma unroll 16
        for (int c = 0; c < 256; ++c) { __hip_atomic_store((unsigned*)&NST[(size_t)c * 512 + it], __float_as_uint(s), __ATOMIC_RELAXED, __HIP_MEMORY_SCOPE_AGENT); s = dec[h * 256 + c] * s + DN[(size_t)c * 512 + it]; }
    }
}

__device__ __forceinline__ void ph_mlstm_D(const Frame& F) {
    const bf16_t* proj = WSP(bf16_t, WS_PROJ); const float* GA = WSP(float, WS_GA); const float* GB = WSP(float, WS_GB); const float* GCM = WSP(float, WS_GCM);
    const float* GST = WSP(float, WS_GST); const bf16_t* Cst = WSP(bf16_t, WS_CST); const float* NST = WSP(float, WS_NST);
    const float* gain = F.in[7]; bf16_t* hcat = WSP(bf16_t, WS_HCAT);
    const int tid = F.tid, lane = F.lane, r32 = lane & 31, hi = lane >> 5;
    const int hb = F.wid >> 2, wl = F.wid & 3, rh = wl & 1, vh = wl >> 1, htid = tid & 255;
    LAS unsigned char* hl = F.lds + hb * 40960;
    LAS float* a_l = (LAS float*)(hl + 32768); LAS float* n_l = (LAS float*)(hl + 33024); LAS float* rowss = (LAS float*)(hl + 33536);
    LAS float* scr = (LAS float*)(hl + 34048 + wl * 256);
    for (int pi = F.bid; pi < NCH * 2; pi += F.G) {
        const int u = pi * 2 + hb, c = u >> 2, h = u & 3, t0 = c * 64;
        __syncthreads();
        { u32x4 raw[8];
#pragma unroll
          for (int i = 0; i < 8; ++i) { const int q = htid + 256 * i, s = q >> 5, vc = (q & 31) * 8;
              raw[i] = *(const u32x4*)(proj + (size_t)(t0 + s) * IN_PAD + OFF_MV + h * 256 + vc); }
          SBAR();
#pragma unroll
          for (int i = 0; i < 8; ++i) { const int q = htid + 256 * i, s = q >> 5, vc = (q & 31) * 8;
              *(LAS u32x4*)(hl + (vc >> 7) * 16384 + v_st(s, vc & 127)) = raw[i]; } }
        if (htid < 64) a_l[htid] = GA[h * T + t0 + htid];
        if (htid < 128) n_l[htid] = NST[(size_t)u * 128 + htid];
        __syncthreads();
        const int j = 32 * rh + r32, t = t0 + j;
        const float m_c = GST[2048 + h * 257 + c];
        const float M_j = fmaxf(m_c, GCM[h * T + t]), b_j = GB[h * T + t];
        bf16x8 qr[8];
#pragma unroll
        for (int cc = 0; cc < 8; ++cc) qr[cc] = *(const bf16x8*)(proj + (size_t)t * IN_PAD + OFF_MQ + h * 128 + cc * 16 + hi * 8);
        f32x16 p0 = f32x16{}, p1 = f32x16{};
#pragma unroll
        for (int cc = 0; cc < 8; ++cc) {
            const bf16x8 k0 = *(const bf16x8*)(proj + (size_t)(t0 + r32) * IN_PAD + OFF_MK + h * 128 + cc * 16 + hi * 8);
            const bf16x8 k1 = *(const bf16x8*)(proj + (size_t)(t0 + 32 + r32) * IN_PAD + OFF_MK + h * 128 + cc * 16 + hi * 8);
            p0 = __builtin_amdgcn_mfma_f32_32x32x16_bf16(k0, qr[cc], p0, 0, 0, 0);
            p1 = __builtin_amdgcn_mfma_f32_32x32x16_bf16(k1, qr[cc], p1, 0, 0, 0);
        }
        float dsum = 0.f;
#pragma unroll
        for (int r = 0; r < 16; ++r) {
            const int s0 = crow(r, hi), s1 = 32 + s0;
            const float e0 = __expf(fminf(a_l[s0] - M_j, 0.f)) * 0.08838834764831845f, e1 = __expf(fminf(a_l[s1] - M_j, 0.f)) * 0.08838834764831845f;
            const float w0 = (s0 <= j) ? e0 : 0.f, w1 = (s1 <= j) ? e1 : 0.f;
            p0[r] *= w0; p1[r] *= w1; dsum += p0[r] + p1[r];
        }
        { auto rr = __builtin_amdgcn_permlane32_swap(__float_as_uint(dsum), __float_as_uint(dsum), false, false); dsum = __uint_as_float(rr[0]) + __uint_as_float(rr[1]); }
        bf16x8 pa0, pa1, pa2, pa3;
        PK4(p0, 0, pa0); PK4(p0, 8, pa1); PK4(p1, 0, pa2); PK4(p1, 8, pa3);
        f32x16 o[4];
#pragma unroll
        for (int d = 0; d < 4; ++d) o[d] = f32x16{};
        const int vb0 = (int)(uintptr_t)(hl + vh * 16384) + v_rd_base(lane);
        pv_tile<0, 4>(o, vb0, pa0, pa1, pa2, pa3);
        const float w_inter = expf(m_c - M_j);
        float qn = 0.f;
        bf16x8 qs[8];
#pragma unroll
        for (int cc = 0; cc < 8; ++cc) {
            const u32x4 w = *reinterpret_cast<const u32x4*>(&qr[cc]);
            const float q0 = bflo(w.x), q1 = bfhi(w.x), q2 = bflo(w.y), q3 = bfhi(w.y), q4 = bflo(w.z), q5 = bfhi(w.z), q6 = bflo(w.w), q7 = bfhi(w.w);
            const LAS float* np = n_l + cc * 16 + hi * 8;
            qn += q0 * np[0] + q1 * np[1] + q2 * np[2] + q3 * np[3] + q4 * np[4] + q5 * np[5] + q6 * np[6] + q7 * np[7];
            u32x4 o_; o_.x = cvt_pk_bf16(q0 * w_inter, q1 * w_inter); o_.y = cvt_pk_bf16(q2 * w_inter, q3 * w_inter); o_.z = cvt_pk_bf16(q4 * w_inter, q5 * w_inter); o_.w = cvt_pk_bf16(q6 * w_inter, q7 * w_inter);
            qs[cc] = *reinterpret_cast<bf16x8*>(&o_);
        }
        { auto rr = __builtin_amdgcn_permlane32_swap(__float_as_uint(qn), __float_as_uint(qn), false, false); qn = __uint_as_float(rr[0]) + __uint_as_float(rr[1]); }
        {
            const bf16_t* cp = Cst + ((size_t)u * 256 + 128 * vh + r32) * 128 + hi * 8;
            bf16x8 cfa[8], cfb[8];
#pragma unroll
            for (int cc = 0; cc < 8; ++cc) cfa[cc] = *(const bf16x8*)(cp + cc * 16);
#pragma unroll
            for (int cc = 0; cc < 8; ++cc) cfb[cc] = *(const bf16x8*)(cp + (size_t)32 * 128 + cc * 16);
            SBAR();
#pragma unroll
            for (int cc = 0; cc < 8; ++cc) o[0] = __builtin_amdgcn_mfma_f32_32x32x16_bf16(qs[cc], cfa[cc], o[0], 0, 0, 0);
            SBAR();
#pragma unroll
            for (int cc = 0; cc < 8; ++cc) cfa[cc] = *(const bf16x8*)(cp + (size_t)64 * 128 + cc * 16);
            SBAR();
#pragma unroll
            for (int cc = 0; cc < 8; ++cc) o[1] = __builtin_amdgcn_mfma_f32_32x32x16_bf16(qs[cc], cfb[cc], o[1], 0, 0, 0);
            SBAR();
#pragma unroll
            for (int cc = 0; cc < 8; ++cc) cfb[cc] = *(const bf16x8*)(cp + (size_t)96 * 128 + cc * 16);
            SBAR();
#pragma unroll
            for (int cc = 0; cc < 8; ++cc) o[2] = __builtin_amdgcn_mfma_f32_32x32x16_bf16(qs[cc], cfa[cc], o[2], 0, 0, 0);
            SBAR();
#pragma unroll
            for (int cc = 0; cc < 8; ++cc) o[3] = __builtin_amdgcn_mfma_f32_32x32x16_bf16(qs[cc], cfb[cc], o[3], 0, 0, 0);
        }
        const float den = dsum + w_inter * qn;
        const float inv = 1.0f / fmaxf(fabsf(den), expf(-(b_j + M_j)));
        if (hi == 0) scr[r32] = inv;
        LGKM0();
        float ss[16];
#pragma unroll
        for (int r = 0; r < 16; ++r) { const float iv = scr[crow(r, hi)]; float a = 0.f;
#pragma unroll
            for (int d = 0; d < 4; ++d) { o[d][r] *= iv; a += o[d][r] * o[d][r]; }
            a += __shfl_xor(a, 1); a += __shfl_xor(a, 2); a += __shfl_xor(a, 4); a += __shfl_xor(a, 8); a += __shfl_xor(a, 16);
            ss[r] = a; }
        if (r32 == 0) {
#pragma unroll
            for (int r = 0; r < 16; ++r) rowss[vh * 64 + 32 * rh + crow(r, hi)] = ss[r]; }
        __syncthreads();
#pragma unroll
        for (int r = 0; r < 16; ++r) { const int jr = 32 * rh + crow(r, hi);
#pragma unroll
            for (int d = 0; d < 4; ++d) *(LAS bf16_t*)(hl + jr * 512 + (128 * vh + 32 * d + r32) * 2) = f2bf(o[d][r]); }
        __syncthreads();
        { u32x4 ov[8], mv[8];
#pragma unroll
          for (int i = 0; i < 8; ++i) { const int q = htid + 256 * i, row = q >> 5, c8 = (q & 31) * 8;
              ov[i] = *(const LAS u32x4*)(hl + row * 512 + c8 * 2);
              mv[i] = *(const u32x4*)(proj + (size_t)(t0 + row) * IN_PAD + OFF_MO + h * 256 + c8); }
#pragma unroll
          for (int i = 0; i < 8; ++i) { const int q = htid + 256 * i, row = q >> 5, c8 = (q & 31) * 8;
              const float rstd = rsqrtf((rowss[row] + rowss[64 + row]) * (1.0f / 256.0f) + EPS);
              const f32x4 g0 = *(const f32x4*)(gain + h * 256 + c8), g1 = *(const f32x4*)(gain + h * 256 + c8 + 4);
              float v[8];
#pragma unroll
              for (int e = 0; e < 4; ++e) { const unsigned ow = ov[i][e], mw = mv[i][e];
                  v[2 * e] = bflo(ow) * rstd * ((e < 2) ? g0[2 * e] : g1[2 * e - 4]) / (1.0f + __expf(-bflo(mw)));
                  v[2 * e + 1] = bfhi(ow) * rstd * ((e < 2) ? g0[2 * e + 1] : g1[2 * e - 3]) / (1.0f + __expf(-bfhi(mw))); }
              u32x4 w; w.x = cvt_pk_bf16(v[0], v[1]); w.y = cvt_pk_bf16(v[2], v[3]); w.z = cvt_pk_bf16(v[4], v[5]); w.w = cvt_pk_bf16(v[6], v[7]);
              *(u32x4*)(hcat + (size_t)(t0 + row) * 2048 + h * 256 + c8) = w; } }
    }
    __syncthreads();
}

constexpr int NPHASE = 26;
__device__ __forceinline__ void moe_phase_router(const Frame& F, int layer) {
    PolRouter p; p.A = WSP(bf16_t, WS_H2); p.Bt = WSP(bf16_t, WS_WR) + (size_t)layer * 256 * 2048; p.part = WSP(float, WS_LOGP); p.K = 512; p.ldb = 2048;
    pg8::gemm_phase(F.lds, p);
}
__device__ __forceinline__ void moe_phase_gateup(const Frame& F, int layer) {
    PolGateUp p; p.A = WSP(bf16_t, WS_H2); p.W = WSP(bf16_t, WS_WGU) + (size_t)layer * 65 * 512 * 2048; p.rowtok = WSP(int, WS_ROWTOK); p.act = WSP(bf16_t, WS_ACT);
    p.tb = moe_tables(F); p.K = 2048; p.ldb = 2048;
    {
        LAS int* ridx = (LAS int*)(F.aux + 6144);
        for (int idx = F.tid; idx < 8 * 256; idx += NTHREADS) { const int i = idx >> 8, r = idx & 255, L = p.tb.rank + i * p.tb.nrank;
            if (L < p.tb.nrb * 2) ridx[idx] = p.rowtok[p.tb.blk_row0[p.tb.rb0 + (L >> 1)] + r]; }
        __syncthreads();
        p.ridx = ridx; }
    pg8::gemm_phase(F.lds, p);
}
__device__ __forceinline__ void moe_phase_down(const Frame& F, int layer, int nostore = 0) {
    PolDown p; p.nostore = nostore; p.A = WSP(bf16_t, WS_ACT); p.W = WSP(bf16_t, WS_WDN) + (size_t)layer * 65 * 2048 * 256; p.Y = WSP(unsigned char, WS_Y);
    p.tb = moe_tables(F); p.K = 256; p.ldb = 256;
    pg8::gemm_phase(F.lds, p);
}

__global__ void __launch_bounds__(NTHREADS, 2) mk_fwd(Args args) {
    extern __shared__ __attribute__((aligned(16))) unsigned char lds_raw[];
    Frame F;
    F.lds = (LAS unsigned char*)lds_raw; F.aux = F.lds + LDS_MAIN;
    F.in = args.in; F.out = args.out; F.ws = args.ws;
    F.tid = threadIdx.x; F.lane = F.tid & 63; F.wid = __builtin_amdgcn_readfirstlane(F.tid >> 6); F.G = gridDim.x; F.bid = blockIdx.x;
    volatile LAS unsigned* xbw = (volatile LAS unsigned*)(F.lds + LDS_MAIN + LDS_AUX);
    if (F.tid < 4) xbw[F.tid] = 0u;
    __syncthreads();
    const int lo = args.ph_lo, hi = args.ph_hi;
    XcdBarrier bar; bar.bar = WSP(unsigned, WS_ZERO + ZB_BAR); bar.x = 0; bar.st = xbw;
    if (hi - lo > 1) bar = xcd_barrier_post(WSP(unsigned, WS_ZERO + ZB_BAR), xbw);
#ifdef PH_ONLY
#define IN(k) ((k) == PH_ONLY)
#else
#define IN(k) (lo <= (k) && (k) < hi)
#endif
#define SEAM(k) do { if (IN(k) && IN((k) + 1)) xcd_barrier(bar); { int t_ = threadIdx.x; asm volatile("" : "+v"(t_)); F.tid = t_; F.lane = t_ & 63; F.wid = __builtin_amdgcn_readfirstlane(t_ >> 6); } } while (0)
    const float* mod = WSP(float, WS_ZERO + ZB_MOD);
    const float* mod0 = mod; const float* mod1 = mod + 12288;

    if (IN(0)) { PRB(0) { ph_adaln(F); ph_rope_table(F); ph_convert(F); } } SEAM(0);
#if PROBE_EXTRA_BARRIERS
    if (hi - lo > 1) { for (int xb = 0; xb < 16; ++xb) xcd_barrier(bar); }
#endif
    if (IN(1)) { PRB(15) ph_modulate<0>(F, F.in[0], mod0 + 0, mod0 + 2048, WSP(bf16_t, WS_HA)); } SEAM(1);
    if (IN(2)) { PRB(5) { PolBf16 p{{WSP(bf16_t, WS_HA), WSP(bf16_t, WS_WIN), 2048, 2048, 2048, 64, IN_PAD / 256}, WSP(bf16_t, WS_PROJ), IN_PAD, nullptr}; pg8::gemm_phase(F.lds, p); } } SEAM(2);
    if (IN(3)) { PRB(14) { ph_mla_prep(F); ph_gates(F); } } SEAM(3);
    if (IN(4)) {
        LAS float* mst = (LAS float*)F.aux;
        m_scan(F, mst);
        { PolBf16 p{{WSP(bf16_t, WS_CQN), WSP(bf16_t, WS_WUQ), 768, 768, 768, 64, 6}, WSP(bf16_t, WS_QRAW), 1536, nullptr}; pg8::gemm_phase(F.lds, p); }
        { PolBf16 p{{WSP(bf16_t, WS_CKVN), WSP(bf16_t, WS_WUKV), 512, 512, 512, 64, 8}, WSP(bf16_t, WS_KVRAW), 2048, nullptr}; pg8::gemm_phase(F.lds, p); }
        PRB(12) ph_mlstm_B(F, mst);
    } SEAM(4);
    if (IN(6)) {
        {
            unsigned* cctr = WSP(unsigned, WS_ZERO + ZB_CTR + 256); unsigned* cdone = WSP(unsigned, WS_ZERO + ZB_CTR + 384);
            for (;;) { const int c = grab(F, cctr); if (c >= 65) break;
                mlstm_C_item(F, c);
                asm volatile("s_waitcnt vmcnt(0)" ::: "memory"); __syncthreads();
                if (F.tid == 0) (void)__hip_atomic_fetch_add(cdone, 1u, __ATOMIC_RELAXED, __HIP_MEMORY_SCOPE_AGENT); }
        }
        AttnBlk<192, 128, 64> A;
        A.ldq = 1536; A.ldk1 = 2048; A.K2 = WSP(bf16_t, WS_KPE); A.ldk2 = 64; A.ldv = 2048; A.ldo = 2048;
        A.C2 = 0.07216878364870323f * 1.4426950408889634f; A.m_init = -1e30f; A.l_init = 0.f; A.W = 1u << 30; A.wrow = 32; A.wq = 0; A.wo = 0; A.sinks = nullptr; A.sink_scale = 0.f; A.ropeq = WSP(float2, WS_ROPE);
        const bool cvt_first = F.bid < MCV_BLOCKS;
        if (cvt_first) moe_cvt_queue(F);
        unsigned* actr = WSP(unsigned, WS_ZERO + ZB_CTR + 128);
        for (;;) {
            const int u = grab(F, actr); if (u >= 512) break;
            const int h = u & 7, qb = 63 - (u >> 3);
            A.Q = WSP(bf16_t, WS_QRAW) + 192 * h; A.K1 = WSP(bf16_t, WS_KVRAW) + 256 * h; A.V = WSP(bf16_t, WS_KVRAW) + 256 * h + 128; A.O = WSP(bf16_t, WS_HCAT) + 1024 + 128 * h;
            A.run(F.lds, qb * 256, 0, qb * 4 + 4);
        }
        if (!cvt_first) moe_cvt_queue(F);
        __syncthreads();
        {
            unsigned* cdone = WSP(unsigned, WS_ZERO + ZB_CTR + 384);
            if (F.tid == 0) { unsigned sp = 0; while (__hip_atomic_load(cdone, __ATOMIC_RELAXED, __HIP_MEMORY_SCOPE_AGENT) < 65u) { __builtin_amdgcn_s_sleep(1); if (++sp > (1u << 24)) break; }
                __builtin_amdgcn_fence(__ATOMIC_ACQUIRE, "agent"); }
            __syncthreads();
            ph_mlstm_D(F);
        }
        __syncthreads();
    } SEAM(6);
    if (IN(7)) { PolResid<false> p{{WSP(bf16_t, WS_HCAT), WSP(bf16_t, WS_WOUT), 2048, 2048, 2048, 64, 8}, F.in[0], mod0 + 4096, WSP(bf16_t, WS_XA)}; pg8::gemm_phase(F.lds, p); } SEAM(7);
    if (IN(8)) { PRB(4) ph_modulate<1>(F, WSP(bf16_t, WS_XA), mod0 + 6144, mod0 + 8192, WSP(bf16_t, WS_H2)); } SEAM(8);
    if (IN(9)) { PRB(6) moe_phase_router(F, 0); } SEAM(9);
    if (IN(10)) { PRB(9) ph_route(F, 0); } SEAM(10);
    if (IN(11)) { PRB(9) ph_dispatch(F); } SEAM(11);
    if (IN(12)) { PRB(1) moe_phase_gateup(F, 0); } SEAM(12);
    if (IN(13)) { moe_phase_down(F, 0);
#if PROBE_DOWN_NOSTORE == 1
        moe_phase_down(F, 0, 1);
#elif PROBE_DOWN_NOSTORE == 2
        moe_phase_down(F, 0, 0);
#endif
    } SEAM(13);
    if (IN(14)) { PRB(3) ph_combine<0>(F, WSP(bf16_t, WS_XA), mod0 + 10240, WSP(bf16_t, WS_XB), mod1 + 0, mod1 + 2048, WSP(bf16_t, WS_HA), nullptr); } SEAM(14);
    if (IN(15)) { PolBf16 p{{WSP(bf16_t, WS_HA), WSP(bf16_t, WS_WQKV), 2048, 2048, 2048, 64, 10}, WSP(bf16_t, WS_PROJ), 2560, F.in[14]}; pg8::gemm_phase(F.lds, p); } SEAM(15);
    if (IN(17)) { PRB(7) ph_swa(F);
    } SEAM(17);
    if (IN(18)) { PolResid<true> p{{WSP(bf16_t, WS_HCAT), WSP(bf16_t, WS_WO), 2048, 2048, 2048, 64, 8}, WSP(bf16_t, WS_XB), mod1 + 4096, WSP(bf16_t, WS_XA)}; pg8::gemm_phase(F.lds, p); } SEAM(18);
    if (IN(19)) { ph_modulate<1>(F, WSP(bf16_t, WS_XA), mod1 + 6144, mod1 + 8192, WSP(bf16_t, WS_H2)); } SEAM(19);
    if (IN(20)) { moe_phase_router(F, 1); } SEAM(20);
    if (IN(21)) { ph_route(F, 1); } SEAM(21);
    if (IN(22)) { ph_dispatch(F); } SEAM(22);
    if (IN(23)) { moe_phase_gateup(F, 1); } SEAM(23);
    if (IN(24)) { moe_phase_down(F, 1); } SEAM(24);
    if (IN(25)) { ph_combine<1>(F, WSP(bf16_t, WS_XA), mod1 + 10240, nullptr, nullptr, F.in[23], nullptr, F.out); }
#undef IN
#undef SEAM
}

#ifdef DBG_DUMP_OFF
__global__ void __launch_bounds__(512) dbg_dump(unsigned char* ws, float* out) {
    const size_t NOUT = (size_t)T * D;
    for (size_t i = (size_t)blockIdx.x * 512 + threadIdx.x; i < NOUT; i += (size_t)gridDim.x * 512) {
        float a = 0.f;
        for (size_t j = i; j < (size_t)(DBG_DUMP_N); j += NOUT) a += (DBG_DUMP_KIND == 0) ? bf2f(((const bf16_t*)(ws + DBG_DUMP_OFF))[j]) : (DBG_DUMP_KIND == 1 ? ((const float*)(ws + DBG_DUMP_OFF))[j] : (DBG_DUMP_KIND == 2 ? (float)((const int*)(ws + DBG_DUMP_OFF))[j] : ((((const int*)(ws + DBG_DUMP_OFF))[j] < 0 || ((const int*)(ws + DBG_DUMP_OFF))[j] > 63) ? 1.0e6f : 0.0f)));
        if (DBG_DUMP_KIND == 4) { a = 0.f; if (i < (size_t)T * 8) { const int sl = ((const int*)(ws + WS_PSLOT))[i]; const int tk = (sl >= 0 && sl < NSLOT) ? ((const int*)(ws + WS_ROWTOK))[sl] : -7; a = (tk == (int)(i >> 3)) ? 0.f : 1.0e6f; } }
        if (DBG_DUMP_KIND == 5) { const int t = (int)(i >> 11), c = (int)(i & 2047); const bf16_t* Yp = (const bf16_t*)(ws + WS_Y); a = bf2f(Yp[(size_t)t * 2048 + c]);
            for (int k = 0; k < 8; ++k) { const int sl = ((const int*)(ws + WS_PSLOT))[t * 8 + k]; a += bf2f(Yp[(size_t)sl * 2048 + c]); } }
        if (DBG_DUMP_KIND == 6) { const int t = (int)(i >> 11), c = (int)(i & 2047); const bf16_t* Ap = (const bf16_t*)(ws + WS_ACT); a = 0.f; if (c < 256) { a = bf2f(Ap[(size_t)t * 256 + c]);
            for (int k = 0; k < 8; ++k) { const int sl = ((const int*)(ws + WS_PSLOT))[t * 8 + k]; a += bf2f(Ap[(size_t)sl * 256 + c]); } } }
        out[i] = a;
    }
}
#endif
extern "C" void kernel_launch(void* const* d_in, const int* in_sizes, int n_in, void* d_out, int out_size, void* d_ws, size_t ws_size, hipStream_t stream) {
    static int grid = 0;
    if (grid == 0) {
        if (n_in != 24 || out_size != T * D || ws_size < WS_END) { fprintf(stderr, "kernel_launch: unexpected shapes (n_in %d out %d ws %zu need %zu)\n", n_in, out_size, ws_size, (size_t)WS_END); grid = -1; return; }
        int dev = 0, cus = 0;
        if (hipGetDevice(&dev) != hipSuccess || hipDeviceGetAttribute(&cus, hipDeviceAttributeMultiprocessorCount, dev) != hipSuccess) { grid = -1; return; }
        if (hipFuncSetAttribute((const void*)mk_fwd, hipFuncAttributeMaxDynamicSharedMemorySize, LDS_BYTES) != hipSuccess) { fprintf(stderr, "kernel_launch: hipFuncSetAttribute failed\n"); grid = -1; return; }
        int per_cu = 0;
        if (hipOccupancyMaxActiveBlocksPerMultiprocessor(&per_cu, (const void*)mk_fwd, NTHREADS, LDS_BYTES) != hipSuccess || per_cu < 1) { fprintf(stderr, "kernel_launch: occupancy query says %d blocks per CU\n", per_cu); }
        (void)hipGetLastError();
        grid = cus;
    }
    if (grid < 0) return;
    (void)hipMemsetAsync((char*)d_ws + WS_ZERO, 0, ZERO_BYTES, stream);
    Args a; memset(&a, 0, sizeof(a));
    for (int i = 0; i < 24; ++i) a.in[i] = (const float*)d_in[i];
    a.out = (float*)d_out; a.ws = (unsigned char*)d_ws;
#if MK_MULTI
#ifdef DBG_DUMP_OFF
    for (int p = 0; p <= DBG_LAST; ++p) { a.ph_lo = p; a.ph_hi = p + 1; hipLaunchKernelGGL(mk_fwd, dim3(grid), dim3(NTHREADS), LDS_BYTES, stream, a); }
    hipLaunchKernelGGL(dbg_dump, dim3(1024), dim3(512), 0, stream, (unsigned char*)d_ws, (float*)d_out);
#else
    for (int p = 0; p < NPHASE; ++p) { a.ph_lo = p; a.ph_hi = p + 1; hipLaunchKernelGGL(mk_fwd, dim3(grid), dim3(NTHREADS), LDS_BYTES, stream, a); }
#endif
#else
    a.ph_lo = 0; a.ph_hi = NPHASE;
    hipLaunchKernelGGL(mk_fwd, dim3(grid), dim3(NTHREADS), LDS_BYTES, stream, a);
#endif
}
```

```cpp
#include <hip/hip_runtime.h>
#include <cstdio>
#include <cstdint>
#include <cstring>

#ifndef PROBE_EXTRA_BARRIERS
#define PROBE_EXTRA_BARRIERS 0
#endif
#ifndef PROBE_DOWN_NOSTORE
#define PROBE_DOWN_NOSTORE 0
#endif
#ifndef EXP_DUP_LDS
#define EXP_DUP_LDS 0
#endif
#ifndef EXP_DUP_QK
#define EXP_DUP_QK 0
#endif
#ifndef EXP_DUP_EXP
#define EXP_DUP_EXP 0
#endif
#ifndef ATT_STAGGER
#define ATT_STAGGER 0
#endif
#ifndef NT_STORES
#define NT_STORES 0
#endif
#ifndef DENSE_XCD
#define DENSE_XCD 0
#endif
#ifndef PROBE_SET
#define PROBE_SET 0
#endif
#define PRB(bit) _Pragma("unroll") for (int rep_ = 0; rep_ < (((PROBE_SET) >> (bit)) & 1) + 1; ++rep_)
#ifndef PROBE_REP_MLA
#define PROBE_REP_MLA 1
#endif
#ifndef MCV_BLOCKS
#define MCV_BLOCKS 32
#endif
#ifndef MK_MULTI
#define MK_MULTI 0
#endif

#define LAS __attribute__((address_space(3)))
typedef unsigned short bf16_t;
typedef short bf16x8 __attribute__((ext_vector_type(8)));
typedef short s16x4 __attribute__((ext_vector_type(4)));
typedef float f32x4 __attribute__((ext_vector_type(4)));
typedef float f32x16 __attribute__((ext_vector_type(16)));
typedef unsigned u32x4 __attribute__((ext_vector_type(4)));
typedef unsigned u32x2 __attribute__((ext_vector_type(2)));

constexpr int T = 16384, D = 2048;
constexpr int IN_DIM = 4424, IN_PAD = 4608;
constexpr int OFF_MQ = 0, OFF_MK = 512, OFF_MV = 1024, OFF_MO = 2048, OFF_MI = 3072, OFF_MF = 3076, OFF_CQ = 3080, OFF_CKV = 3848, OFF_KR = 4360;
constexpr int NE = 64, TOPK = 8, EFF = 256;
constexpr int NSLOT = T + T * TOPK + NE * 256;
constexpr int NCH = 256;
constexpr float EPS = 1e-6f;

constexpr size_t al256(size_t x) { return (x + 255) & ~(size_t)255; }
constexpr size_t WS_ZERO = 0;
constexpr size_t ZB_BAR = 0;
constexpr size_t ZB_MOD = 16384;
constexpr size_t ZB_CTR = 16384 + 98304;
constexpr size_t ZERO_BYTES = 16384 + 98304 + 16384;
constexpr size_t WS_ROPE = al256(WS_ZERO + ZERO_BYTES);
constexpr size_t WS_WIN = al256(WS_ROPE + (size_t)T * 32 * 8);
constexpr size_t WS_WUQ = al256(WS_WIN + (size_t)IN_PAD * 2048 * 2);
constexpr size_t WS_WUKV = al256(WS_WUQ + (size_t)1536 * 768 * 2);
constexpr size_t WS_WOUT = al256(WS_WUKV + (size_t)2048 * 512 * 2);
constexpr size_t WS_WQKV = al256(WS_WOUT + (size_t)2048 * 2048 * 2);
constexpr size_t WS_WO = al256(WS_WQKV + (size_t)2560 * 2048 * 2);
constexpr size_t WS_WR = al256(WS_WO + (size_t)2048 * 2048 * 2);
constexpr size_t WS_WGU = al256(WS_WR + (size_t)2 * 256 * 4096 * 2);
constexpr size_t WS_WDN = al256(WS_WGU + (size_t)2 * 65 * 512 * 2048 * 2);
constexpr size_t WS_HA = al256(WS_WDN + (size_t)2 * 65 * 2048 * 256 * 2);
constexpr size_t WS_H2 = al256(WS_HA + (size_t)T * 2048 * 2);
constexpr size_t WS_XA = al256(WS_H2 + (size_t)T * 4096 * 2);
constexpr size_t WS_XB = al256(WS_XA + (size_t)T * 2048 * 4);
constexpr size_t WS_HCAT = al256(WS_XB + (size_t)T * 2048 * 4);
constexpr size_t WS_GA = al256(WS_HCAT + (size_t)T * 2048 * 2);
constexpr size_t WS_GB = al256(WS_GA + (size_t)4 * T * 4);
constexpr size_t WS_GCM = al256(WS_GB + (size_t)4 * T * 4);
constexpr size_t WS_GST = al256(WS_GCM + (size_t)4 * T * 4);
constexpr size_t WS_DN = al256(WS_GST + 16384);
constexpr size_t WS_NST = al256(WS_DN + (size_t)NCH * 4 * 128 * 4);
constexpr size_t WS_LOGP = al256(WS_NST + (size_t)NCH * 4 * 128 * 4);
constexpr size_t WS_TKI = al256(WS_LOGP + (size_t)4 * T * 128 * 4);
constexpr size_t WS_TKW = al256(WS_TKI + (size_t)T * 8 * 4);
constexpr size_t WS_PSLOT = al256(WS_TKW + (size_t)T * 8 * 4);
constexpr size_t WS_HIST = al256(WS_PSLOT + (size_t)T * 8 * 4);
constexpr size_t WS_ETAB = al256(WS_HIST + (size_t)256 * 64 * 4);
constexpr size_t WS_ROWTOK = al256(WS_ETAB + 4096);
constexpr size_t WS_ACT = al256(WS_ROWTOK + (size_t)NSLOT * 4);
constexpr size_t WS_Y = al256(WS_ACT + (size_t)NSLOT * 256 * 2);
constexpr size_t WS_PROJ = WS_Y;
constexpr size_t WS_CQN = al256(WS_PROJ + (size_t)T * IN_PAD * 2);
constexpr size_t WS_CKVN = al256(WS_CQN + (size_t)T * 768 * 2);
constexpr size_t WS_KPE = al256(WS_CKVN + (size_t)T * 512 * 2);
constexpr size_t WS_QRAW = al256(WS_KPE + (size_t)T * 64 * 2);
constexpr size_t WS_KVRAW = al256(WS_QRAW + (size_t)T * 1536 * 2);
constexpr size_t WS_DC = al256(WS_KVRAW + (size_t)T * 2048 * 2);
constexpr size_t WS_CST = al256(WS_DC + (size_t)NCH * 4 * 256 * 128 * 2);
constexpr size_t WS_MIXEND = al256(WS_CST + (size_t)NCH * 4 * 256 * 128 * 2);
constexpr size_t WS_END = al256(WS_Y + (size_t)NSLOT * 2048 * 2);
static_assert(WS_MIXEND <= WS_END, "mixer temporaries must fit inside the Y region");

__device__ __forceinline__ unsigned cvt_pk_bf16(float lo, float hi) { unsigned r; asm volatile("v_cvt_pk_bf16_f32 %0, %1, %2" : "=v"(r) : "v"(lo), "v"(hi)); return r; }
__device__ __forceinline__ float bf2f(unsigned short h) { return __uint_as_float((unsigned)h << 16); }
__device__ __forceinline__ float bflo(unsigned w) { return __uint_as_float(w << 16); }
__device__ __forceinline__ float bfhi(unsigned w) { return __uint_as_float(w & 0xffff0000u); }
__device__ __forceinline__ bf16_t f2bf(float f) { return (bf16_t)(cvt_pk_bf16(f, f) & 0xffffu); }
template <int CTRL> __device__ __forceinline__ float dpp_add(float v) { return v + __int_as_float(__builtin_amdgcn_update_dpp(0, __float_as_int(v), CTRL, 0xF, 0xF, true)); }
__device__ __forceinline__ float wave_sum(float v) {
    v = dpp_add<0xB1>(v); v = dpp_add<0x4E>(v); v = dpp_add<0x141>(v); v = dpp_add<0x140>(v);
    v += __int_as_float(__builtin_amdgcn_ds_swizzle(__float_as_int(v), 0x401F));
    return __int_as_float(__builtin_amdgcn_readlane(__float_as_int(v), 0)) + __int_as_float(__builtin_amdgcn_readlane(__float_as_int(v), 32));
}
template <int CTRL> __device__ __forceinline__ float dpp_max(float v) { return fmaxf(v, __int_as_float(__builtin_amdgcn_update_dpp(__float_as_int(v), __float_as_int(v), CTRL, 0xF, 0xF, false))); }
__device__ __forceinline__ float grp8_max(float v) { v = dpp_max<0xB1>(v); v = dpp_max<0x4E>(v); return dpp_max<0x141>(v); }
__device__ __forceinline__ int wave_incl_scan(int v, int lane) {
#pragma unroll
    for (int o = 1; o < 64; o <<= 1) { const int u = __shfl_up(v, o); v += (lane >= o) ? u : 0; }
    return v;
}
__device__ __forceinline__ float sigmoidf_(float x) { return 1.0f / (1.0f + __expf(-x)); }

#define XB_TMO      128
#define XB_XCNT(j)  (256  + 64 * (j))
#define XB_XSUB(j)  (1280 + 64 * (j))
#define XB_XGEN(j)  (2304 + 64 * (j))
#define XB_TOP      3328
#define XB_TOPGEN   3392
#define XCD_BAR_WORDS 3456
#define XB_SPIN_CAP (1u << 22)
__device__ __forceinline__ unsigned xb_ld(unsigned* p)              { return __hip_atomic_load(p, __ATOMIC_RELAXED, __HIP_MEMORY_SCOPE_AGENT); }
__device__ __forceinline__ unsigned xb_add(unsigned* p, unsigned v) { return __hip_atomic_fetch_add(p, v, __ATOMIC_RELAXED, __HIP_MEMORY_SCOPE_AGENT); }
__device__ __forceinline__ unsigned xb_xcc_id() { return (unsigned)__builtin_amdgcn_s_getreg((3 << 11) | 20) & 0xFu; }
#define XB_SPIN(cond, bar) do { unsigned _sp = 0; while (cond) { __builtin_amdgcn_s_sleep(1); \
    if ((++_sp & 255u) == 0u) { if (xb_ld(&(bar)[XB_TMO])) break; if (_sp > XB_SPIN_CAP) { atomicAdd(&(bar)[XB_TMO], 1u); break; } } } } while (0)
struct XcdBarrier { unsigned* bar; unsigned x; volatile LAS unsigned* st; };
__device__ __forceinline__ XcdBarrier xcd_barrier_post(unsigned* bar, volatile LAS unsigned* st) {
    XcdBarrier b; b.bar = bar; b.x = xb_xcc_id(); b.st = st;
    if (threadIdx.x == 0) (void)xb_add(&bar[XB_XCNT(b.x)], 1u);
    return b;
}
__device__ __forceinline__ void xcd_barrier_complete(unsigned* bar, unsigned x, unsigned& nloc, unsigned& nx) {
    const unsigned G = gridDim.x * gridDim.y * gridDim.z;
    unsigned sum, cnt, mine, sp = 0u;
    for (;;) {
        sum = 0u; cnt = 0u; mine = 0u;
#pragma unroll
        for (unsigned j = 0; j < 16; ++j) { const unsigned c = xb_ld(&bar[XB_XCNT(j)]); sum += c; cnt += (c > 0u) ? 1u : 0u; mine = (j == x) ? c : mine; }
        if (sum == G) break;
        __builtin_amdgcn_s_sleep(1);
        if ((++sp & 255u) == 0u) { if (xb_ld(&bar[XB_TMO])) break; if (sp > XB_SPIN_CAP) { atomicAdd(&bar[XB_TMO], 1u); break; } }
    }
    nloc = mine > 0u ? mine : 1u; nx = cnt > 0u ? cnt : 1u;
}
__device__ __forceinline__ void xcd_barrier(const XcdBarrier& b) {
    asm volatile("s_waitcnt vmcnt(0)" ::: "memory");
    __syncthreads();
    if (threadIdx.x == 0) {
        unsigned* bar = b.bar;
        __builtin_amdgcn_s_waitcnt(0);
        unsigned nloc = b.st[0], nx = b.st[1];
        if (nloc == 0u) { xcd_barrier_complete(bar, b.x, nloc, nx); b.st[0] = nloc; b.st[1] = nx; }
        const unsigned old = xb_add(&bar[XB_XSUB(b.x)], 1u);
        const unsigned gen = old / nloc;
        if (old + 1u == (gen + 1u) * nloc) {
            __builtin_amdgcn_fence(__ATOMIC_RELEASE, "agent");
            asm volatile("s_waitcnt vmcnt(0)" ::: "memory");
            const unsigned og = xb_add(&bar[XB_TOP], 1u);
            const unsigned tg = og / nx;
            if (og + 1u == (tg + 1u) * nx) xb_add(&bar[XB_TOPGEN], 1u);
            else XB_SPIN(xb_ld(&bar[XB_TOPGEN]) == tg, bar);
            __builtin_amdgcn_fence(__ATOMIC_ACQUIRE, "agent");
            xb_add(&bar[XB_XGEN(b.x)], 1u);
            asm volatile("s_waitcnt vmcnt(0)" ::: "memory");
        } else {
            XB_SPIN(xb_ld(&bar[XB_XGEN(b.x)]) == gen, bar);
            __builtin_amdgcn_fence(__ATOMIC_ACQUIRE, "agent");
            asm volatile("s_waitcnt vmcnt(0)" ::: "memory");
        }
    }
    __syncthreads();
}

struct Args {
    const float* in[24];
    float* out;
    unsigned char* ws;
    int ph_lo, ph_hi;
};
constexpr int NTHREADS = 512;
constexpr int LDS_MAIN = 131072, LDS_AUX = 16384;
constexpr int LDS_BYTES = LDS_MAIN + LDS_AUX + 16;

struct Frame {
    LAS unsigned char* lds;
    LAS unsigned char* aux;
    const float* const* in;
    float* out;
    unsigned char* ws;
    int tid, lane, wid, G, bid;
};
#define WSP(T_, off) ((T_*)(F.ws + (off)))

namespace pg8 {
constexpr int BM = 256, BK = 64, HALF = 128, HTB = HALF * BK * 2, STAGE_BYTES = 8 * HTB;
__device__ __forceinline__ int lds_byte(int r, int c) { const int st = (r >> 4) * 2 + (c >> 5), rr = r & 15, cc = c & 31, ob = rr * 64 + cc * 2; return st * 1024 + (ob ^ (((ob >> 9) & 1) << 5)); }
__device__ __forceinline__ void stage_rc(int b, int& R, int& C) { const int st = b / 1024, sb = b % 1024, swz = sb ^ (((sb >> 9) & 1) << 5); R = (st >> 1) * 16 + swz / 64; C = (st & 1) * 32 + (swz % 64) / 2; }
__device__ __forceinline__ int perm32(int rho) { const int n = rho >> 4, i = rho & 15; return 8 * (i >> 2) + 4 * n + (i & 3); }
struct Unit { int a, b, c, d; };

template <class P>
__device__ __forceinline__ void gemm_phase(LAS unsigned char* lds, const P& p) {
    const int tid = threadIdx.x, wid = __builtin_amdgcn_readfirstlane(tid >> 6), lane = tid & 63, wr = wid >> 2, wc = wid & 3, fr = lane & 15, fq = lane >> 4;
    const int K = p.K, nt = K / BK;
    const int G = p.stride(), c0 = p.first();
    const int NU = p.nunits();
    if (c0 >= NU) return;
    int R[2], C[2]; unsigned voffB[2][2];
#pragma unroll
    for (int i = 0; i < 2; ++i) { stage_rc(tid * 16 + i * 8192, R[i], C[i]); const int Rb = P::PERM ? ((R[i] & ~31) + perm32(R[i] & 31)) : R[i];
#pragma unroll
        for (int h = 0; h < 2; ++h) voffB[h][i] = (unsigned)((h * HALF + Rb) * p.ldb + C[i]) * 2u; }
    const size_t kstep = (size_t)(BK * 2);
    const unsigned ldsw = (unsigned)wid * 1024u;
    const int aoff = lds_byte(wr * 64 + fr, fq * 8), boff = lds_byte(wc * 32 + fr, fq * 8);
    const char* const Ab = p.abase();
#define PG8_SA(b, h) (((b) * 2 + (h)) * HTB)
#define PG8_SB(b, h) ((4 + (b) * 2 + (h)) * HTB)
#define PG8_STAGE(bufoff, gbase, o0, o1) do { \
        __builtin_amdgcn_global_load_lds((const unsigned*)((const char*)(gbase) + (o0)), (LAS unsigned*)(lds + (bufoff) + ldsw), 16, 0, 0); \
        __builtin_amdgcn_global_load_lds((const unsigned*)((const char*)(gbase) + (o1)), (LAS unsigned*)(lds + (bufoff) + ldsw + 8192), 16, 0, 0); } while (0)
#define PG8_LDA(dst, b, h) do { _Pragma("unroll") for (int m = 0; m < 4; ++m) _Pragma("unroll") for (int k = 0; k < 2; ++k) dst[m][k] = *(const LAS bf16x8*)(lds + PG8_SA(b, h) + aoff + m * 2048 + k * 1024); } while (0)
#define PG8_LDB(dst, b, h) do { _Pragma("unroll") for (int n = 0; n < 2; ++n) _Pragma("unroll") for (int k = 0; k < 2; ++k) dst[n][k] = *(const LAS bf16x8*)(lds + PG8_SB(b, h) + boff + n * 2048 + k * 1024); } while (0)
#define PG8_MMA(ai, bj, At, Bt) do { __builtin_amdgcn_s_setprio(1); _Pragma("unroll") for (int m = 0; m < 4; ++m) _Pragma("unroll") for (int n = 0; n < 2; ++n) _Pragma("unroll") for (int k = 0; k < 2; ++k) \
        acc[ai][bj][m][n] = __builtin_amdgcn_mfma_f32_16x16x32_bf16(Bt[n][k], At[m][k], acc[ai][bj][m][n], 0, 0, 0); __builtin_amdgcn_s_setprio(0); } while (0)
#define PG8_WAIT_V(n) asm volatile("s_waitcnt vmcnt(" #n ")" ::: "memory")
#define PG8_WAIT_L(n) asm volatile("s_waitcnt lgkmcnt(" #n ")" ::: "memory")
#define PG8_BAR __builtin_amdgcn_s_barrier()
#define PG8_SCHED __builtin_amdgcn_sched_barrier(0)
    Unit cur, nxt; int ui = 0;
    p.unit(c0, cur);
    unsigned aoc[2][2], aon[2][2];
    p.a_off(cur, R, C, aoc);
    f32x4 acc[2][2][4][2];
#pragma unroll
    for (int a = 0; a < 2; ++a)
#pragma unroll
        for (int b = 0; b < 2; ++b)
#pragma unroll
            for (int m = 0; m < 4; ++m)
#pragma unroll
                for (int n = 0; n < 2; ++n) acc[a][b][m][n] = (f32x4){0.f, 0.f, 0.f, 0.f};
    bf16x8 At[4][2], B0[2][2], B1[2][2];
    const char* cB = p.bbase(cur);
    PG8_STAGE(PG8_SB(0, 0), cB, voffB[0][0], voffB[0][1]); PG8_STAGE(PG8_SA(0, 0), Ab, aoc[0][0], aoc[0][1]);
    PG8_STAGE(PG8_SB(0, 1), cB, voffB[1][0], voffB[1][1]); PG8_STAGE(PG8_SA(0, 1), Ab, aoc[1][0], aoc[1][1]);
    if (wr == 1) PG8_BAR;
    PG8_WAIT_V(4); PG8_BAR;
    PG8_STAGE(PG8_SB(1, 0), cB + kstep, voffB[0][0], voffB[0][1]); PG8_STAGE(PG8_SA(1, 0), Ab + kstep, aoc[0][0], aoc[0][1]);
    PG8_STAGE(PG8_SB(1, 1), cB + kstep, voffB[1][0], voffB[1][1]);
    PG8_WAIT_V(6); PG8_BAR;
    for (;;) {
        const bool has_next = (c0 + (ui + 1) * G) < NU;
        if (has_next) { p.unit(c0 + (ui + 1) * G, nxt); p.a_off(nxt, R, C, aon); }
        else { nxt = cur;
#pragma unroll
            for (int h = 0; h < 2; ++h)
#pragma unroll
                for (int i = 0; i < 2; ++i) aon[h][i] = aoc[h][i]; }
        const char* nB = has_next ? p.bbase(nxt) : cB;
        for (int t = 0; t < nt; t += 2) {
            const bool last = (t == nt - 2);
            const char* a1 = Ab + (size_t)(t + 1) * kstep;
            const char* a2 = last ? Ab : Ab + (size_t)(t + 2) * kstep; const char* b2 = last ? nB : cB + (size_t)(t + 2) * kstep;
            const char* a3 = a2 + kstep; const char* b3 = b2 + kstep;
            unsigned ao2[2][2];
#pragma unroll
            for (int h = 0; h < 2; ++h)
#pragma unroll
                for (int i = 0; i < 2; ++i) ao2[h][i] = last ? aon[h][i] : aoc[h][i];
            PG8_LDB(B0, 0, 0); PG8_SCHED; PG8_LDA(At, 0, 0); PG8_STAGE(PG8_SA(1, 1), a1, aoc[1][0], aoc[1][1]);
            PG8_WAIT_L(8); PG8_BAR; PG8_WAIT_L(0); PG8_MMA(0, 0, At, B0); PG8_BAR; PG8_SCHED;
            PG8_LDB(B1, 0, 1); PG8_STAGE(PG8_SB(0, 0), b2, voffB[0][0], voffB[0][1]);
            PG8_BAR; PG8_WAIT_L(0); PG8_MMA(0, 1, At, B1); PG8_BAR;
            PG8_LDA(At, 0, 1); PG8_STAGE(PG8_SA(0, 0), a2, ao2[0][0], ao2[0][1]);
            PG8_BAR; PG8_WAIT_L(0); PG8_MMA(1, 0, At, B0); PG8_BAR; PG8_SCHED;
            PG8_STAGE(PG8_SB(0, 1), b2, voffB[1][0], voffB[1][1]);
            PG8_WAIT_V(6); PG8_BAR; PG8_MMA(1, 1, At, B1); PG8_BAR;
            PG8_LDB(B0, 1, 0); PG8_SCHED; PG8_LDA(At, 1, 0); PG8_STAGE(PG8_SA(0, 1), a2, ao2[1][0], ao2[1][1]);
            PG8_WAIT_L(8); PG8_BAR; PG8_WAIT_L(0); PG8_MMA(0, 0, At, B0); PG8_BAR; PG8_SCHED;
            PG8_LDB(B1, 1, 1); PG8_STAGE(PG8_SB(1, 0), b3, voffB[0][0], voffB[0][1]);
            PG8_BAR; PG8_WAIT_L(0); PG8_MMA(0, 1, At, B1); PG8_BAR;
            PG8_LDA(At, 1, 1); PG8_STAGE(PG8_SA(1, 0), a3, ao2[0][0], ao2[0][1]);
            PG8_BAR; PG8_WAIT_L(0); PG8_MMA(1, 0, At, B0); PG8_BAR; PG8_SCHED;
            PG8_STAGE(PG8_SB(1, 1), b3, voffB[1][0], voffB[1][1]);
            PG8_WAIT_V(6); PG8_BAR; PG8_MMA(1, 1, At, B1); PG8_BAR;
        }
        p.epi(acc, cur, wr, wc, fr, fq);
        if (!has_next) break;
#pragma unroll
        for (int a = 0; a < 2; ++a)
#pragma unroll
            for (int b = 0; b < 2; ++b)
#pragma unroll
                for (int m = 0; m < 4; ++m)
#pragma unroll
                    for (int n = 0; n < 2; ++n) acc[a][b][m][n] = (f32x4){0.f, 0.f, 0.f, 0.f};
        cur = nxt; cB = nB; ++ui;
#pragma unroll
        for (int h = 0; h < 2; ++h)
#pragma unroll
            for (int i = 0; i < 2; ++i) aoc[h][i] = aon[h][i];
    }
    PG8_WAIT_V(0);
    if (wr == 0) PG8_BAR;
    PG8_BAR;
#undef PG8_SA
#undef PG8_SB
#undef PG8_STAGE
#undef PG8_LDA
#undef PG8_LDB
#undef PG8_MMA
#undef PG8_WAIT_V
#undef PG8_WAIT_L
#undef PG8_BAR
#undef PG8_SCHED
}
}

__device__ __forceinline__ void adaln_sc(const Frame& F) {
    const float* c = F.in[1]; LAS float* sc = (LAS float*)F.lds;
    __syncthreads();
    for (int i = F.tid; i < 2048; i += NTHREADS) { const float cv = c[i]; sc[i] = cv / (1.0f + expf(-cv)); }
    __syncthreads();
}
__device__ __forceinline__ void adaln_unit(const Frame& F, int u) {
    const float* w_ada = F.in[3]; const float* b_ada = F.in[4];
    float* mod = WSP(float, WS_ZERO + ZB_MOD);
    const LAS float* sc = (const LAS float*)F.lds;
    LAS f32x4* part = (LAS f32x4*)(F.lds + 8192);
    const int cg = F.tid % 24, kg = F.tid / 24;
    const int l = u >> 7, col0 = (u & 127) * 96;
    if (F.tid < 504) {
        f32x4 acc = (f32x4){0.f, 0.f, 0.f, 0.f};
        const float* wp = w_ada + (size_t)l * 2048 * 12288 + col0 + cg * 4;
#pragma unroll 7
        for (int k = kg; k < 2048; k += 21) { const f32x4 w = *(const f32x4*)(wp + (size_t)k * 12288); acc += w * sc[k]; }
        part[kg * 24 + cg] = acc;
    }
    __syncthreads();
    if (F.tid < 96) { float s_ = 0.f; const LAS float* pf = (const LAS float*)part;
        for (int g = 0; g < 21; ++g) s_ += pf[g * 96 + F.tid];
        mod[(size_t)l * 12288 + col0 + F.tid] = s_ + b_ada[(size_t)l * 12288 + col0 + F.tid]; }
    __syncthreads();
}
__device__ __forceinline__ void ph_adaln(const Frame& F) {
    if (F.bid >= 128 && F.G >= 256) return;
    adaln_sc(F);
    for (int u = F.bid; u < 128; u += F.G) adaln_unit(F, u);
}

__device__ __forceinline__ void ph_rope_table(const Frame& F) {
    const int* pos = (const int*)F.in[2];
    float2* tab = WSP(float2, WS_ROPE);
    for (int idx = F.bid * NTHREADS + F.tid; idx < T * 32; idx += F.G * NTHREADS) {
        const int t = idx >> 5, i = idx & 31;
        const float inv_freq = (float)exp2(-(double)i * (13.287712379549449 / 32.0));
        const float ang = (float)pos[t] * inv_freq;
        const double rev = (double)ang * 0.15915494309189535;
        const float fr = (float)(rev - rint(rev));
        tab[idx] = make_float2(__builtin_amdgcn_cosf(fr), __builtin_amdgcn_sinf(fr));
    }
}

struct CvtJob { const float* src; bf16_t* dst; int K, Nsrc, Ndst, batch, mode, tiles_per_mat, tile0; size_t sbs, dbs; };
__device__ __forceinline__ void cvt_load(const Frame& F, const CvtJob& j, int lt, f32x4 (&v)[2][2]) {
    const int b = lt / j.tiles_per_mat, r = lt - b * j.tiles_per_mat;
    const int nkt = j.K / 128, ntile = r / nkt, kt = r - ntile * nkt;
    const float* src = j.src + (size_t)b * j.sbs;
    const int n4 = F.tid & 15, kp = F.tid >> 4;
    const int nd = ntile * 64 + n4 * 4;
    int scol; bool valid;
    if (j.mode == 1) { scol = ((nd >> 7) & 1) * 256 + (nd >> 8) * 128 + (nd & 127); valid = true; }
    else { scol = nd; valid = nd < j.Nsrc; }
#pragma unroll
    for (int jj = 0; jj < 2; ++jj)
#pragma unroll
        for (int e = 0; e < 2; ++e) { const int k = kt * 128 + jj * 64 + kp * 2 + e;
            v[jj][e] = valid ? __builtin_nontemporal_load((const f32x4*)(src + (size_t)k * j.Nsrc + scol)) : (f32x4){0.f, 0.f, 0.f, 0.f}; }
}
__device__ __forceinline__ void cvt_store(const Frame& F, const CvtJob& j, int lt, const f32x4 (&v)[2][2]) {
    const int b = lt / j.tiles_per_mat, r = lt - b * j.tiles_per_mat;
    const int nkt = j.K / 128, ntile = r / nkt, kt = r - ntile * nkt;
    bf16_t* dst = j.dst + (size_t)b * j.dbs;
    LAS unsigned* L = (LAS unsigned*)F.lds;
    const int n4 = F.tid & 15, kp = F.tid >> 4;
#pragma unroll
    for (int jj = 0; jj < 2; ++jj)
#pragma unroll
        for (int i = 0; i < 4; ++i) L[(n4 * 4 + i) * 65 + jj * 32 + kp] = cvt_pk_bf16(v[jj][0][i], v[jj][1][i]);
    __syncthreads();
    const int n = F.tid >> 3, ch = F.tid & 7;
    u32x4 o0, o1;
    o0.x = L[n * 65 + ch * 8 + 0]; o0.y = L[n * 65 + ch * 8 + 1]; o0.z = L[n * 65 + ch * 8 + 2]; o0.w = L[n * 65 + ch * 8 + 3];
    o1.x = L[n * 65 + ch * 8 + 4]; o1.y = L[n * 65 + ch * 8 + 5]; o1.z = L[n * 65 + ch * 8 + 6]; o1.w = L[n * 65 + ch * 8 + 7];
    bf16_t* dp = dst + (size_t)(ntile * 64 + n) * j.K + kt * 128 + ch * 16;
    *(u32x4*)dp = o0; *(u32x4*)(dp + 8) = o1;
    __syncthreads();
}
constexpr int NJOBS = 14;
__device__ __forceinline__ CvtJob make_job(const float* src, bf16_t* dst, int K, int Nsrc, int Ndst, int batch, int mode, size_t sbs, size_t dbs) {
    CvtJob j; j.src = src; j.dst = dst; j.K = K; j.Nsrc = Nsrc; j.Ndst = Ndst; j.batch = batch; j.mode = mode; j.sbs = sbs; j.dbs = dbs;
    j.tiles_per_mat = (K / 128) * (Ndst / 64); j.tile0 = 0; return j;
}
__device__ __forceinline__ void ph_convert(const Frame& F) {
    const bool split = F.G >= 256; const int VG = split ? F.G - 128 : F.G, vb_ = split ? F.bid - 128 : F.bid;
    int run = 0;
    if (vb_ >= 0) {
#define DO_JOB(J) do { const CvtJob jb = (J); const int nt_ = jb.tiles_per_mat * jb.batch; \
        int lt = (vb_ - (run % VG) + VG) % VG; f32x4 va[2][2], vb[2][2]; \
        if (lt < nt_) cvt_load(F, jb, lt, va); \
        for (; lt < nt_; lt += VG) { const int ltn = lt + VG; if (ltn < nt_) cvt_load(F, jb, ltn, vb); cvt_store(F, jb, lt, va); \
            _Pragma("unroll") for (int a_ = 0; a_ < 2; ++a_) _Pragma("unroll") for (int b_ = 0; b_ < 2; ++b_) va[a_][b_] = vb[a_][b_]; } \
        run += nt_; } while (0)
    DO_JOB(make_job(F.in[5], WSP(bf16_t, WS_WIN), 2048, IN_DIM, IN_PAD, 1, 0, 0, 0));
    DO_JOB(make_job(F.in[10], WSP(bf16_t, WS_WUQ), 768, 1536, 1536, 1, 0, 0, 0));
    DO_JOB(make_job(F.in[11], WSP(bf16_t, WS_WUKV), 512, 2048, 2048, 1, 0, 0, 0));
    DO_JOB(make_job(F.in[12], WSP(bf16_t, WS_WOUT), 2048, 2048, 2048, 1, 0, 0, 0));
#undef DO_JOB
    }
    bf16_t* wr = WSP(bf16_t, WS_WR);
    for (int idx = F.bid * NTHREADS + F.tid; idx < 2 * 256 * 2048; idx += F.G * NTHREADS) {
        const int l = idx >> 19, n = (idx >> 11) & 255, k = idx & 2047;
        bf16_t o = 0;
        if (n < 128) { const int e = n & 63;
            const float w = F.in[17][((size_t)l * 2048 + k) * 64 + e];
            const bf16_t hi = f2bf(w);
            o = (n < 64) ? hi : f2bf(w - bf2f(hi)); }
        wr[idx] = o;
    }
}

constexpr int MCV_CHUNK = 32;
constexpr int MCV_LAYER_TILES = 8192 + 128 + 4096 + 64;
constexpr int MCV_NMOE = 2 * MCV_LAYER_TILES / MCV_CHUNK;
constexpr int MCV_NCVT = MCV_NMOE + 20 + 16;
constexpr int MCV_NCHUNK = MCV_NCVT + 128;
__device__ __forceinline__ int grab(const Frame& F, unsigned* ctr) {
    LAS int* sl = (LAS int*)(F.aux + 16000);
    __syncthreads();
    if (F.tid == 0) *sl = (int)__hip_atomic_fetch_add(ctr, 1u, __ATOMIC_RELAXED, __HIP_MEMORY_SCOPE_AGENT);
    __syncthreads();
    return __builtin_amdgcn_readfirstlane(*sl);
}
__device__ __forceinline__ void moe_cvt_chunk(const Frame& F, int c) {
    if (c >= MCV_NCVT) { adaln_sc(F); adaln_unit(F, 128 + (c - MCV_NCVT)); return; }
    const int gt = c * MCV_CHUNK, l = gt / MCV_LAYER_TILES, r = gt - l * MCV_LAYER_TILES;
    CvtJob jb; int lt0;
    if (c >= MCV_NMOE + 20) { lt0 = (c - MCV_NMOE - 20) * MCV_CHUNK; jb = make_job(F.in[16], WSP(bf16_t, WS_WO), 2048, 2048, 2048, 1, 0, 0, 0); }
    else if (c >= MCV_NMOE) { lt0 = (c - MCV_NMOE) * MCV_CHUNK; jb = make_job(F.in[13], WSP(bf16_t, WS_WQKV), 2048, 2560, 2560, 1, 0, 0, 0); }
    else if (r < 8192) { lt0 = r; jb = make_job(F.in[19] + (size_t)l * 64 * 2048 * 512, WSP(bf16_t, WS_WGU) + (size_t)l * 65 * 512 * 2048, 2048, 512, 512, 64, 1, (size_t)2048 * 512, (size_t)512 * 2048); }
    else if (r < 8320) { lt0 = r - 8192; jb = make_job(F.in[21] + (size_t)l * 2048 * 512, WSP(bf16_t, WS_WGU) + ((size_t)l * 65 + 64) * 512 * 2048, 2048, 512, 512, 1, 1, 0, 0); }
    else if (r < 12416) { lt0 = r - 8320; jb = make_job(F.in[20] + (size_t)l * 64 * 256 * 2048, WSP(bf16_t, WS_WDN) + (size_t)l * 65 * 2048 * 256, 256, 2048, 2048, 64, 0, (size_t)256 * 2048, (size_t)2048 * 256); }
    else { lt0 = r - 12416; jb = make_job(F.in[22] + (size_t)l * 256 * 2048, WSP(bf16_t, WS_WDN) + ((size_t)l * 65 + 64) * 2048 * 256, 256, 2048, 2048, 1, 0, 0, 0); }
    f32x4 v0[2][2], v1[2][2], v2[2][2], v3[2][2];
    cvt_load(F, jb, lt0, v0); cvt_load(F, jb, lt0 + 1, v1); cvt_load(F, jb, lt0 + 2, v2);
#pragma unroll 1
    for (int i = 0; i < MCV_CHUNK; i += 4) {
        cvt_load(F, jb, lt0 + i + 3, v3); cvt_store(F, jb, lt0 + i, v0);
        if (i + 4 < MCV_CHUNK) cvt_load(F, jb, lt0 + i + 4, v0);
        cvt_store(F, jb, lt0 + i + 1, v1);
        if (i + 4 < MCV_CHUNK) cvt_load(F, jb, lt0 + i + 5, v1);
        cvt_store(F, jb, lt0 + i + 2, v2);
        if (i + 4 < MCV_CHUNK) cvt_load(F, jb, lt0 + i + 6, v2);
        cvt_store(F, jb, lt0 + i + 3, v3);
    }
}
__device__ __forceinline__ void moe_cvt_queue(const Frame& F) {
    unsigned* ctr = WSP(unsigned, WS_ZERO + ZB_CTR);
    for (;;) { const int c = grab(F, ctr); if (c >= MCV_NCHUNK) break; moe_cvt_chunk(F, c); }
}

template <int MODE>
__device__ __forceinline__ void ph_modulate(const Frame& F, const void* x, const float* shift, const float* scale, bf16_t* out) {
    f32x4 sc[8], sh[8];
#pragma unroll
    for (int j = 0; j < 8; ++j) { const int col = 4 * F.lane + 256 * j; sc[j] = *(const f32x4*)(scale + col) + 1.0f; sh[j] = *(const f32x4*)(shift + col); }
    for (int row = F.bid * 8 + F.wid; row < T; row += F.G * 8) {
        f32x4 v[8]; float ss = 0.f;
        if (MODE == 1) { u32x2 xw[8];
#pragma unroll
            for (int j = 0; j < 8; ++j) xw[j] = *(const u32x2*)((const bf16_t*)x + (size_t)row * D + 4 * F.lane + 256 * j);
#pragma unroll
            for (int j = 0; j < 8; ++j) v[j] = (f32x4){bflo(xw[j].x), bfhi(xw[j].x), bflo(xw[j].y), bfhi(xw[j].y)};
        }
#pragma unroll
        for (int j = 0; j < 8; ++j) { if (MODE == 0) v[j] = __builtin_nontemporal_load((const f32x4*)((const float*)x + (size_t)row * D + 4 * F.lane + 256 * j)); ss += v[j][0] * v[j][0] + v[j][1] * v[j][1] + v[j][2] * v[j][2] + v[j][3] * v[j][3]; }
        ss = wave_sum(ss);
        const float rstd = rsqrtf(ss * (1.0f / D) + EPS);
#pragma unroll
        for (int j = 0; j < 8; ++j) {
            const f32x4 h = (v[j] * rstd) * sc[j] + sh[j];
            const int col = 4 * F.lane + 256 * j;
            u32x2 hi; hi.x = cvt_pk_bf16(h[0], h[1]); hi.y = cvt_pk_bf16(h[2], h[3]);
            if (MODE == 0) { *(u32x2*)(out + (size_t)row * 2048 + col) = hi; }
            else {
                *(u32x2*)(out + (size_t)row * 2048 + col) = hi;
            }
        }
    }
}

typedef float f32x2_ __attribute__((ext_vector_type(2)));
template <int FINAL>
__device__ __forceinline__ void ph_combine(const Frame& F, const bf16_t* xold, const float* g, bf16_t* xnew, const float* shift, const float* scale, bf16_t* hout, float* fout) {
    const unsigned char* Y = WSP(unsigned char, WS_Y); const int* pslot = WSP(int, WS_PSLOT); const float* tkw = WSP(float, WS_TKW);
    for (int row = F.bid * 8 + F.wid; row < T; row += F.G * 8) {
        int sl[9]; float w[9];
#pragma unroll
        for (int k = 0; k < 8; ++k) { sl[k] = pslot[row * 8 + k]; w[k] = tkw[row * 8 + k] * (1.0f / 8.0f); }
        sl[8] = row; w[8] = 1.0f / 8.0f;
        float xn[2][16]; float ss = 0.f;
#pragma unroll
        for (int j = 0; j < 2; ++j) {
            const int col = 16 * F.lane + 1024 * j;
            float a[16];
#pragma unroll
            for (int e = 0; e < 16; ++e) a[e] = 0.f;
#pragma unroll
            for (int k = 0; k < 9; ++k) { const u32x4 y = __builtin_nontemporal_load((const u32x4*)(Y + (size_t)sl[k] * 2048 + col));
#pragma unroll
                for (int q = 0; q < 4; ++q) { const f32x2_ lo = __builtin_amdgcn_cvt_pk_f32_fp8((int)y[q], false), hi = __builtin_amdgcn_cvt_pk_f32_fp8((int)y[q], true);
                    a[4 * q + 0] += w[k] * lo[0]; a[4 * q + 1] += w[k] * lo[1]; a[4 * q + 2] += w[k] * hi[0]; a[4 * q + 3] += w[k] * hi[1]; } }
            const u32x4 xw0 = *(const u32x4*)(xold + (size_t)row * D + col), xw1 = *(const u32x4*)(xold + (size_t)row * D + col + 8);
            const unsigned xw[8] = {xw0.x, xw0.y, xw0.z, xw0.w, xw1.x, xw1.y, xw1.z, xw1.w};
#pragma unroll
            for (int q = 0; q < 4; ++q) { const f32x4 x0 = (f32x4){bflo(xw[2 * q]), bfhi(xw[2 * q]), bflo(xw[2 * q + 1]), bfhi(xw[2 * q + 1])}; const f32x4 g0 = *(const f32x4*)(g + col + 4 * q);
#pragma unroll
                for (int e = 0; e < 4; ++e) { const float v = x0[e] + g0[e] * a[4 * q + e]; xn[j][4 * q + e] = v; ss += v * v; } }
            if (!FINAL) { u32x4 o0, o1; o0.x = cvt_pk_bf16(xn[j][0], xn[j][1]); o0.y = cvt_pk_bf16(xn[j][2], xn[j][3]); o0.z = cvt_pk_bf16(xn[j][4], xn[j][5]); o0.w = cvt_pk_bf16(xn[j][6], xn[j][7]);
                o1.x = cvt_pk_bf16(xn[j][8], xn[j][9]); o1.y = cvt_pk_bf16(xn[j][10], xn[j][11]); o1.z = cvt_pk_bf16(xn[j][12], xn[j][13]); o1.w = cvt_pk_bf16(xn[j][14], xn[j][15]);
                *(u32x4*)(xnew + (size_t)row * D + col) = o0; *(u32x4*)(xnew + (size_t)row * D + col + 8) = o1; }
        }
        ss = wave_sum(ss);
        const float rstd = rsqrtf(ss * (1.0f / D) + EPS);
#pragma unroll
        for (int j = 0; j < 2; ++j) {
            const int col = 16 * F.lane + 1024 * j;
            float h[16];
#pragma unroll
            for (int q = 0; q < 4; ++q) { const f32x4 s0 = *(const f32x4*)(scale + col + 4 * q);
                if (FINAL) { f32x4 o0;
#pragma unroll
                    for (int e = 0; e < 4; ++e) o0[e] = xn[j][4 * q + e] * rstd * s0[e];
                    *(f32x4*)(fout + (size_t)row * D + col + 4 * q) = o0; }
                else { const f32x4 h0 = *(const f32x4*)(shift + col + 4 * q);
#pragma unroll
                    for (int e = 0; e < 4; ++e) h[4 * q + e] = xn[j][4 * q + e] * rstd * (1.0f + s0[e]) + h0[e]; } }
            if (!FINAL) { u32x4 o0, o1; o0.x = cvt_pk_bf16(h[0], h[1]); o0.y = cvt_pk_bf16(h[2], h[3]); o0.z = cvt_pk_bf16(h[4], h[5]); o0.w = cvt_pk_bf16(h[6], h[7]);
                o1.x = cvt_pk_bf16(h[8], h[9]); o1.y = cvt_pk_bf16(h[10], h[11]); o1.z = cvt_pk_bf16(h[12], h[13]); o1.w = cvt_pk_bf16(h[14], h[15]);
                *(u32x4*)(hout + (size_t)row * 2048 + col) = o0; *(u32x4*)(hout + (size_t)row * 2048 + col + 8) = o1; }
        }
    }
}

using pg8::Unit;
template <bool NT>
__device__ __forceinline__ void store_bf16_tile(const f32x4 (&acc)[2][2][4][2], bf16_t* O, int ldc, int row0, int col0, const float* bias, int bcol0, int wr, int wc, int fr, int fq) {
    const int r0 = row0 + wr * 64 + fr, c0 = col0 + wc * 32 + 8 * fq, bc0 = bcol0 + wc * 32 + 8 * fq;
    f32x4 bv[2][2];
#pragma unroll
    for (int bj = 0; bj < 2; ++bj)
#pragma unroll
        for (int n = 0; n < 2; ++n) bv[bj][n] = bias ? *(const f32x4*)(bias + bc0 + bj * 128 + 4 * n) : (f32x4){0.f, 0.f, 0.f, 0.f};
#pragma unroll
    for (int ai = 0; ai < 2; ++ai)
#pragma unroll
        for (int m = 0; m < 4; ++m) { bf16_t* rowp = O + (size_t)(r0 + ai * 128 + m * 16) * ldc + c0;
#pragma unroll
            for (int bj = 0; bj < 2; ++bj) { const f32x4 v0 = acc[ai][bj][m][0] + bv[bj][0], v1 = acc[ai][bj][m][1] + bv[bj][1];
                u32x4 w; w.x = cvt_pk_bf16(v0[0], v0[1]); w.y = cvt_pk_bf16(v0[2], v0[3]); w.z = cvt_pk_bf16(v1[0], v1[1]); w.w = cvt_pk_bf16(v1[2], v1[3]);
                if (NT) __builtin_nontemporal_store(w, (u32x4*)(rowp + bj * 128)); else *(u32x4*)(rowp + bj * 128) = w; } }
}

struct PolDenseBase {
    const bf16_t* A; const bf16_t* Bt; int lda, ldb, K, nM, nN;
    __device__ __forceinline__ int nunits() const { return nM * nN; }
    __device__ __forceinline__ int first() const { return blockIdx.x; }
    __device__ __forceinline__ int stride() const { return gridDim.x; }
    __device__ __forceinline__ void unit(int L, Unit& u) const {
#if DENSE_XCD
        const int nwg = nM * nN; int wgid = L;
        if ((gridDim.x & 7) == 0) { const int q = nwg / 8, r = nwg % 8, xcd = wgid % 8, off = wgid / 8; wgid = (xcd < r ? xcd * (q + 1) : r * (q + 1) + (xcd - r) * q) + off; }
        const int nig = 8 * nN, gid = wgid / nig, fm = gid * 8, gsz = (nM - fm) < 8 ? (nM - fm) : 8;
        u.a = fm + ((wgid % nig) % gsz); u.b = (wgid % nig) / gsz; u.c = 0; u.d = 0;
#else
        u.a = L / nN; u.b = L - u.a * nN; u.c = 0; u.d = 0;
#endif
    }
    __device__ __forceinline__ const char* abase() const { return (const char*)A; }
    __device__ __forceinline__ void a_off(const Unit& u, const int (&R)[2], const int (&C)[2], unsigned (&off)[2][2]) const {
#pragma unroll
        for (int h = 0; h < 2; ++h)
#pragma unroll
            for (int i = 0; i < 2; ++i) off[h][i] = (unsigned)((u.a * 256 + h * 128 + R[i]) * lda + C[i]) * 2u;
    }
    __device__ __forceinline__ const char* bbase(const Unit& u) const { return (const char*)(Bt + (size_t)u.b * 256 * ldb); }
};
struct PolBf16 : PolDenseBase {
    static constexpr bool PERM = true;
    bf16_t* O; int ldc; const float* bias;
    __device__ __forceinline__ void epi(const f32x4 (&acc)[2][2][4][2], const Unit& u, int wr, int wc, int fr, int fq) const {
        store_bf16_tile<false>(acc, O, ldc, u.a * 256, u.b * 256, bias, u.b * 256, wr, wc, fr, fq);
    }
};
template <bool XIN_BF16>
struct PolResid : PolDenseBase {
    static constexpr bool PERM = true;
    const void* xin; const float* g; bf16_t* xout;
    __device__ __forceinline__ void epi(const f32x4 (&acc)[2][2][4][2], const Unit& u, int wr, int wc, int fr, int fq) const {
        const int row0 = u.a * 256 + wr * 64 + fr, col0 = u.b * 256 + wc * 32 + 8 * fq;
        f32x4 gv[2][2];
#pragma unroll
        for (int bj = 0; bj < 2; ++bj)
#pragma unroll
            for (int n = 0; n < 2; ++n) gv[bj][n] = *(const f32x4*)(g + col0 + bj * 128 + n * 4);
#pragma unroll
        for (int ai = 0; ai < 2; ++ai)
#pragma unroll
            for (int mp = 0; mp < 2; ++mp) {
                f32x4 xi[2][2][2];
                if (XIN_BF16) {
                    u32x4 xw[2][2];
#pragma unroll
                    for (int mm = 0; mm < 2; ++mm) { const size_t ro = (size_t)(row0 + ai * 128 + (mp * 2 + mm) * 16) * D + col0;
#pragma unroll
                        for (int bj = 0; bj < 2; ++bj) xw[mm][bj] = *(const u32x4*)((const bf16_t*)xin + ro + bj * 128); }
                    __builtin_amdgcn_sched_barrier(0);
#pragma unroll
                    for (int mm = 0; mm < 2; ++mm)
#pragma unroll
                        for (int bj = 0; bj < 2; ++bj) { xi[mm][bj][0] = (f32x4){bflo(xw[mm][bj].x), bfhi(xw[mm][bj].x), bflo(xw[mm][bj].y), bfhi(xw[mm][bj].y)};
                            xi[mm][bj][1] = (f32x4){bflo(xw[mm][bj].z), bfhi(xw[mm][bj].z), bflo(xw[mm][bj].w), bfhi(xw[mm][bj].w)}; }
                } else {
#pragma unroll
                    for (int mm = 0; mm < 2; ++mm) { const size_t ro = (size_t)(row0 + ai * 128 + (mp * 2 + mm) * 16) * D + col0;
#pragma unroll
                        for (int bj = 0; bj < 2; ++bj)
#pragma unroll
                            for (int n = 0; n < 2; ++n) xi[mm][bj][n] = *(const f32x4*)((const float*)xin + ro + bj * 128 + n * 4); }
                    __builtin_amdgcn_sched_barrier(0);
                }
#pragma unroll
                for (int mm = 0; mm < 2; ++mm) { const size_t ro = (size_t)(row0 + ai * 128 + (mp * 2 + mm) * 16) * D + col0;
#pragma unroll
                    for (int bj = 0; bj < 2; ++bj) { const f32x4 v0 = xi[mm][bj][0] + gv[bj][0] * acc[ai][bj][mp * 2 + mm][0], v1 = xi[mm][bj][1] + gv[bj][1] * acc[ai][bj][mp * 2 + mm][1];
                        u32x4 w; w.x = cvt_pk_bf16(v0[0], v0[1]); w.y = cvt_pk_bf16(v0[2], v0[3]); w.z = cvt_pk_bf16(v1[0], v1[1]); w.w = cvt_pk_bf16(v1[2], v1[3]);
                        *(u32x4*)(xout + ro + bj * 128) = w; } }
                __builtin_amdgcn_sched_barrier(0);
            }
    }
};
struct PolRouter {
    static constexpr bool PERM = false;
    const bf16_t* A; const bf16_t* Bt; float* part; int K, ldb;
    __device__ __forceinline__ int nunits() const { return 64 * 4; }
    __device__ __forceinline__ int first() const { return blockIdx.x; }
    __device__ __forceinline__ int stride() const { return gridDim.x; }
    __device__ __forceinline__ void unit(int L, Unit& u) const { u.a = L >> 2; u.b = L & 3; u.c = 0; u.d = 0; }
    __device__ __forceinline__ const char* abase() const { return (const char*)A; }
    __device__ __forceinline__ void a_off(const Unit& u, const int (&R)[2], const int (&C)[2], unsigned (&off)[2][2]) const {
#pragma unroll
        for (int h = 0; h < 2; ++h)
#pragma unroll
            for (int i = 0; i < 2; ++i) off[h][i] = (unsigned)((u.a * 256 + h * 128 + R[i]) * 2048 + u.b * 512 + C[i]) * 2u;
    }
    __device__ __forceinline__ const char* bbase(const Unit& u) const { return (const char*)(Bt + (size_t)u.b * 512); }
    __device__ __forceinline__ void epi(const f32x4 (&acc)[2][2][4][2], const Unit& u, int wr, int wc, int fr, int fq) const {
        const int row0 = u.a * 256 + wr * 64 + fr, col0 = wc * 32 + 4 * fq;
        float* P = part + (size_t)u.b * T * 128;
#pragma unroll
        for (int ai = 0; ai < 2; ++ai)
#pragma unroll
            for (int m = 0; m < 4; ++m)
#pragma unroll
                for (int n = 0; n < 2; ++n) *(f32x4*)(P + (size_t)(row0 + ai * 128 + m * 16) * 128 + col0 + n * 16) = acc[ai][0][m][n];
    }
};
struct MoeTab { const LAS int* blk_e; const LAS int* blk_row0; int rb0, nrb, rank, nrank; };
__device__ __forceinline__ void moe_decode(const MoeTab& tb, int j, int NT, Unit& u) {
    const int rbl = j / NT, pn = j - rbl * NT, rb = tb.rb0 + rbl;
    u.a = tb.blk_row0[rb]; u.b = pn; u.c = tb.blk_e[rb]; u.d = 0;
}
struct PolGateUp {
    static constexpr bool PERM = true;
    const bf16_t* A; const bf16_t* W; const int* rowtok; bf16_t* act; MoeTab tb; int K, ldb; const LAS int* ridx;
    __device__ __forceinline__ int nunits() const { return tb.nrb * 2; }
    __device__ __forceinline__ int first() const { return tb.rank; }
    __device__ __forceinline__ int stride() const { return tb.nrank; }
    __device__ __forceinline__ void unit(int L, Unit& u) const { moe_decode(tb, L, 2, u); u.d = (L - tb.rank) / tb.nrank; }
    __device__ __forceinline__ const char* abase() const { return (const char*)A; }
    __device__ __forceinline__ void a_off(const Unit& u, const int (&R)[2], const int (&C)[2], unsigned (&off)[2][2]) const {
#pragma unroll
        for (int h = 0; h < 2; ++h)
#pragma unroll
            for (int i = 0; i < 2; ++i) { const int tok = (u.d < 8) ? ridx[u.d * 256 + h * 128 + R[i]] : rowtok[u.a + h * 128 + R[i]]; off[h][i] = (unsigned)(tok * 2048 + C[i]) * 2u; }
    }
    __device__ __forceinline__ const char* bbase(const Unit& u) const { return (const char*)(W + ((size_t)u.c * 512 + (size_t)u.b * 256) * 2048); }
    __device__ __forceinline__ void epi(const f32x4 (&acc)[2][2][4][2], const Unit& u, int wr, int wc, int fr, int fq) const {
        const int r0 = u.a + wr * 64 + fr, c0 = u.b * 128 + wc * 32 + 8 * fq;
#pragma unroll
        for (int ai = 0; ai < 2; ++ai)
#pragma unroll
            for (int m = 0; m < 4; ++m) {
                float o[8];
#pragma unroll
                for (int n = 0; n < 2; ++n)
#pragma unroll
                    for (int e = 0; e < 4; ++e) { const float gt = acc[ai][0][m][n][e], up = acc[ai][1][m][n][e]; o[n * 4 + e] = gt * __builtin_amdgcn_rcpf(1.0f + __expf(-gt)) * up; }
                u32x4 w; w.x = cvt_pk_bf16(o[0], o[1]); w.y = cvt_pk_bf16(o[2], o[3]); w.z = cvt_pk_bf16(o[4], o[5]); w.w = cvt_pk_bf16(o[6], o[7]);
                *(u32x4*)(act + (size_t)(r0 + ai * 128 + m * 16) * 256 + c0) = w; }
    }
};
constexpr float Y_SCALE = 8.0f;
struct PolDown {
    static constexpr bool PERM = true;
    const bf16_t* A; const bf16_t* W; unsigned char* Y; MoeTab tb; int K, ldb; int nostore;
    __device__ __forceinline__ int nunits() const { return tb.nrb * 8; }
    __device__ __forceinline__ int first() const { return tb.rank; }
    __device__ __forceinline__ int stride() const { return tb.nrank; }
    __device__ __forceinline__ void unit(int L, Unit& u) const { moe_decode(tb, L, 8, u); }
    __device__ __forceinline__ const char* abase() const { return (const char*)A; }
    __device__ __forceinline__ void a_off(const Unit& u, const int (&R)[2], const int (&C)[2], unsigned (&off)[2][2]) const {
#pragma unroll
        for (int h = 0; h < 2; ++h)
#pragma unroll
            for (int i = 0; i < 2; ++i) off[h][i] = (unsigned)((u.a + h * 128 + R[i]) * 256 + C[i]) * 2u;
    }
    __device__ __forceinline__ const char* bbase(const Unit& u) const { return (const char*)(W + ((size_t)u.c * 2048 + (size_t)u.b * 256) * 256); }
    __device__ __forceinline__ void epi(const f32x4 (&acc)[2][2][4][2], const Unit& u, int wr, int wc, int fr, int fq) const {
        const int odd = fq & 1, pq = fq >> 1;
#pragma unroll
        for (int ai = 0; ai < 2; ++ai)
#pragma unroll
            for (int bj = 0; bj < 2; ++bj) {
                int D[4][2];
#pragma unroll
                for (int m = 0; m < 4; ++m)
#pragma unroll
                    for (int n = 0; n < 2; ++n) { const f32x4 v = acc[ai][bj][m][n] * Y_SCALE; int w_ = __builtin_amdgcn_cvt_pk_fp8_f32(v[0], v[1], 0, false); D[m][n] = __builtin_amdgcn_cvt_pk_fp8_f32(v[2], v[3], w_, true); }
#pragma unroll
                for (int pr = 0; pr < 2; ++pr) {
                    const int s0 = odd ? D[2 * pr][0] : D[2 * pr + 1][0], s1 = odd ? D[2 * pr][1] : D[2 * pr + 1][1];
                    const int r0 = __shfl_xor(s0, 16), r1 = __shfl_xor(s1, 16);
                    u32x4 w;
                    if (odd) { w.x = (unsigned)r0; w.y = (unsigned)r1; w.z = (unsigned)D[2 * pr + 1][0]; w.w = (unsigned)D[2 * pr + 1][1]; }
                    else { w.x = (unsigned)D[2 * pr][0]; w.y = (unsigned)D[2 * pr][1]; w.z = (unsigned)r0; w.w = (unsigned)r1; }
                    const int row = u.a + ai * 128 + wr * 64 + (2 * pr + odd) * 16 + fr, col = u.b * 256 + bj * 128 + wc * 32 + pq * 16;
                    if (!nostore) { if (NT_STORES) __builtin_nontemporal_store(w, (u32x4*)(Y + (size_t)row * 2048 + col)); else *(u32x4*)(Y + (size_t)row * 2048 + col) = w; } else asm volatile("" :: "v"(w));
                }
            }
    }
};


__device__ __forceinline__ void ph_route(const Frame& F, int layer) {
    const float* part = WSP(float, WS_LOGP); const float* rbias = F.in[18] + layer * 64;
    int* tki = WSP(int, WS_TKI); float* tkw = WSP(float, WS_TKW); int* hist = WSP(int, WS_HIST);
    LAS int* lh = (LAS int*)F.aux;
    const int lane = F.lane; const int g = lane >> 3;
    const float bia = rbias[lane];
    for (int tb = F.bid; tb < 256; tb += F.G) {
        if (F.tid < 64) lh[F.tid] = 0;
        __syncthreads();
        float pv[8][8];
#pragma unroll
        for (int ti = 0; ti < 8; ++ti) { const int t = tb * 64 + F.wid * 8 + ti;
#pragma unroll
            for (int ks = 0; ks < 4; ++ks) { const float* pr = part + ((size_t)ks * T + t) * 128; pv[ti][2 * ks] = pr[lane]; pv[ti][2 * ks + 1] = pr[64 + lane]; } }
#pragma unroll
        for (int ti = 0; ti < 8; ++ti) {
            const int t = tb * 64 + F.wid * 8 + ti;
            float logit = 0.f;
#pragma unroll
            for (int ks = 0; ks < 4; ++ks) logit += pv[ti][2 * ks] + pv[ti][2 * ks + 1];
            const float score = 1.0f / (1.0f + expf(-logit));
            const float biased = score + bia;
            const float m1 = grp8_max(biased);
            const unsigned long long eqm = __ballot(biased == m1);
            const unsigned long long gm = eqm & (0xFFull << (8 * g));
            const int first = __builtin_ctzll(gm);
            const float v2 = grp8_max((lane == first) ? -__builtin_inff() : biased);
            const float gs = m1 + v2;
            int cnt = 0;
#pragma unroll
            for (int gg = 0; gg < 8; ++gg) { const float o = __int_as_float(__builtin_amdgcn_readlane(__float_as_int(gs), 8 * gg)); cnt += ((o > gs) || (o == gs && gg < g)) ? 1 : 0; }
            const bool sel = cnt < 4;
            const float masked = sel ? biased : -__builtin_inff();
            int rank = 0;
#pragma unroll
            for (int l = 0; l < 64; ++l) { const float o = __int_as_float(__builtin_amdgcn_readlane(__float_as_int(masked), l)); rank += ((o > masked) || (o == masked && l < lane)) ? 1 : 0; }
            const bool chosen = sel && rank < 8;
            const float wsum = wave_sum(chosen ? score : 0.f);
            if (chosen) { tki[t * 8 + rank] = lane; tkw[t * 8 + rank] = score / wsum * 2.5f; (void)__hip_atomic_fetch_add(lh + lane, 1, __ATOMIC_RELAXED, __HIP_MEMORY_SCOPE_WORKGROUP); }
        }
        __syncthreads();
        if (F.tid < 64) hist[tb * 64 + F.tid] = lh[F.tid];
        __syncthreads();
    }
}

__device__ __forceinline__ void ph_dispatch(const Frame& F) {
    const int* hist = WSP(int, WS_HIST); const int* tki = WSP(int, WS_TKI);
    int* pslot = WSP(int, WS_PSLOT); int* rowtok = WSP(int, WS_ROWTOK); int* etab = WSP(int, WS_ETAB);
    LAS int* tot = (LAS int*)F.aux; LAS int* pre = tot + 64; LAS int* eoff = tot + 128; LAS int* cursor = tot + 192;
    LAS int* ps = tot + 256;
    LAS int* wc = tot + 1280;
    for (int tb = F.bid; tb < 256; tb += F.G) {
        __syncthreads();
        {
            const int e = F.tid & 63, gq = F.tid >> 6;
            int hv[32];
#pragma unroll
            for (int b = 0; b < 32; ++b) hv[b] = hist[(gq * 32 + b) * 64 + e];
            int s_ = 0, p_ = 0;
#pragma unroll
            for (int b = 0; b < 32; ++b) { s_ += hv[b]; p_ += (gq * 32 + b < tb) ? hv[b] : 0; }
            ps[gq * 64 + e] = s_; ps[512 + gq * 64 + e] = p_; wc[F.tid] = 0;
        }
        __syncthreads();
        if (F.tid < 64) { int s_ = 0, p_ = 0;
#pragma unroll
            for (int q = 0; q < 8; ++q) { s_ += ps[q * 64 + F.tid]; p_ += ps[512 + q * 64 + F.tid]; }
            tot[F.tid] = s_; pre[F.tid] = p_;
            const int pad = (s_ + 255) & ~255; const int off = T + wave_incl_scan(pad, F.tid) - pad;
            eoff[F.tid] = off; cursor[F.tid] = off + p_;
            if (tb == 0) { etab[F.tid] = off; etab[64 + F.tid] = s_; } }
        { const int t = tb * 64 + (F.tid >> 3), k = F.tid & 7; const int e = tki[t * 8 + k];
          int rnk = 0;
#pragma unroll 8
          for (int l = 0; l < 64; ++l) { const int o = __builtin_amdgcn_readlane(e, l); rnk += (o == e && l < F.lane) ? 1 : 0; }
          (void)__hip_atomic_fetch_add(wc + F.wid * 64 + e, 1, __ATOMIC_RELAXED, __HIP_MEMORY_SCOPE_WORKGROUP);
          __syncthreads();
          for (int w = 0; w < F.wid; ++w) rnk += wc[w * 64 + e];
          const int slot = cursor[e] + rnk; rowtok[slot] = t; pslot[t * 8 + k] = slot; }
        if (F.tid < 64) rowtok[tb * 64 + F.tid] = tb * 64 + F.tid;
        if (tb < 64) { const int e = tb; const int beg = eoff[e] + tot[e], end = eoff[e] + ((tot[e] + 255) & ~255); for (int s = beg + F.tid; s < end; s += NTHREADS) rowtok[s] = 0; }
        __syncthreads();
    }
}

__device__ __forceinline__ MoeTab moe_tables(const Frame& F) {
    const int* etab = WSP(int, WS_ETAB);
    LAS int* blk_e = (LAS int*)F.aux; LAS int* blk_row0 = blk_e + 640; LAS int* pre = blk_e + 1280;
    __syncthreads();
    if (F.tid < 64) { blk_e[F.tid] = 64; blk_row0[F.tid] = F.tid * 256; }
    if (F.tid < 64) { const int nb_ = (etab[64 + F.tid] + 255) >> 8, inc = wave_incl_scan(nb_, F.tid); pre[F.tid] = inc - nb_; if (F.tid == 63) pre[64] = inc; }
    __syncthreads();
    if (F.tid < 64) { const int e = F.tid, nb = (etab[64 + e] + 255) >> 8, b0 = 64 + pre[e], r0 = etab[e]; for (int i = 0; i < nb; ++i) { blk_e[b0 + i] = e; blk_row0[b0 + i] = r0 + i * 256; } }
    __syncthreads();
    const int nblk = 64 + pre[64];
    const int ng = ((F.G & 7) == 0) ? 8 : 1, x = F.bid % ng;
    MoeTab tb; tb.blk_e = blk_e; tb.blk_row0 = blk_row0;
    tb.rb0 = (int)(((long)nblk * x) / ng); tb.nrb = (int)(((long)nblk * (x + 1)) / ng) - tb.rb0; tb.rank = F.bid / ng; tb.nrank = F.G / ng;
    return tb;
}

#define SBAR() __builtin_amdgcn_sched_barrier(0)
__device__ __forceinline__ int v_st(int k, int c) { const int kk = (k & ~0xC) | ((k & 4) << 1) | ((k & 8) >> 1); return ((kk >> 3) * 4 + (c >> 5)) * 512 + ((kk & 7) * 32 + (c & 31)) * 2; }
__device__ __forceinline__ int v_rd_base(int lane) { return ((lane & 3) << 3) | (((lane >> 2) & 3) << 6) | (((lane >> 4) & 1) << 5) | (((lane >> 5) & 1) << 8); }
constexpr int v_rd_off(int d0, int ks, int half) { return d0 * 512 + ks * 4096 + half * 2048; }
__device__ __forceinline__ int crow(int r, int hi) { return (r & 3) + 8 * (r >> 2) + 4 * hi; }
template <int OFF> __device__ __forceinline__ s16x4 trrd(int base) { s16x4 d; asm volatile("ds_read_b64_tr_b16 %0, %1 offset:%2" : "=&v"(d) : "v"(base), "i"(OFF) : "memory"); return d; }
#define LGKM0() asm volatile("s_waitcnt lgkmcnt(0)" ::: "memory")
#define ROPE2(W0, W1, CS, O0, O1) do { const float a0 = bflo(W0), a1 = bfhi(W0), b0_ = bflo(W1), b1_ = bfhi(W1); \
    O0 = cvt_pk_bf16(a0 * CS[0] - b0_ * CS[1], a1 * CS[2] - b1_ * CS[3]); O1 = cvt_pk_bf16(b0_ * CS[0] + a0 * CS[1], b1_ * CS[2] + a1 * CS[3]); } while (0)
__device__ __forceinline__ bf16x8 cat44(s16x4 l, s16x4 h) { return (bf16x8){l[0], l[1], l[2], l[3], h[0], h[1], h[2], h[3]}; }

__device__ __forceinline__ void mask_tile(f32x16& p0, f32x16& p1, int dq, unsigned W) {
    const float NEG = -__builtin_inff();
#pragma unroll
    for (int r = 0; r < 16; ++r) {
        const int c = (r & 3) + 8 * (r >> 2);
        if ((unsigned)(dq - c) >= W) p0[r] = NEG;
        if ((unsigned)(dq - c - 32) >= W) p1[r] = NEG;
    }
}
__device__ __forceinline__ float softmax_tile(f32x16& p0, f32x16& p1, float& m_reg, float& l_reg, float C2, bf16x8& pa0, bf16x8& pa1, bf16x8& pa2, bf16x8& pa3) {
    float pmax = p0[0];
#pragma unroll
    for (int r = 1; r < 16; ++r) pmax = fmaxf(pmax, p0[r]);
#pragma unroll
    for (int r = 0; r < 16; ++r) pmax = fmaxf(pmax, p1[r]);
    { auto rr = __builtin_amdgcn_permlane32_swap(__float_as_uint(pmax), __float_as_uint(pmax), false, false);
      pmax = fmaxf(__uint_as_float(rr[0]), __uint_as_float(rr[1])); }
    float mn, alpha;
    if (__all((pmax - m_reg) * C2 <= 11.5f)) { mn = m_reg; alpha = 1.f; }
    else { mn = fmaxf(m_reg, pmax); alpha = __builtin_amdgcn_exp2f((m_reg - mn) * C2); m_reg = mn; }
    const float mnL = -mn * C2;
    float ps = 0.f;
#pragma unroll
    for (int r = 0; r < 16; ++r) { p0[r] = __builtin_amdgcn_exp2f(fmaf(p0[r], C2, mnL)); ps += p0[r]; }
#pragma unroll
    for (int r = 0; r < 16; ++r) { p1[r] = __builtin_amdgcn_exp2f(fmaf(p1[r], C2, mnL)); ps += p1[r]; }
    { auto rr = __builtin_amdgcn_permlane32_swap(__float_as_uint(ps), __float_as_uint(ps), false, false);
      ps = __uint_as_float(rr[0]) + __uint_as_float(rr[1]); }
    l_reg = l_reg * alpha + ps;
#define PK4(P, B_, OUT) do { unsigned a0 = cvt_pk_bf16(P[B_+0], P[B_+1]), a1 = cvt_pk_bf16(P[B_+2], P[B_+3]);                          \
        unsigned b0 = cvt_pk_bf16(P[B_+4], P[B_+5]), b1 = cvt_pk_bf16(P[B_+6], P[B_+7]);                                             \
        auto r0 = __builtin_amdgcn_permlane32_swap(a0, b0, false, false); auto r1 = __builtin_amdgcn_permlane32_swap(a1, b1, false, false); \
        u32x4 w = {r0[0], r1[0], r0[1], r1[1]}; OUT = *reinterpret_cast<bf16x8*>(&w); } while (0)
    PK4(p0, 0, pa0); PK4(p0, 8, pa1); PK4(p1, 0, pa2); PK4(p1, 8, pa3);
    return alpha;
}
template <int VOFF, int ND0, int KG = 2048>
__device__ __forceinline__ void pv_tile(f32x16* o, int vb, bf16x8 pa0, bf16x8 pa1, bf16x8 pa2, bf16x8 pa3) {
#define PV_D0(d0) do { s16x4 l0, l1, l2, l3, h0, h1, h2, h3; constexpr int b_ = VOFF + d0 * 512; \
        l0 = trrd<b_>(vb); h0 = trrd<b_ + KG>(vb); l1 = trrd<b_ + 2 * KG>(vb); h1 = trrd<b_ + 3 * KG>(vb); l2 = trrd<b_ + 4 * KG>(vb); h2 = trrd<b_ + 5 * KG>(vb); l3 = trrd<b_ + 6 * KG>(vb); h3 = trrd<b_ + 7 * KG>(vb); \
        LGKM0(); SBAR(); \
        o[d0] = __builtin_amdgcn_mfma_f32_32x32x16_bf16(pa0, cat44(l0, h0), o[d0], 0, 0, 0); \
        o[d0] = __builtin_amdgcn_mfma_f32_32x32x16_bf16(pa1, cat44(l1, h1), o[d0], 0, 0, 0); \
        o[d0] = __builtin_amdgcn_mfma_f32_32x32x16_bf16(pa2, cat44(l2, h2), o[d0], 0, 0, 0); \
        o[d0] = __builtin_amdgcn_mfma_f32_32x32x16_bf16(pa3, cat44(l3, h3), o[d0], 0, 0, 0); } while (0)
    PV_D0(0); PV_D0(1);
    if (ND0 > 2) { PV_D0(2); PV_D0(3); }
#undef PV_D0
}

template <int DQK, int DV, int D2>
struct AttnBlk {
    static constexpr int RB = DQK * 2, KBYTES = 64 * RB, VBYTES = 16384, KOFF = 0, VOFF = 2 * KBYTES, SOFF = VOFF + 3 * VBYTES;
    static constexpr int NC = DQK / 16, ND0 = DV / 32, KPIECES = 64 * DQK / 8, KPT = KPIECES / NTHREADS, VPIECES = 64 * DV / 8, VPT = (VPIECES + NTHREADS - 1) / NTHREADS, PPR = DQK / 8, VPR = DV / 8;
    const bf16_t* Q; int ldq; const bf16_t* K1; int ldk1; const bf16_t* K2; int ldk2; const bf16_t* V; int ldv; bf16_t* O; int ldo;
    float C2; float m_init; float l_init; unsigned W;
    int wrow; int wq; int wo; const float* sinks; float sink_scale; const float2* ropeq;

    struct StageOffs { unsigned ko[KPT]; unsigned vo[1]; };
    __device__ __forceinline__ void stage_setup(StageOffs& so_, int tid) const {
#pragma unroll
        for (int i = 0; i < KPT; ++i) { const int p = tid + NTHREADS * i, row = p / PPR, sp = p - row * PPR;
            const int pc = (sp & ~7) | ((sp ^ (row >> 1)) & 7);
            const bool k1 = (D2 == 0 || pc < (DQK - D2) / 8);
            so_.ko[i] = k1 ? (unsigned)(row * ldk1 + pc * 8) * 2u : ((unsigned)(row * ldk2 + (pc - (DQK - D2) / 8) * 8) * 2u) | 0x80000000u; }
        { const int p = tid;
            const int off = p * 16, sub = off >> 9, g8 = sub >> 2, cblk = sub & 3, rem = (off & 511) >> 1, kkl = rem >> 5, cl = rem & 31;
            const int kk = g8 * 8 + kkl, k = (kk & ~0xC) | ((kk & 4) << 1) | ((kk & 8) >> 1), c = cblk * 32 + cl;
            so_.vo[0] = (unsigned)(k * ldv + c) * 2u; }
    }
    __device__ __forceinline__ void stage_tile(LAS unsigned char* lds, int kbuf, int vbuf, int kb, const StageOffs& so_, int tid, int wid) const {
        const char* kb1 = (const char*)(K1 + (size_t)kb * ldk1); const char* kb2 = (const char*)(K2 + (size_t)kb * ldk2); const char* vbp = (const char*)(V + (size_t)kb * ldv);
#pragma unroll
        for (int i = 0; i < KPT; ++i) {
            const unsigned o_ = so_.ko[i]; LAS unsigned* dst_ = (LAS unsigned*)(lds + KOFF + kbuf * KBYTES + (NTHREADS * i + 64 * wid) * 16);
            if (D2 == 0 || !(o_ >> 31)) __builtin_amdgcn_global_load_lds((const unsigned*)(kb1 + o_), dst_, 16, 0, 0);
            else __builtin_amdgcn_global_load_lds((const unsigned*)(kb2 + (o_ & 0x7fffffffu)), dst_, 16, 0, 0); }
#pragma unroll
        for (int i = 0; i < VPT; ++i) { const int p = tid + NTHREADS * i;
            if (VPIECES >= NTHREADS * (i + 1) || p < VPIECES)
                __builtin_amdgcn_global_load_lds((const unsigned*)(vbp + (size_t)i * 32 * ldv * 2 + so_.vo[0]), (LAS unsigned*)(lds + VOFF + vbuf * VBYTES + (NTHREADS * i + 64 * wid) * 16), 16, 0, 0); }
    }
    __device__ __forceinline__ void run(LAS unsigned char* lds, int P0, int j_lo, int j_hi) const {
        const int tid = threadIdx.x, wid = __builtin_amdgcn_readfirstlane(tid >> 6), lane = tid & 63, r32 = lane & 31, hi = lane >> 5;
        const int qlo = P0 + wid * 32, qm = qlo + r32 - 4 * hi;
        const bool grpB = ATT_STAGGER && wid >= 4;
        LAS float* ws = (LAS float*)(lds + SOFF) + wid * 64; LAS float* li_l = ws; LAS float* al_l = ws + 32;
        bf16x8 qr[NC];
#pragma unroll
        for (int c = 0; c < NC; ++c) qr[c] = *(const bf16x8*)(Q + (size_t)(qlo + r32) * ldq + c * 16 + hi * 8);
        if (NC == 12 && ropeq) {
            const float2* rp = ropeq + (size_t)(qlo + r32) * 32 + hi * 8;
#pragma unroll
            for (int cc = 0; cc < 2; ++cc) {
                const f32x4* cs = (const f32x4*)(rp + cc * 16);
                const f32x4 c0 = cs[0], c1 = cs[1], c2 = cs[2], c3 = cs[3];
                const u32x4 a = __builtin_bit_cast(u32x4, qr[(NC == 12 ? 8 : 0) + cc]), b = __builtin_bit_cast(u32x4, qr[(NC == 12 ? 10 : 0) + cc]);
                u32x4 ra, rb_;
                ROPE2(a.x, b.x, c0, ra.x, rb_.x); ROPE2(a.y, b.y, c1, ra.y, rb_.y); ROPE2(a.z, b.z, c2, ra.z, rb_.z); ROPE2(a.w, b.w, c3, ra.w, rb_.w);
                qr[(NC == 12 ? 8 : 0) + cc] = __builtin_bit_cast(bf16x8, ra); qr[(NC == 12 ? 10 : 0) + cc] = __builtin_bit_cast(bf16x8, rb_);
            }
        }
        float m_reg = m_init, l_reg = l_init; f32x16 o[ND0];
#pragma unroll
        for (int d = 0; d < ND0; ++d) o[d] = f32x16{};
        const int vb0 = (int)(uintptr_t)(lds + VOFF) + v_rd_base(lane);
        const LAS unsigned char* kb4[4];
#pragma unroll
        for (int cl = 0; cl < 4; ++cl) kb4[cl] = lds + KOFF + r32 * RB + ((cl * 32 + hi * 16) ^ (((r32 >> 1) & 7) << 4));
        f32x16 p0, p1; bf16x8 pa0, pa1, pa2, pa3; float alpha = 1.f;
#define ATT_QK(kbuf_) do { \
            _Pragma("unroll") for (int g = 0; g < NC / 4; ++g) { bf16x8 b0[4], b1[4]; \
                _Pragma("unroll") for (int cl = 0; cl < 4; ++cl) { b0[cl] = *(const LAS bf16x8*)(kb4[cl] + (kbuf_) * KBYTES + g * 128); b1[cl] = *(const LAS bf16x8*)(kb4[cl] + (kbuf_) * KBYTES + g * 128 + 32 * RB); } \
                SBAR(); \
                _Pragma("unroll") for (int cl = 0; cl < 4; ++cl) { \
                    if (g == 0 && cl == 0) { p0 = __builtin_amdgcn_mfma_f32_32x32x16_bf16(b0[cl], qr[0], (f32x16){0.f,0.f,0.f,0.f,0.f,0.f,0.f,0.f,0.f,0.f,0.f,0.f,0.f,0.f,0.f,0.f}, 0, 0, 0); \
                                             p1 = __builtin_amdgcn_mfma_f32_32x32x16_bf16(b1[cl], qr[0], (f32x16){0.f,0.f,0.f,0.f,0.f,0.f,0.f,0.f,0.f,0.f,0.f,0.f,0.f,0.f,0.f,0.f}, 0, 0, 0); } \
                    else { p0 = __builtin_amdgcn_mfma_f32_32x32x16_bf16(b0[cl], qr[g * 4 + cl], p0, 0, 0, 0); \
                           p1 = __builtin_amdgcn_mfma_f32_32x32x16_bf16(b1[cl], qr[g * 4 + cl], p1, 0, 0, 0); } } \
                SBAR(); } } while (0)
#define ATT_SM(kb_) do { if ((kb_) + 63 > qlo || (kb_) + (int)W <= qlo + 31) mask_tile(p0, p1, qm - (kb_), W); \
            alpha = softmax_tile(p0, p1, m_reg, l_reg, C2, pa0, pa1, pa2, pa3); } while (0)
#define ATT_PV(vbuf_) do { if (__any(alpha < 1.f)) { if (hi == 0) al_l[r32] = alpha; LGKM0(); \
                _Pragma("unroll") for (int d = 0; d < ND0; ++d) _Pragma("unroll") for (int r = 0; r < 16; ++r) o[d][r] *= al_l[crow(r, hi)]; } \
            if ((vbuf_) == 0) pv_tile<0, ND0>(o, vb0, pa0, pa1, pa2, pa3); else if ((vbuf_) == 1) pv_tile<VBYTES, ND0>(o, vb0, pa0, pa1, pa2, pa3); else pv_tile<2 * VBYTES, ND0>(o, vb0, pa0, pa1, pa2, pa3); } while (0)
        __syncthreads();
        StageOffs SO; stage_setup(SO, tid);
        stage_tile(lds, 0, 0, j_lo * 64, SO, tid, wid);
        asm volatile("s_waitcnt vmcnt(0)" ::: "memory");
        __syncthreads();
        const int NT = j_hi - j_lo;
#if ATT_STAGGER
        {
        int vcur = 0;
        for (int t = 0; t < NT; ++t) {
            const int kbuf = t & 1, kb = (j_lo + t) * 64;
            const int vnext = (vcur == 2) ? 0 : vcur + 1;
            if (t + 1 < NT) stage_tile(lds, kbuf ^ 1, vnext, kb + 64, SO, tid, wid);
            ATT_QK(kbuf); ATT_SM(kb);
            if (grpB) { asm volatile("s_waitcnt vmcnt(0)" ::: "memory"); __syncthreads(); }
            ATT_PV(vcur);
            if (!grpB) { asm volatile("s_waitcnt vmcnt(0)" ::: "memory"); __syncthreads(); }
            vcur = vnext;
        } }
#else
        for (int t = 0; t < NT; ++t) {
            const int kbuf = t & 1, kb = (j_lo + t) * 64;
            if (t + 1 < NT) stage_tile(lds, kbuf ^ 1, kbuf ^ 1, kb + 64, SO, tid, wid);
            ATT_QK(kbuf); ATT_SM(kb);
            if (__any(alpha < 1.f)) { if (hi == 0) al_l[r32] = alpha; LGKM0();
#pragma unroll
                for (int d = 0; d < ND0; ++d)
#pragma unroll
                    for (int r = 0; r < 16; ++r) o[d][r] *= al_l[crow(r, hi)]; }
            if (kbuf == 0) pv_tile<0, ND0>(o, vb0, pa0, pa1, pa2, pa3); else pv_tile<VBYTES, ND0>(o, vb0, pa0, pa1, pa2, pa3);
            asm volatile("s_waitcnt vmcnt(0)" ::: "memory");
            __syncthreads();
        }
#endif
#undef ATT_QK
#undef ATT_SM
#undef ATT_PV
        if (hi == 0) li_l[r32] = l_reg; LGKM0();
        int hi_o = hi, r32_o = r32; asm volatile("" : "+v"(hi_o), "+v"(r32_o));
        bf16_t* Ow = O + (size_t)qlo * ldo;
#pragma unroll
        for (int r = 0; r < 16; ++r) { const int orow = crow(r, hi_o); const float rl = 1.0f / li_l[orow];
#pragma unroll
            for (int d = 0; d < ND0; ++d) { const float v = o[d][r] * rl; const float vn = __shfl_xor(v, 1);
                if ((r32_o & 1) == 0) *(unsigned*)(Ow + (size_t)orow * ldo + d * 32 + r32_o) = cvt_pk_bf16(v, vn); } }
    }
};

__device__ __forceinline__ int v_st64(int k, int c) { const int kk = (k & ~0xC) | ((k & 4) << 1) | ((k & 8) >> 1); return ((kk >> 3) * 2 + (c >> 5)) * 512 + ((kk & 7) * 32 + (c & 31)) * 2; }
__device__ __forceinline__ void ph_swa(const Frame& F) {
    const bf16_t* qkv = WSP(bf16_t, WS_PROJ); bf16_t* hcat = WSP(bf16_t, WS_HCAT); const float* sinks = F.in[15];
    LAS unsigned char* lds = F.lds;
    constexpr int KT = 8192, VT = 8192, VBASE = 6 * KT, SCR = VBASE + 6 * VT;
    const int tid = F.tid, wid = F.wid, lane = F.lane, r32 = lane & 31, hi = lane >> 5;
    const float C2 = 0.125f * 1.4426950408889634f;
    LAS float* ws = (LAS float*)(lds + SCR) + wid * 64; LAS float* li_l = ws; LAS float* al_l = ws + 32;
    const LAS unsigned char* kb4[4];
#pragma unroll
    for (int cl = 0; cl < 4; ++cl) kb4[cl] = lds + r32 * 128 + ((cl * 32 + hi * 16) ^ (((r32 >> 1) & 7) << 4));
    const int vbase = (int)(uintptr_t)(lds + VBASE) + v_rd_base(lane);
    for (int U = F.bid; U < 256; U += F.G) {
        const int hkv = U & 3, P0 = (U >> 2) * 256;
        const int tile0 = (P0 >> 6) - 2 < 0 ? 0 : (P0 >> 6) - 2, ntl = (P0 >> 6) + 4 - tile0;
        __syncthreads();
        { int tq = tid; asm volatile("" : "+v"(tq));
          const float2* rope = WSP(float2, WS_ROPE);
#pragma unroll
          for (int i = 0; i < 3; ++i) { const int q = tq + NTHREADS * i, key = q >> 2, pc = q & 3;
              if (key < ntl * 64) { const int tl = key >> 6, row = key & 63; const int kabs = tile0 * 64 + key; const size_t g = (size_t)kabs * 2560;
                  const u32x4 k0 = *(const u32x4*)(qkv + g + 2048 + 64 * hkv + pc * 8), k1 = *(const u32x4*)(qkv + g + 2048 + 64 * hkv + 32 + pc * 8);
                  const u32x4 v0 = *(const u32x4*)(qkv + g + 2304 + 64 * hkv + pc * 8), v1 = *(const u32x4*)(qkv + g + 2304 + 64 * hkv + 32 + pc * 8);
                  const f32x4 c0 = *(const f32x4*)(rope + (size_t)kabs * 32 + pc * 8), c1 = *(const f32x4*)(rope + (size_t)kabs * 32 + pc * 8 + 2), c2 = *(const f32x4*)(rope + (size_t)kabs * 32 + pc * 8 + 4), c3 = *(const f32x4*)(rope + (size_t)kabs * 32 + pc * 8 + 6);
                  u32x4 r0, r1;
                  ROPE2(k0.x, k1.x, c0, r0.x, r1.x); ROPE2(k0.y, k1.y, c1, r0.y, r1.y); ROPE2(k0.z, k1.z, c2, r0.z, r1.z); ROPE2(k0.w, k1.w, c3, r0.w, r1.w);
                  *(LAS u32x4*)(lds + tl * KT + row * 128 + ((pc * 16) ^ (((row >> 1) & 7) << 4))) = r0;
                  *(LAS u32x4*)(lds + tl * KT + row * 128 + (((pc + 4) * 16) ^ (((row >> 1) & 7) << 4))) = r1;
                  *(LAS u32x4*)(lds + VBASE + tl * VT + v_st64(row, pc * 8)) = v0;
                  *(LAS u32x4*)(lds + VBASE + tl * VT + v_st64(row, 32 + pc * 8)) = v1; } } }
        __syncthreads();
        const int hq = hkv * 8 + wid;
        const float m0 = sinks[hq] * 8.0f;
        const float2* rope = WSP(float2, WS_ROPE);
        u32x4 qn[4]; f32x4 cn[2][4];
#define SWA_LDQ(rb_) do { const int ql_ = P0 + 32 * (rb_); \
            _Pragma("unroll") for (int c = 0; c < 4; ++c) qn[c] = *(const u32x4*)(qkv + (size_t)(ql_ + r32) * 2560 + 64 * hq + c * 16 + hi * 8); \
            _Pragma("unroll") for (int c = 0; c < 2; ++c) { const f32x4* cs = (const f32x4*)(rope + (size_t)(ql_ + r32) * 32 + 16 * c + 8 * hi); cn[c][0] = cs[0]; cn[c][1] = cs[1]; cn[c][2] = cs[2]; cn[c][3] = cs[3]; } } while (0)
        SWA_LDQ(0);
        for (int rb = 0; rb < 8; ++rb) {
            const int qlo = P0 + 32 * rb, qm = qlo + r32 - 4 * hi;
            bf16x8 qr[4];
            {
#pragma unroll
              for (int c = 0; c < 2; ++c) { const u32x4 a = qn[c], b = qn[c + 2]; u32x4 ra, rb_;
                  ROPE2(a.x, b.x, cn[c][0], ra.x, rb_.x); ROPE2(a.y, b.y, cn[c][1], ra.y, rb_.y); ROPE2(a.z, b.z, cn[c][2], ra.z, rb_.z); ROPE2(a.w, b.w, cn[c][3], ra.w, rb_.w);
                  qr[c] = *reinterpret_cast<bf16x8*>(&ra); qr[c + 2] = *reinterpret_cast<bf16x8*>(&rb_); } }
            __builtin_amdgcn_sched_barrier(0);
            if (rb + 1 < 8) SWA_LDQ(rb + 1);
            __builtin_amdgcn_sched_barrier(0);
            float m_reg = m0, l_reg = 1.f; f32x16 o[2] = {f32x16{}, f32x16{}};
            const int tlo = (qlo - 127 < 0) ? 0 : (qlo - 127) >> 6, thi = (qlo + 31) >> 6;
            for (int tile = tlo; tile <= thi; ++tile) {
                const int lt = tile - tile0, kb = tile * 64;
                f32x16 p0 = f32x16{}, p1 = f32x16{};
                { bf16x8 b0[4], b1[4];
#pragma unroll
                  for (int cl = 0; cl < 4; ++cl) { b0[cl] = *(const LAS bf16x8*)(kb4[cl] + lt * KT); b1[cl] = *(const LAS bf16x8*)(kb4[cl] + lt * KT + 32 * 128); }
#pragma unroll
                  for (int cl = 0; cl < 4; ++cl) { p0 = __builtin_amdgcn_mfma_f32_32x32x16_bf16(b0[cl], qr[cl], p0, 0, 0, 0); p1 = __builtin_amdgcn_mfma_f32_32x32x16_bf16(b1[cl], qr[cl], p1, 0, 0, 0); } }
                mask_tile(p0, p1, qm - kb, 128u);
                bf16x8 pa0, pa1, pa2, pa3;
                const float alpha = softmax_tile(p0, p1, m_reg, l_reg, C2, pa0, pa1, pa2, pa3);
                if (__any(alpha < 1.f)) { if (hi == 0) al_l[r32] = alpha; LGKM0();
#pragma unroll
                    for (int d = 0; d < 2; ++d)
#pragma unroll
                        for (int r = 0; r < 16; ++r) o[d][r] *= al_l[crow(r, hi)]; }
                pv_tile<0, 2, 1024>(o, vbase + lt * VT, pa0, pa1, pa2, pa3);
            }
            if (hi == 0) li_l[r32] = l_reg; LGKM0();
            int hi_o = hi, r32_o = r32; asm volatile("" : "+v"(hi_o), "+v"(r32_o));
            bf16_t* Ow = hcat + (size_t)qlo * 2048 + 64 * hq;
#pragma unroll
            for (int r = 0; r < 16; ++r) { const int orow = crow(r, hi_o); const float rl = 1.0f / li_l[orow];
#pragma unroll
                for (int d = 0; d < 2; ++d) { const float v = o[d][r] * rl; const float vn = __shfl_xor(v, 1);
                    if ((r32_o & 1) == 0) *(unsigned*)(Ow + (size_t)orow * 2048 + d * 32 + r32_o) = cvt_pk_bf16(v, vn); } }
        }
    }
    __syncthreads();
}

__device__ __forceinline__ void ph_mla_prep(const Frame& F) {
    const bf16_t* proj = WSP(bf16_t, WS_PROJ); const float* qn = F.in[8]; const float* kvn = F.in[9];
    bf16_t* cqn = WSP(bf16_t, WS_CQN); bf16_t* ckvn = WSP(bf16_t, WS_CKVN); bf16_t* kpe = WSP(bf16_t, WS_KPE); const float2* rope = WSP(float2, WS_ROPE);
    const int lane = F.lane;
    const int tstep = F.G * 8;
    for (int t0 = F.bid * 8 + F.wid; t0 < T; t0 += 2 * tstep) {
        u32x2 wq[2][3], wk[2][2]; bf16_t k1[2], k2[2]; float2 cs[2]; bool ok[2];
#pragma unroll
        for (int q = 0; q < 2; ++q) { const int t = t0 + q * tstep; ok[q] = t < T; const int tc = ok[q] ? t : t0; const bf16_t* pr = proj + (size_t)tc * IN_PAD;
#pragma unroll
            for (int j = 0; j < 3; ++j) wq[q][j] = *(const u32x2*)(pr + OFF_CQ + 4 * lane + 256 * j);
#pragma unroll
            for (int j = 0; j < 2; ++j) wk[q][j] = *(const u32x2*)(pr + OFF_CKV + 4 * lane + 256 * j);
            k1[q] = pr[OFF_KR + (lane & 31)]; k2[q] = pr[OFF_KR + 32 + (lane & 31)]; cs[q] = rope[tc * 32 + (lane & 31)]; }
        f32x4 gq[3], gk[2];
#pragma unroll
        for (int j = 0; j < 3; ++j) gq[j] = *(const f32x4*)(qn + 4 * lane + 256 * j);
#pragma unroll
        for (int j = 0; j < 2; ++j) gk[j] = *(const f32x4*)(kvn + 4 * lane + 256 * j);
#pragma unroll
        for (int q = 0; q < 2; ++q) { const int t = t0 + q * tstep; if (!ok[q]) break;
            { float v[3][4]; float ss = 0.f;
#pragma unroll
              for (int j = 0; j < 3; ++j) { const u32x2 w = wq[q][j]; v[j][0] = bflo(w.x); v[j][1] = bfhi(w.x); v[j][2] = bflo(w.y); v[j][3] = bfhi(w.y);
                  ss += v[j][0] * v[j][0] + v[j][1] * v[j][1] + v[j][2] * v[j][2] + v[j][3] * v[j][3]; }
              ss = wave_sum(ss); const float rstd = rsqrtf(ss * (1.0f / 768.0f) + EPS);
#pragma unroll
              for (int j = 0; j < 3; ++j) { const int col = 4 * lane + 256 * j; const f32x4 g = gq[j];
                  u32x2 o; o.x = cvt_pk_bf16(v[j][0] * rstd * g[0], v[j][1] * rstd * g[1]); o.y = cvt_pk_bf16(v[j][2] * rstd * g[2], v[j][3] * rstd * g[3]);
                  *(u32x2*)(cqn + (size_t)t * 768 + col) = o; } }
            { float v[2][4]; float ss = 0.f;
#pragma unroll
              for (int j = 0; j < 2; ++j) { const u32x2 w = wk[q][j]; v[j][0] = bflo(w.x); v[j][1] = bfhi(w.x); v[j][2] = bflo(w.y); v[j][3] = bfhi(w.y);
                  ss += v[j][0] * v[j][0] + v[j][1] * v[j][1] + v[j][2] * v[j][2] + v[j][3] * v[j][3]; }
              ss = wave_sum(ss); const float rstd = rsqrtf(ss * (1.0f / 512.0f) + EPS);
#pragma unroll
              for (int j = 0; j < 2; ++j) { const int col = 4 * lane + 256 * j; const f32x4 g = gk[j];
                  u32x2 o; o.x = cvt_pk_bf16(v[j][0] * rstd * g[0], v[j][1] * rstd * g[1]); o.y = cvt_pk_bf16(v[j][2] * rstd * g[2], v[j][3] * rstd * g[3]);
                  *(u32x2*)(ckvn + (size_t)t * 512 + col) = o; } }
            if (lane < 32) { const float x1 = bf2f(k1[q]), x2 = bf2f(k2[q]);
                kpe[(size_t)t * 64 + lane] = f2bf(x1 * cs[q].x - x2 * cs[q].y); kpe[(size_t)t * 64 + 32 + lane] = f2bf(x2 * cs[q].x + x1 * cs[q].y); }
        }
    }
}

__device__ __forceinline__ void ph_gates(const Frame& F) {
    const bf16_t* proj = WSP(bf16_t, WS_PROJ); const float* bif = F.in[6];
    float* GA = WSP(float, WS_GA); float* GB = WSP(float, WS_GB); float* GCM = WSP(float, WS_GCM); float* GST = WSP(float, WS_GST);
    const int lane = F.lane;
    for (int u = F.bid * 8 + F.wid; u < NCH * 4; u += F.G * 8) {
        const int c = u >> 2, h = u & 3, t = c * 64 + lane;
        const float ipre = bf2f(proj[(size_t)t * IN_PAD + OFF_MI + h]) + bif[h], fpre = bf2f(proj[(size_t)t * IN_PAD + OFF_MF + h]) + bif[4 + h];
        const float ig = 15.0f * tanhf(ipre * (1.0f / 15.0f)); const float z = 15.0f * tanhf(fpre * (1.0f / 15.0f));
        const float lf = (z >= 0.f) ? -log1pf(expf(-z)) : z - log1pf(expf(z));
        float b = lf;
#pragma unroll
        for (int o = 1; o < 64; o <<= 1) { const float v = __shfl_up(b, o); if (lane >= o) b += v; }
        const float a = ig - b;
        float cm = a;
#pragma unroll
        for (int o = 1; o < 64; o <<= 1) { const float v = __shfl_up(cm, o); if (lane >= o) cm = fmaxf(cm, v); }
        GA[h * T + t] = a; GB[h * T + t] = b; GCM[h * T + t] = cm;
        if (lane == 63) { GST[h * 256 + c] = cm; GST[1024 + h * 256 + c] = b; }
    }
}

__device__ __forceinline__ void m_scan(const Frame& F, LAS float* mst) {
    float* GST = WSP(float, WS_GST);
    LAS float* tmp = mst + 4 * 257 + 3;
    __syncthreads();
    for (int i = F.tid; i < 2048; i += NTHREADS) tmp[i] = GST[i];
    __syncthreads();
    if (F.tid < 4) { const int h = F.tid; float m = 0.f; mst[h * 257] = 0.f;
        for (int c = 0; c < 256; ++c) { m = tmp[1024 + h * 256 + c] + fmaxf(m, tmp[h * 256 + c]); mst[h * 257 + c + 1] = m; } }
    __syncthreads();
    if (F.bid == 0) for (int i = F.tid; i < 4 * 257; i += NTHREADS) GST[2048 + i] = mst[i];
}

__device__ __forceinline__ void ph_rope_q(const Frame& F) {
    const float2* rope = WSP(float2, WS_ROPE); bf16_t* qraw = WSP(bf16_t, WS_QRAW);
    for (int idx = F.bid * NTHREADS + F.tid; idx < T * 32; idx += F.G * NTHREADS) {
        const int t = idx >> 5, hh = (idx >> 2) & 7, pc = idx & 3;
        bf16_t* p = qraw + (size_t)t * 1536 + hh * 192 + 128 + pc * 8;
        const u32x4 a = *(const u32x4*)p, b = *(const u32x4*)(p + 32);
        const f32x4* cs = (const f32x4*)(rope + (size_t)t * 32 + pc * 8);
        const f32x4 c0 = cs[0], c1 = cs[1], c2 = cs[2], c3 = cs[3];
        u32x4 ra, rb_;
        ROPE2(a.x, b.x, c0, ra.x, rb_.x); ROPE2(a.y, b.y, c1, ra.y, rb_.y); ROPE2(a.z, b.z, c2, ra.z, rb_.z); ROPE2(a.w, b.w, c3, ra.w, rb_.w);
        *(u32x4*)p = ra; *(u32x4*)(p + 32) = rb_;
    }
}

#define TRF(dst, base, TOFF, d0, ks) do { const s16x4 l_ = trrd<(TOFF) + v_rd_off(d0, ks, 0)>(base); const s16x4 h_ = trrd<(TOFF) + v_rd_off(d0, ks, 1)>(base); LGKM0(); dst = cat44(l_, h_); } while (0)
__device__ __forceinline__ void ph_mlstm_B(const Frame& F, const LAS float* mst) {
    const bf16_t* proj = WSP(bf16_t, WS_PROJ); const float* GA = WSP(float, WS_GA); const float* GST = WSP(float, WS_GST);
    bf16_t* dC = WSP(bf16_t, WS_DC); float* DN = WSP(float, WS_DN);
    LAS unsigned char* lds = F.lds;
    const int tid = F.tid, lane = F.lane, w = F.wid, r32 = lane & 31, hi = lane >> 5;
    const int lbase = (int)(uintptr_t)lds + v_rd_base(lane);
    for (int u = F.bid; u < NCH * 4; u += F.G) {
        const int c = u >> 2, h = u & 3, t0 = c * 64;
        const float mx = fmaxf(mst[h * 257 + c], GST[h * 256 + c]);
        __syncthreads();
#pragma unroll
        for (int i = 0; i < 2; ++i) { const int q = tid + NTHREADS * i, s = q >> 4, dc = (q & 15) * 8;
            const u32x4 raw = *(const u32x4*)(proj + (size_t)(t0 + s) * IN_PAD + OFF_MK + h * 128 + dc);
            const float wsc = expf(GA[h * T + t0 + s] - mx) * 0.08838834764831845f;
            u32x4 o; o.x = cvt_pk_bf16(bflo(raw.x) * wsc, bfhi(raw.x) * wsc); o.y = cvt_pk_bf16(bflo(raw.y) * wsc, bfhi(raw.y) * wsc);
            o.z = cvt_pk_bf16(bflo(raw.z) * wsc, bfhi(raw.z) * wsc); o.w = cvt_pk_bf16(bflo(raw.w) * wsc, bfhi(raw.w) * wsc);
            *(LAS u32x4*)(lds + v_st(s, dc)) = o; }
#pragma unroll
        for (int i = 0; i < 4; ++i) { const int q = tid + NTHREADS * i, s = q >> 5, vc = (q & 31) * 8;
            const u32x4 raw = *(const u32x4*)(proj + (size_t)(t0 + s) * IN_PAD + OFF_MV + h * 256 + vc);
            *(LAS u32x4*)(lds + 16384 + (vc >> 7) * 16384 + v_st(s, vc & 127)) = raw; }
        __syncthreads();
        bf16x8 Bf[4];
        {
            const int vb = lbase + 16384 + (w >> 2) * 16384 + (w & 3) * 512;
            TRF(Bf[0], vb, 0, 0, 0); TRF(Bf[1], vb, 0, 0, 1); TRF(Bf[2], vb, 0, 0, 2); TRF(Bf[3], vb, 0, 0, 3);
        }
        f32x16 acc[4];
#define MB_STEP(mb) do { bf16x8 a0, a1, a2, a3; TRF(a0, lbase, 0, mb, 0); TRF(a1, lbase, 0, mb, 1); TRF(a2, lbase, 0, mb, 2); TRF(a3, lbase, 0, mb, 3); \
        f32x16 z = f32x16{}; z = __builtin_amdgcn_mfma_f32_32x32x16_bf16(a0, Bf[0], z, 0, 0, 0); z = __builtin_amdgcn_mfma_f32_32x32x16_bf16(a1, Bf[1], z, 0, 0, 0); \
        z = __builtin_amdgcn_mfma_f32_32x32x16_bf16(a2, Bf[2], z, 0, 0, 0); z = __builtin_amdgcn_mfma_f32_32x32x16_bf16(a3, Bf[3], z, 0, 0, 0); acc[mb] = z; } while (0)
        MB_STEP(0); MB_STEP(1); MB_STEP(2); MB_STEP(3);
#undef MB_STEP
        bf16_t* outp = dC + ((size_t)u * 256 + w * 32 + r32) * 128;
#pragma unroll
        for (int mb = 0; mb < 4; ++mb)
#pragma unroll
            for (int rq = 0; rq < 4; ++rq) { u32x2 o; o.x = cvt_pk_bf16(acc[mb][4 * rq + 0], acc[mb][4 * rq + 1]); o.y = cvt_pk_bf16(acc[mb][4 * rq + 2], acc[mb][4 * rq + 3]);
                *(u32x2*)(outp + mb * 32 + 8 * rq + 4 * hi) = o; }
        if (tid < 128) { float s_ = 0.f; const int d = tid;
            for (int s = 0; s < 64; ++s) s_ += bf2f(*(const LAS bf16_t*)(lds + v_st(s, d & ~7) + (d & 7) * 2));
            DN[(size_t)u * 128 + d] = s_; }
    }
    __syncthreads();
}

__device__ __forceinline__ void mlstm_C_item(const Frame& F, int item) {
    const float* GST = WSP(float, WS_GST);
    const bf16_t* dC = WSP(bf16_t, WS_DC); bf16_t* Cst = WSP(bf16_t, WS_CST); const float* DN = WSP(float, WS_DN); float* NST = WSP(float, WS_NST);
    LAS float* dec = (LAS float*)F.aux;
    __syncthreads();
    for (int i = F.tid; i < 1024; i += NTHREADS) { const int h = i >> 8, c = i & 255; const float m = GST[2048 + h * 257 + c]; dec[i] = expf(m - fmaxf(m, GST[h * 256 + c])); }
    __syncthreads();
    if (item < 64) {
        const int it = item * 512 + F.tid;
        const int h = it >> 13, rem = it & 8191;
        const size_t off0 = (size_t)h * 256 * 128 + (size_t)rem * 4;
        float s0 = 0.f, s1 = 0.f, s2 = 0.f, s3 = 0.f;
        u32x2 buf[16];
#pragma unroll
        for (int j = 0; j < 16; ++j) buf[j] = __builtin_nontemporal_load((const u32x2*)(dC + (size_t)j * 131072 + off0));
        for (int cb = 0; cb < 256; cb += 16) {
            u32x2 nb[16];
            if (cb + 16 < 256) {
#pragma unroll
                for (int j = 0; j < 16; ++j) nb[j] = __builtin_nontemporal_load((const u32x2*)(dC + (size_t)(cb + 16 + j) * 131072 + off0));
            }
#pragma unroll
            for (int j = 0; j < 16; ++j) {
                const unsigned long long o = (unsigned long long)cvt_pk_bf16(s0, s1) | ((unsigned long long)cvt_pk_bf16(s2, s3) << 32);
                __hip_atomic_store((unsigned long long*)(Cst + (size_t)(cb + j) * 131072 + off0), o, __ATOMIC_RELAXED, __HIP_MEMORY_SCOPE_AGENT);
                const float d = dec[h * 256 + cb + j];
                s0 = d * s0 + bflo(buf[j].x); s1 = d * s1 + bfhi(buf[j].x); s2 = d * s2 + bflo(buf[j].y); s3 = d * s3 + bfhi(buf[j].y);
            }
            if (cb + 16 < 256) {
#pragma unroll
                for (int j = 0; j < 16; ++j) buf[j] = nb[j];
            }
        }
    } else {
        const int it = F.tid; const int h = it >> 7;
        float s = 0.f;
#pragma unroll 16
        for (int c = 0; c < 256; ++c) { __hip_atomic_store((unsigned*)&NST[(size_t)c * 512 + it], __float_as_uint(s), __ATOMIC_RELAXED, __HIP_MEMORY_SCOPE_AGENT); s = dec[h * 256 + c] * s + DN[(size_t)c * 512 + it]; }
    }
}

__device__ __forceinline__ void ph_mlstm_D(const Frame& F) {
    const bf16_t* proj = WSP(bf16_t, WS_PROJ); const float* GA = WSP(float, WS_GA); const float* GB = WSP(float, WS_GB); const float* GCM = WSP(float, WS_GCM);
    const float* GST = WSP(float, WS_GST); const bf16_t* Cst = WSP(bf16_t, WS_CST); const float* NST = WSP(float, WS_NST);
    const float* gain = F.in[7]; bf16_t* hcat = WSP(bf16_t, WS_HCAT);
    const int tid = F.tid, lane = F.lane, r32 = lane & 31, hi = lane >> 5;
    const int hb = F.wid >> 2, wl = F.wid & 3, rh = wl & 1, vh = wl >> 1, htid = tid & 255;
    LAS unsigned char* hl = F.lds + hb * 40960;
    LAS float* a_l = (LAS float*)(hl + 32768); LAS float* n_l = (LAS float*)(hl + 33024); LAS float* rowss = (LAS float*)(hl + 33536);
    LAS float* scr = (LAS float*)(hl + 34048 + wl * 256);
    for (int pi = F.bid; pi < NCH * 2; pi += F.G) {
        const int u = pi * 2 + hb, c = u >> 2, h = u & 3, t0 = c * 64;
        __syncthreads();
        { u32x4 raw[8];
#pragma unroll
          for (int i = 0; i < 8; ++i) { const int q = htid + 256 * i, s = q >> 5, vc = (q & 31) * 8;
              raw[i] = *(const u32x4*)(proj + (size_t)(t0 + s) * IN_PAD + OFF_MV + h * 256 + vc); }
          SBAR();
#pragma unroll
          for (int i = 0; i < 8; ++i) { const int q = htid + 256 * i, s = q >> 5, vc = (q & 31) * 8;
              *(LAS u32x4*)(hl + (vc >> 7) * 16384 + v_st(s, vc & 127)) = raw[i]; } }
        if (htid < 64) a_l[htid] = GA[h * T + t0 + htid];
        if (htid < 128) n_l[htid] = NST[(size_t)u * 128 + htid];
        __syncthreads();
        const int j = 32 * rh + r32, t = t0 + j;
        const float m_c = GST[2048 + h * 257 + c];
        const float M_j = fmaxf(m_c, GCM[h * T + t]), b_j = GB[h * T + t];
        bf16x8 qr[8];
#pragma unroll
        for (int cc = 0; cc < 8; ++cc) qr[cc] = *(const bf16x8*)(proj + (size_t)t * IN_PAD + OFF_MQ + h * 128 + cc * 16 + hi * 8);
        f32x16 p0 = f32x16{}, p1 = f32x16{};
#pragma unroll
        for (int cc = 0; cc < 8; ++cc) {
            const bf16x8 k0 = *(const bf16x8*)(proj + (size_t)(t0 + r32) * IN_PAD + OFF_MK + h * 128 + cc * 16 + hi * 8);
            const bf16x8 k1 = *(const bf16x8*)(proj + (size_t)(t0 + 32 + r32) * IN_PAD + OFF_MK + h * 128 + cc * 16 + hi * 8);
            p0 = __builtin_amdgcn_mfma_f32_32x32x16_bf16(k0, qr[cc], p0, 0, 0, 0);
            p1 = __builtin_amdgcn_mfma_f32_32x32x16_bf16(k1, qr[cc], p1, 0, 0, 0);
        }
        float dsum = 0.f;
#pragma unroll
        for (int r = 0; r < 16; ++r) {
            const int s0 = crow(r, hi), s1 = 32 + s0;
            const float e0 = __expf(fminf(a_l[s0] - M_j, 0.f)) * 0.08838834764831845f, e1 = __expf(fminf(a_l[s1] - M_j, 0.f)) * 0.08838834764831845f;
            const float w0 = (s0 <= j) ? e0 : 0.f, w1 = (s1 <= j) ? e1 : 0.f;
            p0[r] *= w0; p1[r] *= w1; dsum += p0[r] + p1[r];
        }
        { auto rr = __builtin_amdgcn_permlane32_swap(__float_as_uint(dsum), __float_as_uint(dsum), false, false); dsum = __uint_as_float(rr[0]) + __uint_as_float(rr[1]); }
        bf16x8 pa0, pa1, pa2, pa3;
        PK4(p0, 0, pa0); PK4(p0, 8, pa1); PK4(p1, 0, pa2); PK4(p1, 8, pa3);
        f32x16 o[4];
#pragma unroll
        for (int d = 0; d < 4; ++d) o[d] = f32x16{};
        const int vb0 = (int)(uintptr_t)(hl + vh * 16384) + v_rd_base(lane);
        pv_tile<0, 4>(o, vb0, pa0, pa1, pa2, pa3);
        const float w_inter = expf(m_c - M_j);
        float qn = 0.f;
        bf16x8 qs[8];
#pragma unroll
        for (int cc = 0; cc < 8; ++cc) {
            const u32x4 w = *reinterpret_cast<const u32x4*>(&qr[cc]);
            const float q0 = bflo(w.x), q1 = bfhi(w.x), q2 = bflo(w.y), q3 = bfhi(w.y), q4 = bflo(w.z), q5 = bfhi(w.z), q6 = bflo(w.w), q7 = bfhi(w.w);
            const LAS float* np = n_l + cc * 16 + hi * 8;
            qn += q0 * np[0] + q1 * np[1] + q2 * np[2] + q3 * np[3] + q4 * np[4] + q5 * np[5] + q6 * np[6] + q7 * np[7];
            u32x4 o_; o_.x = cvt_pk_bf16(q0 * w_inter, q1 * w_inter); o_.y = cvt_pk_bf16(q2 * w_inter, q3 * w_inter); o_.z = cvt_pk_bf16(q4 * w_inter, q5 * w_inter); o_.w = cvt_pk_bf16(q6 * w_inter, q7 * w_inter);
            qs[cc] = *reinterpret_cast<bf16x8*>(&o_);
        }
        { auto rr = __builtin_amdgcn_permlane32_swap(__float_as_uint(qn), __float_as_uint(qn), false, false); qn = __uint_as_float(rr[0]) + __uint_as_float(rr[1]); }
        {
            const bf16_t* cp = Cst + ((size_t)u * 256 + 128 * vh + r32) * 128 + hi * 8;
            bf16x8 cfa[8], cfb[8];
#pragma unroll
            for (int cc = 0; cc < 8; ++cc) cfa[cc] = *(const bf16x8*)(cp + cc * 16);
#pragma unroll
            for (int cc = 0; cc < 8; ++cc) cfb[cc] = *(const bf16x8*)(cp + (size_t)32 * 128 + cc * 16);
            SBAR();
#pragma unroll
            for (int cc = 0; cc < 8; ++cc) o[0] = __builtin_amdgcn_mfma_f32_32x32x16_bf16(qs[cc], cfa[cc], o[0], 0, 0, 0);
            SBAR();
#pragma unroll
            for (int cc = 0; cc < 8; ++cc) cfa[cc] = *(const bf16x8*)(cp + (size_t)64 * 128 + cc * 16);
            SBAR();
#pragma unroll
            for (int cc = 0; cc < 8; ++cc) o[1] = __builtin_amdgcn_mfma_f32_32x32x16_bf16(qs[cc], cfb[cc], o[1], 0, 0, 0);
            SBAR();
#pragma unroll
            for (int cc = 0; cc < 8; ++cc) cfb[cc] = *(const bf16x8*)(cp + (size_t)96 * 128 + cc * 16);
            SBAR();
#pragma unroll
            for (int cc = 0; cc < 8; ++cc) o[2] = __builtin_amdgcn_mfma_f32_32x32x16_bf16(qs[cc], cfa[cc], o[2], 0, 0, 0);
            SBAR();
#pragma unroll
            for (int cc = 0; cc < 8; ++cc) o[3] = __builtin_amdgcn_mfma_f32_32x32x16_bf16(qs[cc], cfb[cc], o[3], 0, 0, 0);
        }
        const float den = dsum + w_inter * qn;
        const float inv = 1.0f / fmaxf(fabsf(den), expf(-(b_j + M_j)));
        if (hi == 0) scr[r32] = inv;
        LGKM0();
        float ss[16];
#pragma unroll
        for (int r = 0; r < 16; ++r) { const float iv = scr[crow(r, hi)]; float a = 0.f;
#pragma unroll
            for (int d = 0; d < 4; ++d) { o[d][r] *= iv; a += o[d][r] * o[d][r]; }
            a += __shfl_xor(a, 1); a += __shfl_xor(a, 2); a += __shfl_xor(a, 4); a += __shfl_xor(a, 8); a += __shfl_xor(a, 16);
            ss[r] = a; }
        if (r32 == 0) {
#pragma unroll
            for (int r = 0; r < 16; ++r) rowss[vh * 64 + 32 * rh + crow(r, hi)] = ss[r]; }
        __syncthreads();
#pragma unroll
        for (int r = 0; r < 16; ++r) { const int jr = 32 * rh + crow(r, hi);
#pragma unroll
            for (int d = 0; d < 4; ++d) *(LAS bf16_t*)(hl + jr * 512 + (128 * vh + 32 * d + r32) * 2) = f2bf(o[d][r]); }
        __syncthreads();
        { u32x4 ov[8], mv[8];
#pragma unroll
          for (int i = 0; i < 8; ++i) { const int q = htid + 256 * i, row = q >> 5, c8 = (q & 31) * 8;
              ov[i] = *(const LAS u32x4*)(hl + row * 512 + c8 * 2);
              mv[i] = *(const u32x4*)(proj + (size_t)(t0 + row) * IN_PAD + OFF_MO + h * 256 + c8); }
#pragma unroll
          for (int i = 0; i < 8; ++i) { const int q = htid + 256 * i, row = q >> 5, c8 = (q & 31) * 8;
              const float rstd = rsqrtf((rowss[row] + rowss[64 + row]) * (1.0f / 256.0f) + EPS);
              const f32x4 g0 = *(const f32x4*)(gain + h * 256 + c8), g1 = *(const f32x4*)(gain + h * 256 + c8 + 4);
              float v[8];
#pragma unroll
              for (int e = 0; e < 4; ++e) { const unsigned ow = ov[i][e], mw = mv[i][e];
                  v[2 * e] = bflo(ow) * rstd * ((e < 2) ? g0[2 * e] : g1[2 * e - 4]) / (1.0f + __expf(-bflo(mw)));
                  v[2 * e + 1] = bfhi(ow) * rstd * ((e < 2) ? g0[2 * e + 1] : g1[2 * e - 3]) / (1.0f + __expf(-bfhi(mw))); }
              u32x4 w; w.x = cvt_pk_bf16(v[0], v[1]); w.y = cvt_pk_bf16(v[2], v[3]); w.z = cvt_pk_bf16(v[4], v[5]); w.w = cvt_pk_bf16(v[6], v[7]);
              *(u32x4*)(hcat + (size_t)(t0 + row) * 2048 + h * 256 + c8) = w; } }
    }
    __syncthreads();
}

constexpr int NPHASE = 26;
__device__ __forceinline__ void moe_phase_router(const Frame& F, int layer) {
    PolRouter p; p.A = WSP(bf16_t, WS_H2); p.Bt = WSP(bf16_t, WS_WR) + (size_t)layer * 256 * 2048; p.part = WSP(float, WS_LOGP); p.K = 512; p.ldb = 2048;
    pg8::gemm_phase(F.lds, p);
}
__device__ __forceinline__ void moe_phase_gateup(const Frame& F, int layer) {
    PolGateUp p; p.A = WSP(bf16_t, WS_H2); p.W = WSP(bf16_t, WS_WGU) + (size_t)layer * 65 * 512 * 2048; p.rowtok = WSP(int, WS_ROWTOK); p.act = WSP(bf16_t, WS_ACT);
    p.tb = moe_tables(F); p.K = 2048; p.ldb = 2048;
    {
        LAS int* ridx = (LAS int*)(F.aux + 6144);
        for (int idx = F.tid; idx < 8 * 256; idx += NTHREADS) { const int i = idx >> 8, r = idx & 255, L = p.tb.rank + i * p.tb.nrank;
            if (L < p.tb.nrb * 2) ridx[idx] = p.rowtok[p.tb.blk_row0[p.tb.rb0 + (L >> 1)] + r]; }
        __syncthreads();
        p.ridx = ridx; }
    pg8::gemm_phase(F.lds, p);
}
__device__ __forceinline__ void moe_phase_down(const Frame& F, int layer, int nostore = 0) {
    PolDown p; p.nostore = nostore; p.A = WSP(bf16_t, WS_ACT); p.W = WSP(bf16_t, WS_WDN) + (size_t)layer * 65 * 2048 * 256; p.Y = WSP(unsigned char, WS_Y);
    p.tb = moe_tables(F); p.K = 256; p.ldb = 256;
    pg8::gemm_phase(F.lds, p);
}

__global__ void __launch_bounds__(NTHREADS, 2) mk_fwd(Args args) {
    extern __shared__ __attribute__((aligned(16))) unsigned char lds_raw[];
    Frame F;
    F.lds = (LAS unsigned char*)lds_raw; F.aux = F.lds + LDS_MAIN;
    F.in = args.in; F.out = args.out; F.ws = args.ws;
    F.tid = threadIdx.x; F.lane = F.tid & 63; F.wid = __builtin_amdgcn_readfirstlane(F.tid >> 6); F.G = gridDim.x; F.bid = blockIdx.x;
    volatile LAS unsigned* xbw = (volatile LAS unsigned*)(F.lds + LDS_MAIN + LDS_AUX);
    if (F.tid < 4) xbw[F.tid] = 0u;
    __syncthreads();
    const int lo = args.ph_lo, hi = args.ph_hi;
    XcdBarrier bar; bar.bar = WSP(unsigned, WS_ZERO + ZB_BAR); bar.x = 0; bar.st = xbw;
    if (hi - lo > 1) bar = xcd_barrier_post(WSP(unsigned, WS_ZERO + ZB_BAR), xbw);
#ifdef PH_ONLY
#define IN(k) ((k) == PH_ONLY)
#else
#define IN(k) (lo <= (k) && (k) < hi)
#endif
#define SEAM(k) do { if (IN(k) && IN((k) + 1)) xcd_barrier(bar); { int t_ = threadIdx.x; asm volatile("" : "+v"(t_)); F.tid = t_; F.lane = t_ & 63; F.wid = __builtin_amdgcn_readfirstlane(t_ >> 6); } } while (0)
    const float* mod = WSP(float, WS_ZERO + ZB_MOD);
    const float* mod0 = mod; const float* mod1 = mod + 12288;

    if (IN(0)) { PRB(0) { ph_adaln(F); ph_rope_table(F); ph_convert(F); } } SEAM(0);
#if PROBE_EXTRA_BARRIERS
    if (hi - lo > 1) { for (int xb = 0; xb < 16; ++xb) xcd_barrier(bar); }
#endif
    if (IN(1)) { PRB(15) ph_modulate<0>(F, F.in[0], mod0 + 0, mod0 + 2048, WSP(bf16_t, WS_HA)); } SEAM(1);
    if (IN(2)) { PRB(5) { PolBf16 p{{WSP(bf16_t, WS_HA), WSP(bf16_t, WS_WIN), 2048, 2048, 2048, 64, IN_PAD / 256}, WSP(bf16_t, WS_PROJ), IN_PAD, nullptr}; pg8::gemm_phase(F.lds, p); } } SEAM(2);
    if (IN(3)) { PRB(14) { ph_mla_prep(F); ph_gates(F); } } SEAM(3);
    if (IN(4)) {
        LAS float* mst = (LAS float*)F.aux;
        m_scan(F, mst);
        { PolBf16 p{{WSP(bf16_t, WS_CQN), WSP(bf16_t, WS_WUQ), 768, 768, 768, 64, 6}, WSP(bf16_t, WS_QRAW), 1536, nullptr}; pg8::gemm_phase(F.lds, p); }
        { PolBf16 p{{WSP(bf16_t, WS_CKVN), WSP(bf16_t, WS_WUKV), 512, 512, 512, 64, 8}, WSP(bf16_t, WS_KVRAW), 2048, nullptr}; pg8::gemm_phase(F.lds, p); }
        PRB(12) ph_mlstm_B(F, mst);
    } SEAM(4);
    if (IN(6)) {
        {
            unsigned* cctr = WSP(unsigned, WS_ZERO + ZB_CTR + 256); unsigned* cdone = WSP(unsigned, WS_ZERO + ZB_CTR + 384);
            for (;;) { const int c = grab(F, cctr); if (c >= 65) break;
                mlstm_C_item(F, c);
                asm volatile("s_waitcnt vmcnt(0)" ::: "memory"); __syncthreads();
                if (F.tid == 0) (void)__hip_atomic_fetch_add(cdone, 1u, __ATOMIC_RELAXED, __HIP_MEMORY_SCOPE_AGENT); }
        }
        AttnBlk<192, 128, 64> A;
        A.ldq = 1536; A.ldk1 = 2048; A.K2 = WSP(bf16_t, WS_KPE); A.ldk2 = 64; A.ldv = 2048; A.ldo = 2048;
        A.C2 = 0.07216878364870323f * 1.4426950408889634f; A.m_init = -1e30f; A.l_init = 0.f; A.W = 1u << 30; A.wrow = 32; A.wq = 0; A.wo = 0; A.sinks = nullptr; A.sink_scale = 0.f; A.ropeq = WSP(float2, WS_ROPE);
        const bool cvt_first = F.bid < MCV_BLOCKS;
        if (cvt_first) moe_cvt_queue(F);
        unsigned* actr = WSP(unsigned, WS_ZERO + ZB_CTR + 128);
        for (;;) {
            const int u = grab(F, actr); if (u >= 512) break;
            const int h = u & 7, qb = 63 - (u >> 3);
            A.Q = WSP(bf16_t, WS_QRAW) + 192 * h; A.K1 = WSP(bf16_t, WS_KVRAW) + 256 * h; A.V = WSP(bf16_t, WS_KVRAW) + 256 * h + 128; A.O = WSP(bf16_t, WS_HCAT) + 1024 + 128 * h;
            A.run(F.lds, qb * 256, 0, qb * 4 + 4);
        }
        if (!cvt_first) moe_cvt_queue(F);
        __syncthreads();
        {
            unsigned* cdone = WSP(unsigned, WS_ZERO + ZB_CTR + 384);
            if (F.tid == 0) { unsigned sp = 0; while (__hip_atomic_load(cdone, __ATOMIC_RELAXED, __HIP_MEMORY_SCOPE_AGENT) < 65u) { __builtin_amdgcn_s_sleep(1); if (++sp > (1u << 24)) break; }
                __builtin_amdgcn_fence(__ATOMIC_ACQUIRE, "agent"); }
            __syncthreads();
            ph_mlstm_D(F);
        }
        __syncthreads();
    } SEAM(6);
    if (IN(7)) { PolResid<false> p{{WSP(bf16_t, WS_HCAT), WSP(bf16_t, WS_WOUT), 2048, 2048, 2048, 64, 8}, F.in[0], mod0 + 4096, WSP(bf16_t, WS_XA)}; pg8::gemm_phase(F.lds, p); } SEAM(7);
    if (IN(8)) { PRB(4) ph_modulate<1>(F, WSP(bf16_t, WS_XA), mod0 + 6144, mod0 + 8192, WSP(bf16_t, WS_H2)); } SEAM(8);
    if (IN(9)) { PRB(6) moe_phase_router(F, 0); } SEAM(9);
    if (IN(10)) { PRB(9) ph_route(F, 0); } SEAM(10);
    if (IN(11)) { PRB(9) ph_dispatch(F); } SEAM(11);
    if (IN(12)) { PRB(1) moe_phase_gateup(F, 0); } SEAM(12);
    if (IN(13)) { moe_phase_down(F, 0);
#if PROBE_DOWN_NOSTORE == 1
        moe_phase_down(F, 0, 1);
#elif PROBE_DOWN_NOSTORE == 2
        moe_phase_down(F, 0, 0);
#endif
    } SEAM(13);
    if (IN(14)) { PRB(3) ph_combine<0>(F, WSP(bf16_t, WS_XA), mod0 + 10240, WSP(bf16_t, WS_XB), mod1 + 0, mod1 + 2048, WSP(bf16_t, WS_HA), nullptr); } SEAM(14);
    if (IN(15)) { PolBf16 p{{WSP(bf16_t, WS_HA), WSP(bf16_t, WS_WQKV), 2048, 2048, 2048, 64, 10}, WSP(bf16_t, WS_PROJ), 2560, F.in[14]}; pg8::gemm_phase(F.lds, p); } SEAM(15);
    if (IN(17)) { PRB(7) ph_swa(F);
    } SEAM(17);
    if (IN(18)) { PolResid<true> p{{WSP(bf16_t, WS_HCAT), WSP(bf16_t, WS_WO), 2048, 2048, 2048, 64, 8}, WSP(bf16_t, WS_XB), mod1 + 4096, WSP(bf16_t, WS_XA)}; pg8::gemm_phase(F.lds, p); } SEAM(18);
    if (IN(19)) { ph_modulate<1>(F, WSP(bf16_t, WS_XA), mod1 + 6144, mod1 + 8192, WSP(bf16_t, WS_H2)); } SEAM(19);
    if (IN(20)) { moe_phase_router(F, 1); } SEAM(20);
    if (IN(21)) { ph_route(F, 1); } SEAM(21);
    if (IN(22)) { ph_dispatch(F); } SEAM(22);
    if (IN(23)) { moe_phase_gateup(F, 1); } SEAM(23);
    if (IN(24)) { moe_phase_down(F, 1); } SEAM(24);
    if (IN(25)) { ph_combine<1>(F, WSP(bf16_t, WS_XA), mod1 + 10240, nullptr, nullptr, F.in[23], nullptr, F.out); }
#undef IN
#undef SEAM
}

#ifdef DBG_DUMP_OFF
__global__ void __launch_bounds__(512) dbg_dump(unsigned char* ws, float* out) {
    const size_t NOUT = (size_t)T * D;
    for (size_t i = (size_t)blockIdx.x * 512 + threadIdx.x; i < NOUT; i += (size_t)gridDim.x * 512) {
        float a = 0.f;
        for (size_t j = i; j < (size_t)(DBG_DUMP_N); j += NOUT) a += (DBG_DUMP_KIND == 0) ? bf2f(((const bf16_t*)(ws + DBG_DUMP_OFF))[j]) : (DBG_DUMP_KIND == 1 ? ((const float*)(ws + DBG_DUMP_OFF))[j] : (DBG_DUMP_KIND == 2 ? (float)((const int*)(ws + DBG_DUMP_OFF))[j] : ((((const int*)(ws + DBG_DUMP_OFF))[j] < 0 || ((const int*)(ws + DBG_DUMP_OFF))[j] > 63) ? 1.0e6f : 0.0f)));
        if (DBG_DUMP_KIND == 4) { a = 0.f; if (i < (size_t)T * 8) { const int sl = ((const int*)(ws + WS_PSLOT))[i]; const int tk = (sl >= 0 && sl < NSLOT) ? ((const int*)(ws + WS_ROWTOK))[sl] : -7; a = (tk == (int)(i >> 3)) ? 0.f : 1.0e6f; } }
        if (DBG_DUMP_KIND == 5) { const int t = (int)(i >> 11), c = (int)(i & 2047); const bf16_t* Yp = (const bf16_t*)(ws + WS_Y); a = bf2f(Yp[(size_t)t * 2048 + c]);
            for (int k = 0; k < 8; ++k) { const int sl = ((const int*)(ws + WS_PSLOT))[t * 8 + k]; a += bf2f(Yp[(size_t)sl * 2048 + c]); } }
        if (DBG_DUMP_KIND == 6) { const int t = (int)(i >> 11), c = (int)(i & 2047); const bf16_t* Ap = (const bf16_t*)(ws + WS_ACT); a = 0.f; if (c < 256) { a = bf2f(Ap[(size_t)t * 256 + c]);
            for (int k = 0; k < 8; ++k) { const int sl = ((const int*)(ws + WS_PSLOT))[t * 8 + k]; a += bf2f(Ap[(size_t)sl * 256 + c]); } } }
        out[i] = a;
    }
}
#endif
extern "C" void kernel_launch(void* const* d_in, const int* in_sizes, int n_in, void* d_out, int out_size, void* d_ws, size_t ws_size, hipStream_t stream) {
    static int grid = 0;
    if (grid == 0) {
        if (n_in != 24 || out_size != T * D || ws_size < WS_END) { fprintf(stderr, "kernel_launch: unexpected shapes (n_in %d out %d ws %zu need %zu)\n", n_in, out_size, ws_size, (size_t)WS_END); grid = -1; return; }
        int dev = 0, cus = 0;
        if (hipGetDevice(&dev) != hipSuccess || hipDeviceGetAttribute(&cus, hipDeviceAttributeMultiprocessorCount, dev) != hipSuccess) { grid = -1; return; }
        if (hipFuncSetAttribute((const void*)mk_fwd, hipFuncAttributeMaxDynamicSharedMemorySize, LDS_BYTES) != hipSuccess) { fprintf(stderr, "kernel_launch: hipFuncSetAttribute failed\n"); grid = -1; return; }
        int per_cu = 0;
        if (hipOccupancyMaxActiveBlocksPerMultiprocessor(&per_cu, (const void*)mk_fwd, NTHREADS, LDS_BYTES) != hipSuccess || per_cu < 1) { fprintf(stderr, "kernel_launch: occupancy query says %d blocks per CU\n", per_cu); }
        (void)hipGetLastError();
        grid = cus;
    }
    if (grid < 0) return;
    (void)hipMemsetAsync((char*)d_ws + WS_ZERO, 0, ZERO_BYTES, stream);
    Args a; memset(&a, 0, sizeof(a));
    for (int i = 0; i < 24; ++i) a.in[i] = (const float*)d_in[i];
    a.out = (float*)d_out; a.ws = (unsigned char*)d_ws;
#if MK_MULTI
#ifdef DBG_DUMP_OFF
    for (int p = 0; p <= DBG_LAST; ++p) { a.ph_lo = p; a.ph_hi = p + 1; hipLaunchKernelGGL(mk_fwd, dim3(grid), dim3(NTHREADS), LDS_BYTES, stream, a); }
    hipLaunchKernelGGL(dbg_dump, dim3(1024), dim3(512), 0, stream, (unsigned char*)d_ws, (float*)d_out);
#else
    for (int p = 0; p < NPHASE; ++p) { a.ph_lo = p; a.ph_hi = p + 1; hipLaunchKernelGGL(mk_fwd, dim3(grid), dim3(NTHREADS), LDS_BYTES, stream, a); }
#endif
#else
    a.ph_lo = 0; a.ph_hi = NPHASE;
    hipLaunchKernelGGL(mk_fwd, dim3(grid), dim3(NTHREADS), LDS_BYTES, stream, a);
#endif
}
```

```cpp
#include <hip/hip_runtime.h>
#include <cstdio>
#include <cstdint>
#include <cstring>

#ifndef PROBE_EXTRA_BARRIERS
#define PROBE_EXTRA_BARRIERS 0
#endif
#ifndef PROBE_DOWN_NOSTORE
#define PROBE_DOWN_NOSTORE 0
#endif
#ifndef EXP_DUP_LDS
#define EXP_DUP_LDS 0
#endif
#ifndef EXP_DUP_QK
#define EXP_DUP_QK 0
#endif
#ifndef EXP_DUP_EXP
#define EXP_DUP_EXP 0
#endif
#ifndef ATT_STAGGER
#define ATT_STAGGER 0
#endif
#ifndef NT_STORES
#define NT_STORES 0
#endif
#ifndef DENSE_XCD
#define DENSE_XCD 0
#endif
#ifndef PROBE_SET
#define PROBE_SET 0
#endif
#define PRB(bit) _Pragma("unroll") for (int rep_ = 0; rep_ < (((PROBE_SET) >> (bit)) & 1) + 1; ++rep_)
#ifndef PROBE_REP_MLA
#define PROBE_REP_MLA 1
#endif
#ifndef MCV_BLOCKS
#define MCV_BLOCKS 32
#endif
#ifndef MK_MULTI
#define MK_MULTI 0
#endif

#define LAS __attribute__((address_space(3)))
typedef unsigned short bf16_t;
typedef short bf16x8 __attribute__((ext_vector_type(8)));
typedef short s16x4 __attribute__((ext_vector_type(4)));
typedef float f32x4 __attribute__((ext_vector_type(4)));
typedef float f32x16 __attribute__((ext_vector_type(16)));
typedef unsigned u32x4 __attribute__((ext_vector_type(4)));
typedef unsigned u32x2 __attribute__((ext_vector_type(2)));

constexpr int T = 16384, D = 2048;
constexpr int IN_DIM = 4424, IN_PAD = 4608;
constexpr int OFF_MQ = 0, OFF_MK = 512, OFF_MV = 1024, OFF_MO = 2048, OFF_MI = 3072, OFF_MF = 3076, OFF_CQ = 3080, OFF_CKV = 3848, OFF_KR = 4360;
constexpr int NE = 64, TOPK = 8, EFF = 256;
constexpr int NSLOT = T + T * TOPK + NE * 256;
constexpr int NCH = 256;
constexpr float EPS = 1e-6f;

constexpr size_t al256(size_t x) { return (x + 255) & ~(size_t)255; }
constexpr size_t WS_ZERO = 0;
constexpr size_t ZB_BAR = 0;
constexpr size_t ZB_MOD = 16384;
constexpr size_t ZB_CTR = 16384 + 98304;
constexpr size_t ZERO_BYTES = 16384 + 98304 + 16384;
constexpr size_t WS_ROPE = al256(WS_ZERO + ZERO_BYTES);
constexpr size_t WS_WIN = al256(WS_ROPE + (size_t)T * 32 * 8);
constexpr size_t WS_WUQ = al256(WS_WIN + (size_t)IN_PAD * 2048 * 2);
constexpr size_t WS_WUKV = al256(WS_WUQ + (size_t)1536 * 768 * 2);
constexpr size_t WS_WOUT = al256(WS_WUKV + (size_t)2048 * 512 * 2);
constexpr size_t WS_WQKV = al256(WS_WOUT + (size_t)2048 * 2048 * 2);
constexpr size_t WS_WO = al256(WS_WQKV + (size_t)2560 * 2048 * 2);
constexpr size_t WS_WR = al256(WS_WO + (size_t)2048 * 2048 * 2);
constexpr size_t WS_WGU = al256(WS_WR + (size_t)2 * 256 * 4096 * 2);
constexpr size_t WS_WDN = al256(WS_WGU + (size_t)2 * 65 * 512 * 2048 * 2);
constexpr size_t WS_HA = al256(WS_WDN + (size_t)2 * 65 * 2048 * 256 * 2);
constexpr size_t WS_H2 = al256(WS_HA + (size_t)T * 2048 * 2);
constexpr size_t WS_XA = al256(WS_H2 + (size_t)T * 4096 * 2);
constexpr size_t WS_XB = al256(WS_XA + (size_t)T * 2048 * 4);
constexpr size_t WS_HCAT = al256(WS_XB + (size_t)T * 2048 * 4);
constexpr size_t WS_GA = al256(WS_HCAT + (size_t)T * 2048 * 2);
constexpr size_t WS_GB = al256(WS_GA + (size_t)4 * T * 4);
constexpr size_t WS_GCM = al256(WS_GB + (size_t)4 * T * 4);
constexpr size_t WS_GST = al256(WS_GCM + (size_t)4 * T * 4);
constexpr size_t WS_DN = al256(WS_GST + 16384);
constexpr size_t WS_NST = al256(WS_DN + (size_t)NCH * 4 * 128 * 4);
constexpr size_t WS_LOGP = al256(WS_NST + (size_t)NCH * 4 * 128 * 4);
constexpr size_t WS_TKI = al256(WS_LOGP + (size_t)4 * T * 128 * 4);
constexpr size_t WS_TKW = al256(WS_TKI + (size_t)T * 8 * 4);
constexpr size_t WS_PSLOT = al256(WS_TKW + (size_t)T * 8 * 4);
constexpr size_t WS_HIST = al256(WS_PSLOT + (size_t)T * 8 * 4);
constexpr size_t WS_ETAB = al256(WS_HIST + (size_t)256 * 64 * 4);
constexpr size_t WS_ROWTOK = al256(WS_ETAB + 4096);
constexpr size_t WS_ACT = al256(WS_ROWTOK + (size_t)NSLOT * 4);
constexpr size_t WS_Y = al256(WS_ACT + (size_t)NSLOT * 256 * 2);
constexpr size_t WS_PROJ = WS_Y;
constexpr size_t WS_CQN = al256(WS_PROJ + (size_t)T * IN_PAD * 2);
constexpr size_t WS_CKVN = al256(WS_CQN + (size_t)T * 768 * 2);
constexpr size_t WS_KPE = al256(WS_CKVN + (size_t)T * 512 * 2);
constexpr size_t WS_QRAW = al256(WS_KPE + (size_t)T * 64 * 2);
constexpr size_t WS_KVRAW = al256(WS_QRAW + (size_t)T * 1536 * 2);
constexpr size_t WS_DC = al256(WS_KVRAW + (size_t)T * 2048 * 2);
constexpr size_t WS_CST = al256(WS_DC + (size_t)NCH * 4 * 256 * 128 * 2);
constexpr size_t WS_MIXEND = al256(WS_CST + (size_t)NCH * 4 * 256 * 128 * 2);
constexpr size_t WS_END = al256(WS_Y + (size_t)NSLOT * 2048 * 2);
static_assert(WS_MIXEND <= WS_END, "mixer temporaries must fit inside the Y region");

__device__ __forceinline__ unsigned cvt_pk_bf16(float lo, float hi) { unsigned r; asm volatile("v_cvt_pk_bf16_f32 %0, %1, %2" : "=v"(r) : "v"(lo), "v"(hi)); return r; }
__device__ __forceinline__ float bf2f(unsigned short h) { return __uint_as_float((unsigned)h << 16); }
__device__ __forceinline__ float bflo(unsigned w) { return __uint_as_float(w << 16); }
__device__ __forceinline__ float bfhi(unsigned w) { return __uint_as_float(w & 0xffff0000u); }
__device__ __forceinline__ bf16_t f2bf(float f) { return (bf16_t)(cvt_pk_bf16(f, f) & 0xffffu); }
template <int CTRL> __device__ __forceinline__ float dpp_add(float v) { return v + __int_as_float(__builtin_amdgcn_update_dpp(0, __float_as_int(v), CTRL, 0xF, 0xF, true)); }
__device__ __forceinline__ float wave_sum(float v) {
    v = dpp_add<0xB1>(v); v = dpp_add<0x4E>(v); v = dpp_add<0x141>(v); v = dpp_add<0x140>(v);
    v += __int_as_float(__builtin_amdgcn_ds_swizzle(__float_as_int(v), 0x401F));
    return __int_as_float(__builtin_amdgcn_readlane(__float_as_int(v), 0)) + __int_as_float(__builtin_amdgcn_readlane(__float_as_int(v), 32));
}
template <int CTRL> __device__ __forceinline__ float dpp_max(float v) { return fmaxf(v, __int_as_float(__builtin_amdgcn_update_dpp(__float_as_int(v), __float_as_int(v), CTRL, 0xF, 0xF, false))); }
__device__ __forceinline__ float grp8_max(float v) { v = dpp_max<0xB1>(v); v = dpp_max<0x4E>(v); return dpp_max<0x141>(v); }
__device__ __forceinline__ int wave_incl_scan(int v, int lane) {
#pragma unroll
    for (int o = 1; o < 64; o <<= 1) { const int u = __shfl_up(v, o); v += (lane >= o) ? u : 0; }
    return v;
}
__device__ __forceinline__ float sigmoidf_(float x) { return 1.0f / (1.0f + __expf(-x)); }

#define XB_TMO      128
#define XB_XCNT(j)  (256  + 64 * (j))
#define XB_XSUB(j)  (1280 + 64 * (j))
#define XB_XGEN(j)  (2304 + 64 * (j))
#define XB_TOP      3328
#define XB_TOPGEN   3392
#define XCD_BAR_WORDS 3456
#define XB_SPIN_CAP (1u << 22)
__device__ __forceinline__ unsigned xb_ld(unsigned* p)              { return __hip_atomic_load(p, __ATOMIC_RELAXED, __HIP_MEMORY_SCOPE_AGENT); }
__device__ __forceinline__ unsigned xb_add(unsigned* p, unsigned v) { return __hip_atomic_fetch_add(p, v, __ATOMIC_RELAXED, __HIP_MEMORY_SCOPE_AGENT); }
__device__ __forceinline__ unsigned xb_xcc_id() { return (unsigned)__builtin_amdgcn_s_getreg((3 << 11) | 20) & 0xFu; }
#define XB_SPIN(cond, bar) do { unsigned _sp = 0; while (cond) { __builtin_amdgcn_s_sleep(1); \
    if ((++_sp & 255u) == 0u) { if (xb_ld(&(bar)[XB_TMO])) break; if (_sp > XB_SPIN_CAP) { atomicAdd(&(bar)[XB_TMO], 1u); break; } } } } while (0)
struct XcdBarrier { unsigned* bar; unsigned x; volatile LAS unsigned* st; };
__device__ __forceinline__ XcdBarrier xcd_barrier_post(unsigned* bar, volatile LAS unsigned* st) {
    XcdBarrier b; b.bar = bar; b.x = xb_xcc_id(); b.st = st;
    if (threadIdx.x == 0) (void)xb_add(&bar[XB_XCNT(b.x)], 1u);
    return b;
}
__device__ __forceinline__ void xcd_barrier_complete(unsigned* bar, unsigned x, unsigned& nloc, unsigned& nx) {
    const unsigned G = gridDim.x * gridDim.y * gridDim.z;
    unsigned sum, cnt, mine, sp = 0u;
    for (;;) {
        sum = 0u; cnt = 0u; mine = 0u;
#pragma unroll
        for (unsigned j = 0; j < 16; ++j) { const unsigned c = xb_ld(&bar[XB_XCNT(j)]); sum += c; cnt += (c > 0u) ? 1u : 0u; mine = (j == x) ? c : mine; }
        if (sum == G) break;
        __builtin_amdgcn_s_sleep(1);
        if ((++sp & 255u) == 0u) { if (xb_ld(&bar[XB_TMO])) break; if (sp > XB_SPIN_CAP) { atomicAdd(&bar[XB_TMO], 1u); break; } }
    }
    nloc = mine > 0u ? mine : 1u; nx = cnt > 0u ? cnt : 1u;
}
__device__ __forceinline__ void xcd_barrier(const XcdBarrier& b) {
    asm volatile("s_waitcnt vmcnt(0)" ::: "memory");
    __syncthreads();
    if (threadIdx.x == 0) {
        unsigned* bar = b.bar;
        __builtin_amdgcn_s_waitcnt(0);
        unsigned nloc = b.st[0], nx = b.st[1];
        if (nloc == 0u) { xcd_barrier_complete(bar, b.x, nloc, nx); b.st[0] = nloc; b.st[1] = nx; }
        const unsigned old = xb_add(&bar[XB_XSUB(b.x)], 1u);
        const unsigned gen = old / nloc;
        if (old + 1u == (gen + 1u) * nloc) {
            __builtin_amdgcn_fence(__ATOMIC_RELEASE, "agent");
            asm volatile("s_waitcnt vmcnt(0)" ::: "memory");
            const unsigned og = xb_add(&bar[XB_TOP], 1u);
            const unsigned tg = og / nx;
            if (og + 1u == (tg + 1u) * nx) xb_add(&bar[XB_TOPGEN], 1u);
            else XB_SPIN(xb_ld(&bar[XB_TOPGEN]) == tg, bar);
            __builtin_amdgcn_fence(__ATOMIC_ACQUIRE, "agent");
            xb_add(&bar[XB_XGEN(b.x)], 1u);
            asm volatile("s_waitcnt vmcnt(0)" ::: "memory");
        } else {
            XB_SPIN(xb_ld(&bar[XB_XGEN(b.x)]) == gen, bar);
            __builtin_amdgcn_fence(__ATOMIC_ACQUIRE, "agent");
            asm volatile("s_waitcnt vmcnt(0)" ::: "memory");
        }
    }
    __syncthreads();
}

struct Args {
    const float* in[24];
    float* out;
    unsigned char* ws;
    int ph_lo, ph_hi;
};
constexpr int NTHREADS = 512;
constexpr int LDS_MAIN = 131072, LDS_AUX = 16384;
constexpr int LDS_BYTES = LDS_MAIN + LDS_AUX + 16;

struct Frame {
    LAS unsigned char* lds;
    LAS unsigned char* aux;
    const float* const* in;
    float* out;
    unsigned char* ws;
    int tid, lane, wid, G, bid;
};
#define WSP(T_, off) ((T_*)(F.ws + (off)))

namespace pg8 {
constexpr int BM = 256, BK = 64, HALF = 128, HTB = HALF * BK * 2, STAGE_BYTES = 8 * HTB;
__device__ __forceinline__ int lds_byte(int r, int c) { const int st = (r >> 4) * 2 + (c >> 5), rr = r & 15, cc = c & 31, ob = rr * 64 + cc * 2; return st * 1024 + (ob ^ (((ob >> 9) & 1) << 5)); }
__device__ __forceinline__ void stage_rc(int b, int& R, int& C) { const int st = b / 1024, sb = b % 1024, swz = sb ^ (((sb >> 9) & 1) << 5); R = (st >> 1) * 16 + swz / 64; C = (st & 1) * 32 + (swz % 64) / 2; }
__device__ __forceinline__ int perm32(int rho) { const int n = rho >> 4, i = rho & 15; return 8 * (i >> 2) + 4 * n + (i & 3); }
struct Unit { int a, b, c, d; };

template <class P>
__device__ __forceinline__ void gemm_phase(LAS unsigned char* lds, const P& p) {
    const int tid = threadIdx.x, wid = __builtin_amdgcn_readfirstlane(tid >> 6), lane = tid & 63, wr = wid >> 2, wc = wid & 3, fr = lane & 15, fq = lane >> 4;
    const int K = p.K, nt = K / BK;
    const int G = p.stride(), c0 = p.first();
    const int NU = p.nunits();
    if (c0 >= NU) return;
    int R[2], C[2]; unsigned voffB[2][2];
#pragma unroll
    for (int i = 0; i < 2; ++i) { stage_rc(tid * 16 + i * 8192, R[i], C[i]); const int Rb = P::PERM ? ((R[i] & ~31) + perm32(R[i] & 31)) : R[i];
#pragma unroll
        for (int h = 0; h < 2; ++h) voffB[h][i] = (unsigned)((h * HALF + Rb) * p.ldb + C[i]) * 2u; }
    const size_t kstep = (size_t)(BK * 2);
    const unsigned ldsw = (unsigned)wid * 1024u;
    const int aoff = lds_byte(wr * 64 + fr, fq * 8), boff = lds_byte(wc * 32 + fr, fq * 8);
    const char* const Ab = p.abase();
#define PG8_SA(b, h) (((b) * 2 + (h)) * HTB)
#define PG8_SB(b, h) ((4 + (b) * 2 + (h)) * HTB)
#define PG8_STAGE(bufoff, gbase, o0, o1) do { \
        __builtin_amdgcn_global_load_lds((const unsigned*)((const char*)(gbase) + (o0)), (LAS unsigned*)(lds + (bufoff) + ldsw), 16, 0, 0); \
        __builtin_amdgcn_global_load_lds((const unsigned*)((const char*)(gbase) + (o1)), (LAS unsigned*)(lds + (bufoff) + ldsw + 8192), 16, 0, 0); } while (0)
#define PG8_LDA(dst, b, h) do { _Pragma("unroll") for (int m = 0; m < 4; ++m) _Pragma("unroll") for (int k = 0; k < 2; ++k) dst[m][k] = *(const LAS bf16x8*)(lds + PG8_SA(b, h) + aoff + m * 2048 + k * 1024); } while (0)
#define PG8_LDB(dst, b, h) do { _Pragma("unroll") for (int n = 0; n < 2; ++n) _Pragma("unroll") for (int k = 0; k < 2; ++k) dst[n][k] = *(const LAS bf16x8*)(lds + PG8_SB(b, h) + boff + n * 2048 + k * 1024); } while (0)
#define PG8_MMA(ai, bj, At, Bt) do { __builtin_amdgcn_s_setprio(1); _Pragma("unroll") for (int m = 0; m < 4; ++m) _Pragma("unroll") for (int n = 0; n < 2; ++n) _Pragma("unroll") for (int k = 0; k < 2; ++k) \
        acc[ai][bj][m][n] = __builtin_amdgcn_mfma_f32_16x16x32_bf16(Bt[n][k], At[m][k], acc[ai][bj][m][n], 0, 0, 0); __builtin_amdgcn_s_setprio(0); } while (0)
#define PG8_WAIT_V(n) asm volatile("s_waitcnt vmcnt(" #n ")" ::: "memory")
#define PG8_WAIT_L(n) asm volatile("s_waitcnt lgkmcnt(" #n ")" ::: "memory")
#define PG8_BAR __builtin_amdgcn_s_barrier()
#define PG8_SCHED __builtin_amdgcn_sched_barrier(0)
    Unit cur, nxt; int ui = 0;
    p.unit(c0, cur);
    unsigned aoc[2][2], aon[2][2];
    p.a_off(cur, R, C, aoc);
    f32x4 acc[2][2][4][2];
#pragma unroll
    for (int a = 0; a < 2; ++a)
#pragma unroll
        for (int b = 0; b < 2; ++b)
#pragma unroll
            for (int m = 0; m < 4; ++m)
#pragma unroll
                for (int n = 0; n < 2; ++n) acc[a][b][m][n] = (f32x4){0.f, 0.f, 0.f, 0.f};
    bf16x8 At[4][2], B0[2][2], B1[2][2];
    const char* cB = p.bbase(cur);
    PG8_STAGE(PG8_SB(0, 0), cB, voffB[0][0], voffB[0][1]); PG8_STAGE(PG8_SA(0, 0), Ab, aoc[0][0], aoc[0][1]);
    PG8_STAGE(PG8_SB(0, 1), cB, voffB[1][0], voffB[1][1]); PG8_STAGE(PG8_SA(0, 1), Ab, aoc[1][0], aoc[1][1]);
    if (wr == 1) PG8_BAR;
    PG8_WAIT_V(4); PG8_BAR;
    PG8_STAGE(PG8_SB(1, 0), cB + kstep, voffB[0][0], voffB[0][1]); PG8_STAGE(PG8_SA(1, 0), Ab + kstep, aoc[0][0], aoc[0][1]);
    PG8_STAGE(PG8_SB(1, 1), cB + kstep, voffB[1][0], voffB[1][1]);
    PG8_WAIT_V(6); PG8_BAR;
    for (;;) {
        const bool has_next = (c0 + (ui + 1) * G) < NU;
        if (has_next) { p.unit(c0 + (ui + 1) * G, nxt); p.a_off(nxt, R, C, aon); }
        else { nxt = cur;
#pragma unroll
            for (int h = 0; h < 2; ++h)
#pragma unroll
                for (int i = 0; i < 2; ++i) aon[h][i] = aoc[h][i]; }
        const char* nB = has_next ? p.bbase(nxt) : cB;
        for (int t = 0; t < nt; t += 2) {
            const bool last = (t == nt - 2);
            const char* a1 = Ab + (size_t)(t + 1) * kstep;
            const char* a2 = last ? Ab : Ab + (size_t)(t + 2) * kstep; const char* b2 = last ? nB : cB + (size_t)(t + 2) * kstep;
            const char* a3 = a2 + kstep; const char* b3 = b2 + kstep;
            unsigned ao2[2][2];
#pragma unroll
            for (int h = 0; h < 2; ++h)
#pragma unroll
                for (int i = 0; i < 2; ++i) ao2[h][i] = last ? aon[h][i] : aoc[h][i];
            PG8_LDB(B0, 0, 0); PG8_SCHED; PG8_LDA(At, 0, 0); PG8_STAGE(PG8_SA(1, 1), a1, aoc[1][0], aoc[1][1]);
            PG8_WAIT_L(8); PG8_BAR; PG8_WAIT_L(0); PG8_MMA(0, 0, At, B0); PG8_BAR; PG8_SCHED;
            PG8_LDB(B1, 0, 1); PG8_STAGE(PG8_SB(0, 0), b2, voffB[0][0], voffB[0][1]);
            PG8_BAR; PG8_WAIT_L(0); PG8_MMA(0, 1, At, B1); PG8_BAR;
            PG8_LDA(At, 0, 1); PG8_STAGE(PG8_SA(0, 0), a2, ao2[0][0], ao2[0][1]);
            PG8_BAR; PG8_WAIT_L(0); PG8_MMA(1, 0, At, B0); PG8_BAR; PG8_SCHED;
            PG8_STAGE(PG8_SB(0, 1), b2, voffB[1][0], voffB[1][1]);
            PG8_WAIT_V(6); PG8_BAR; PG8_MMA(1, 1, At, B1); PG8_BAR;
            PG8_LDB(B0, 1, 0); PG8_SCHED; PG8_LDA(At, 1, 0); PG8_STAGE(PG8_SA(0, 1), a2, ao2[1][0], ao2[1][1]);
            PG8_WAIT_L(8); PG8_BAR; PG8_WAIT_L(0); PG8_MMA(0, 0, At, B0); PG8_BAR; PG8_SCHED;
            PG8_LDB(B1, 1, 1); PG8_STAGE(PG8_SB(1, 0), b3, voffB[0][0], voffB[0][1]);
            PG8_BAR; PG8_WAIT_L(0); PG8_MMA(0, 1, At, B1); PG8_BAR;
            PG8_LDA(At, 1, 1); PG8_STAGE(PG8_SA(1, 0), a3, ao2[0][0], ao2[0][1]);
            PG8_BAR; PG8_WAIT_L(0); PG8_MMA(1, 0, At, B0); PG8_BAR; PG8_SCHED;
            PG8_STAGE(PG8_SB(1, 1), b3, voffB[1][0], voffB[1][1]);
            PG8_WAIT_V(6); PG8_BAR; PG8_MMA(1, 1, At, B1); PG8_BAR;
        }
        p.epi(acc, cur, wr, wc, fr, fq);
        if (!has_next) break;
#pragma unroll
        for (int a = 0; a < 2; ++a)
#pragma unroll
            for (int b = 0; b < 2; ++b)
#pragma unroll
                for (int m = 0; m < 4; ++m)
#pragma unroll
                    for (int n = 0; n < 2; ++n) acc[a][b][m][n] = (f32x4){0.f, 0.f, 0.f, 0.f};
        cur = nxt; cB = nB; ++ui;
#pragma unroll
        for (int h = 0; h < 2; ++h)
#pragma unroll
            for (int i = 0; i < 2; ++i) aoc[h][i] = aon[h][i];
    }
    PG8_WAIT_V(0);
    if (wr == 0) PG8_BAR;
    PG8_BAR;
#undef PG8_SA
#undef PG8_SB
#undef PG8_STAGE
#undef PG8_LDA
#undef PG8_LDB
#undef PG8_MMA
#undef PG8_WAIT_V
#undef PG8_WAIT_L
#undef PG8_BAR
#undef PG8_SCHED
}
}

__device__ __forceinline__ void adaln_sc(const Frame& F) {
    const float* c = F.in[1]; LAS float* sc = (LAS float*)F.lds;
    __syncthreads();
    for (int i = F.tid; i < 2048; i += NTHREADS) { const float cv = c[i]; sc[i] = cv / (1.0f + expf(-cv)); }
    __syncthreads();
}
__device__ __forceinline__ void adaln_unit(const Frame& F, int u) {
    const float* w_ada = F.in[3]; const float* b_ada = F.in[4];
    float* mod = WSP(float, WS_ZERO + ZB_MOD);
    const LAS float* sc = (const LAS float*)F.lds;
    LAS f32x4* part = (LAS f32x4*)(F.lds + 8192);
    const int cg = F.tid % 12, kg = F.tid / 12;
    const int l = u >> 8, col0 = (u & 255) * 48;
    if (F.tid < 504) {
        f32x4 acc = (f32x4){0.f, 0.f, 0.f, 0.f};
        const float* wp = w_ada + (size_t)l * 2048 * 12288 + col0 + cg * 4;
#pragma unroll 7
        for (int k = kg; k < 2048; k += 42) { const f32x4 w = __builtin_nontemporal_load((const f32x4*)(wp + (size_t)k * 12288)); acc += w * sc[k]; }
        part[kg * 12 + cg] = acc;
    }
    __syncthreads();
    if (F.tid < 48) { float s_ = 0.f; const LAS float* pf = (const LAS float*)part;
        for (int g = 0; g < 42; ++g) s_ += pf[g * 48 + F.tid];
        mod[(size_t)l * 12288 + col0 + F.tid] = s_ + b_ada[(size_t)l * 12288 + col0 + F.tid]; }
    __syncthreads();
}
__device__ __forceinline__ void ph_adaln(const Frame& F) {
    adaln_sc(F);
    for (int u = F.bid; u < 256; u += F.G) adaln_unit(F, u);
}

__device__ __forceinline__ void ph_rope_table(const Frame& F) {
    const int* pos = (const int*)F.in[2];
    float2* tab = WSP(float2, WS_ROPE);
    for (int idx = F.bid * NTHREADS + F.tid; idx < T * 32; idx += F.G * NTHREADS) {
        const int t = idx >> 5, i = idx & 31;
        const float inv_freq = (float)exp2(-(double)i * (13.287712379549449 / 32.0));
        const float ang = (float)pos[t] * inv_freq;
        const double rev = (double)ang * 0.15915494309189535;
        const float fr = (float)(rev - rint(rev));
        tab[idx] = make_float2(__builtin_amdgcn_cosf(fr), __builtin_amdgcn_sinf(fr));
    }
}

struct CvtJob { const float* src; bf16_t* dst; int K, Nsrc, Ndst, batch, mode, tiles_per_mat, tile0; size_t sbs, dbs; };
__device__ __forceinline__ void cvt_load(const Frame& F, const CvtJob& j, int lt, f32x4 (&v)[2][2]) {
    const int b = lt / j.tiles_per_mat, r = lt - b * j.tiles_per_mat;
    const int nkt = j.K / 128, ntile = r / nkt, kt = r - ntile * nkt;
    const float* src = j.src + (size_t)b * j.sbs;
    const int n4 = F.tid & 15, kp = F.tid >> 4;
    const int nd = ntile * 64 + n4 * 4;
    int scol; bool valid;
    if (j.mode == 1) { scol = ((nd >> 7) & 1) * 256 + (nd >> 8) * 128 + (nd & 127); valid = true; }
    else { scol = nd; valid = nd < j.Nsrc; }
#pragma unroll
    for (int jj = 0; jj < 2; ++jj)
#pragma unroll
        for (int e = 0; e < 2; ++e) { const int k = kt * 128 + jj * 64 + kp * 2 + e;
            v[jj][e] = valid ? __builtin_nontemporal_load((const f32x4*)(src + (size_t)k * j.Nsrc + scol)) : (f32x4){0.f, 0.f, 0.f, 0.f}; }
}
__device__ __forceinline__ void cvt_store(const Frame& F, const CvtJob& j, int lt, const f32x4 (&v)[2][2]) {
    const int b = lt / j.tiles_per_mat, r = lt - b * j.tiles_per_mat;
    const int nkt = j.K / 128, ntile = r / nkt, kt = r - ntile * nkt;
    bf16_t* dst = j.dst + (size_t)b * j.dbs;
    LAS unsigned* L = (LAS unsigned*)F.lds;
    const int n4 = F.tid & 15, kp = F.tid >> 4;
#pragma unroll
    for (int jj = 0; jj < 2; ++jj)
#pragma unroll
        for (int i = 0; i < 4; ++i) L[(n4 * 4 + i) * 65 + jj * 32 + kp] = cvt_pk_bf16(v[jj][0][i], v[jj][1][i]);
    __syncthreads();
    const int n = F.tid >> 3, ch = F.tid & 7;
    u32x4 o0, o1;
    o0.x = L[n * 65 + ch * 8 + 0]; o0.y = L[n * 65 + ch * 8 + 1]; o0.z = L[n * 65 + ch * 8 + 2]; o0.w = L[n * 65 + ch * 8 + 3];
    o1.x = L[n * 65 + ch * 8 + 4]; o1.y = L[n * 65 + ch * 8 + 5]; o1.z = L[n * 65 + ch * 8 + 6]; o1.w = L[n * 65 + ch * 8 + 7];
    bf16_t* dp = dst + (size_t)(ntile * 64 + n) * j.K + kt * 128 + ch * 16;
    *(u32x4*)dp = o0; *(u32x4*)(dp + 8) = o1;
    __syncthreads();
}
constexpr int NJOBS = 14;
__device__ __forceinline__ CvtJob make_job(const float* src, bf16_t* dst, int K, int Nsrc, int Ndst, int batch, int mode, size_t sbs, size_t dbs) {
    CvtJob j; j.src = src; j.dst = dst; j.K = K; j.Nsrc = Nsrc; j.Ndst = Ndst; j.batch = batch; j.mode = mode; j.sbs = sbs; j.dbs = dbs;
    j.tiles_per_mat = (K / 128) * (Ndst / 64); j.tile0 = 0; return j;
}
__device__ __forceinline__ void ph_convert(const Frame& F) {
    const int VG = F.G, vb_ = F.bid;
    int run = 0;
    if (vb_ >= 0) {
#define DO_JOB(J) do { const CvtJob jb = (J); const int nt_ = jb.tiles_per_mat * jb.batch; \
        int lt = (vb_ - (run % VG) + VG) % VG; f32x4 va[2][2], vb[2][2]; \
        if (lt < nt_) cvt_load(F, jb, lt, va); \
        for (; lt < nt_; lt += VG) { const int ltn = lt + VG; if (ltn < nt_) cvt_load(F, jb, ltn, vb); cvt_store(F, jb, lt, va); \
            _Pragma("unroll") for (int a_ = 0; a_ < 2; ++a_) _Pragma("unroll") for (int b_ = 0; b_ < 2; ++b_) va[a_][b_] = vb[a_][b_]; } \
        run += nt_; } while (0)
    DO_JOB(make_job(F.in[5], WSP(bf16_t, WS_WIN), 2048, IN_DIM, IN_PAD, 1, 0, 0, 0));
    DO_JOB(make_job(F.in[10], WSP(bf16_t, WS_WUQ), 768, 1536, 1536, 1, 0, 0, 0));
    DO_JOB(make_job(F.in[11], WSP(bf16_t, WS_WUKV), 512, 2048, 2048, 1, 0, 0, 0));
    DO_JOB(make_job(F.in[12], WSP(bf16_t, WS_WOUT), 2048, 2048, 2048, 1, 0, 0, 0));
#undef DO_JOB
    }
    bf16_t* wr = WSP(bf16_t, WS_WR);
    for (int idx = F.bid * NTHREADS + F.tid; idx < 2 * 256 * 2048; idx += F.G * NTHREADS) {
        const int l = idx >> 19, n = (idx >> 11) & 255, k = idx & 2047;
        bf16_t o = 0;
        if (n < 128) { const int e = n & 63;
            const float w = F.in[17][((size_t)l * 2048 + k) * 64 + e];
            const bf16_t hi = f2bf(w);
            o = (n < 64) ? hi : f2bf(w - bf2f(hi)); }
        wr[idx] = o;
    }
}

constexpr int MCV_CHUNK = 32;
constexpr int MCV_LAYER_TILES = 8192 + 128 + 4096 + 64;
constexpr int MCV_NMOE = 2 * MCV_LAYER_TILES / MCV_CHUNK;
constexpr int MCV_NCVT = MCV_NMOE + 20 + 16;
constexpr int MCV_NCHUNK = MCV_NCVT + 256;
__device__ __forceinline__ int grab(const Frame& F, unsigned* ctr) {
    LAS int* sl = (LAS int*)(F.aux + 16000);
    __syncthreads();
    if (F.tid == 0) *sl = (int)__hip_atomic_fetch_add(ctr, 1u, __ATOMIC_RELAXED, __HIP_MEMORY_SCOPE_AGENT);
    __syncthreads();
    return __builtin_amdgcn_readfirstlane(*sl);
}
__device__ __forceinline__ void moe_cvt_chunk(const Frame& F, int c) {
    if (c >= MCV_NCVT) { adaln_sc(F); adaln_unit(F, 256 + (c - MCV_NCVT)); return; }
    const int gt = c * MCV_CHUNK, l = gt / MCV_LAYER_TILES, r = gt - l * MCV_LAYER_TILES;
    CvtJob jb; int lt0;
    if (c >= MCV_NMOE + 20) { lt0 = (c - MCV_NMOE - 20) * MCV_CHUNK; jb = make_job(F.in[16], WSP(bf16_t, WS_WO), 2048, 2048, 2048, 1, 0, 0, 0); }
    else if (c >= MCV_NMOE) { lt0 = (c - MCV_NMOE) * MCV_CHUNK; jb = make_job(F.in[13], WSP(bf16_t, WS_WQKV), 2048, 2560, 2560, 1, 0, 0, 0); }
    else if (r < 8192) { lt0 = r; jb = make_job(F.in[19] + (size_t)l * 64 * 2048 * 512, WSP(bf16_t, WS_WGU) + (size_t)l * 65 * 512 * 2048, 2048, 512, 512, 64, 1, (size_t)2048 * 512, (size_t)512 * 2048); }
    else if (r < 8320) { lt0 = r - 8192; jb = make_job(F.in[21] + (size_t)l * 2048 * 512, WSP(bf16_t, WS_WGU) + ((size_t)l * 65 + 64) * 512 * 2048, 2048, 512, 512, 1, 1, 0, 0); }
    else if (r < 12416) { lt0 = r - 8320; jb = make_job(F.in[20] + (size_t)l * 64 * 256 * 2048, WSP(bf16_t, WS_WDN) + (size_t)l * 65 * 2048 * 256, 256, 2048, 2048, 64, 0, (size_t)256 * 2048, (size_t)2048 * 256); }
    else { lt0 = r - 12416; jb = make_job(F.in[22] + (size_t)l * 256 * 2048, WSP(bf16_t, WS_WDN) + ((size_t)l * 65 + 64) * 2048 * 256, 256, 2048, 2048, 1, 0, 0, 0); }
    f32x4 v0[2][2], v1[2][2], v2[2][2], v3[2][2];
    cvt_load(F, jb, lt0, v0); cvt_load(F, jb, lt0 + 1, v1); cvt_load(F, jb, lt0 + 2, v2);
#pragma unroll 1
    for (int i = 0; i < MCV_CHUNK; i += 4) {
        cvt_load(F, jb, lt0 + i + 3, v3); cvt_store(F, jb, lt0 + i, v0);
        if (i + 4 < MCV_CHUNK) cvt_load(F, jb, lt0 + i + 4, v0);
        cvt_store(F, jb, lt0 + i + 1, v1);
        if (i + 4 < MCV_CHUNK) cvt_load(F, jb, lt0 + i + 5, v1);
        cvt_store(F, jb, lt0 + i + 2, v2);
        if (i + 4 < MCV_CHUNK) cvt_load(F, jb, lt0 + i + 6, v2);
        cvt_store(F, jb, lt0 + i + 3, v3);
    }
}
__device__ __forceinline__ void moe_cvt_queue(const Frame& F) {
    unsigned* ctr = WSP(unsigned, WS_ZERO + ZB_CTR);
    for (;;) { const int c = grab(F, ctr); if (c >= MCV_NCHUNK) break; moe_cvt_chunk(F, c); }
}

template <int MODE>
__device__ __forceinline__ void ph_modulate(const Frame& F, const void* x, const float* shift, const float* scale, bf16_t* out) {
    f32x4 sc[8], sh[8];
#pragma unroll
    for (int j = 0; j < 8; ++j) { const int col = 4 * F.lane + 256 * j; sc[j] = *(const f32x4*)(scale + col) + 1.0f; sh[j] = *(const f32x4*)(shift + col); }
    for (int row = F.bid * 8 + F.wid; row < T; row += F.G * 8) {
        f32x4 v[8]; float ss = 0.f;
        if (MODE == 1) { u32x2 xw[8];
#pragma unroll
            for (int j = 0; j < 8; ++j) xw[j] = *(const u32x2*)((const bf16_t*)x + (size_t)row * D + 4 * F.lane + 256 * j);
#pragma unroll
            for (int j = 0; j < 8; ++j) v[j] = (f32x4){bflo(xw[j].x), bfhi(xw[j].x), bflo(xw[j].y), bfhi(xw[j].y)};
        }
#pragma unroll
        for (int j = 0; j < 8; ++j) { if (MODE == 0) v[j] = __builtin_nontemporal_load((const f32x4*)((const float*)x + (size_t)row * D + 4 * F.lane + 256 * j)); ss += v[j][0] * v[j][0] + v[j][1] * v[j][1] + v[j][2] * v[j][2] + v[j][3] * v[j][3]; }
        ss = wave_sum(ss);
        const float rstd = rsqrtf(ss * (1.0f / D) + EPS);
#pragma unroll
        for (int j = 0; j < 8; ++j) {
            const f32x4 h = (v[j] * rstd) * sc[j] + sh[j];
            const int col = 4 * F.lane + 256 * j;
            u32x2 hi; hi.x = cvt_pk_bf16(h[0], h[1]); hi.y = cvt_pk_bf16(h[2], h[3]);
            if (MODE == 0) { *(u32x2*)(out + (size_t)row * 2048 + col) = hi; }
            else {
                *(u32x2*)(out + (size_t)row * 2048 + col) = hi;
            }
        }
    }
}

typedef float f32x2_ __attribute__((ext_vector_type(2)));
template <int FINAL>
__device__ __forceinline__ void ph_combine(const Frame& F, const bf16_t* xold, const float* g, bf16_t* xnew, const float* shift, const float* scale, bf16_t* hout, float* fout) {
    const unsigned char* Y = WSP(unsigned char, WS_Y); const int* pslot = WSP(int, WS_PSLOT); const float* tkw = WSP(float, WS_TKW);
    for (int row = F.bid * 8 + F.wid; row < T; row += F.G * 8) {
        int sl[9]; float w[9];
#pragma unroll
        for (int k = 0; k < 8; ++k) { sl[k] = pslot[row * 8 + k]; w[k] = tkw[row * 8 + k] * (1.0f / 8.0f); }
        sl[8] = row; w[8] = 1.0f / 8.0f;
        float xn[2][16]; float ss = 0.f;
#pragma unroll
        for (int j = 0; j < 2; ++j) {
            const int col = 16 * F.lane + 1024 * j;
            float a[16];
#pragma unroll
            for (int e = 0; e < 16; ++e) a[e] = 0.f;
#pragma unroll
            for (int k = 0; k < 9; ++k) { const u32x4 y = __builtin_nontemporal_load((const u32x4*)(Y + (size_t)sl[k] * 2048 + col));
#pragma unroll
                for (int q = 0; q < 4; ++q) { const f32x2_ lo = __builtin_amdgcn_cvt_pk_f32_fp8((int)y[q], false), hi = __builtin_amdgcn_cvt_pk_f32_fp8((int)y[q], true);
                    a[4 * q + 0] += w[k] * lo[0]; a[4 * q + 1] += w[k] * lo[1]; a[4 * q + 2] += w[k] * hi[0]; a[4 * q + 3] += w[k] * hi[1]; } }
            const u32x4 xw0 = *(const u32x4*)(xold + (size_t)row * D + col), xw1 = *(const u32x4*)(xold + (size_t)row * D + col + 8);
            const unsigned xw[8] = {xw0.x, xw0.y, xw0.z, xw0.w, xw1.x, xw1.y, xw1.z, xw1.w};
#pragma unroll
            for (int q = 0; q < 4; ++q) { const f32x4 x0 = (f32x4){bflo(xw[2 * q]), bfhi(xw[2 * q]), bflo(xw[2 * q + 1]), bfhi(xw[2 * q + 1])}; const f32x4 g0 = *(const f32x4*)(g + col + 4 * q);
#pragma unroll
                for (int e = 0; e < 4; ++e) { const float v = x0[e] + g0[e] * a[4 * q + e]; xn[j][4 * q + e] = v; ss += v * v; } }
            if (!FINAL) { u32x4 o0, o1; o0.x = cvt_pk_bf16(xn[j][0], xn[j][1]); o0.y = cvt_pk_bf16(xn[j][2], xn[j][3]); o0.z = cvt_pk_bf16(xn[j][4], xn[j][5]); o0.w = cvt_pk_bf16(xn[j][6], xn[j][7]);
                o1.x = cvt_pk_bf16(xn[j][8], xn[j][9]); o1.y = cvt_pk_bf16(xn[j][10], xn[j][11]); o1.z = cvt_pk_bf16(xn[j][12], xn[j][13]); o1.w = cvt_pk_bf16(xn[j][14], xn[j][15]);
                *(u32x4*)(xnew + (size_t)row * D + col) = o0; *(u32x4*)(xnew + (size_t)row * D + col + 8) = o1; }
        }
        ss = wave_sum(ss);
        const float rstd = rsqrtf(ss * (1.0f / D) + EPS);
#pragma unroll
        for (int j = 0; j < 2; ++j) {
            const int col = 16 * F.lane + 1024 * j;
            float h[16];
#pragma unroll
            for (int q = 0; q < 4; ++q) { const f32x4 s0 = *(const f32x4*)(scale + col + 4 * q);
                if (FINAL) { f32x4 o0;
#pragma unroll
                    for (int e = 0; e < 4; ++e) o0[e] = xn[j][4 * q + e] * rstd * s0[e];
                    *(f32x4*)(fout + (size_t)row * D + col + 4 * q) = o0; }
                else { const f32x4 h0 = *(const f32x4*)(shift + col + 4 * q);
#pragma unroll
                    for (int e = 0; e < 4; ++e) h[4 * q + e] = xn[j][4 * q + e] * rstd * (1.0f + s0[e]) + h0[e]; } }
            if (!FINAL) { u32x4 o0, o1; o0.x = cvt_pk_bf16(h[0], h[1]); o0.y = cvt_pk_bf16(h[2], h[3]); o0.z = cvt_pk_bf16(h[4], h[5]); o0.w = cvt_pk_bf16(h[6], h[7]);
                o1.x = cvt_pk_bf16(h[8], h[9]); o1.y = cvt_pk_bf16(h[10], h[11]); o1.z = cvt_pk_bf16(h[12], h[13]); o1.w = cvt_pk_bf16(h[14], h[15]);
                *(u32x4*)(hout + (size_t)row * 2048 + col) = o0; *(u32x4*)(hout + (size_t)row * 2048 + col + 8) = o1; }
        }
    }
}

using pg8::Unit;
template <bool NT>
__device__ __forceinline__ void store_bf16_tile(const f32x4 (&acc)[2][2][4][2], bf16_t* O, int ldc, int row0, int col0, const float* bias, int bcol0, int wr, int wc, int fr, int fq) {
    const int r0 = row0 + wr * 64 + fr, c0 = col0 + wc * 32 + 8 * fq, bc0 = bcol0 + wc * 32 + 8 * fq;
    f32x4 bv[2][2];
#pragma unroll
    for (int bj = 0; bj < 2; ++bj)
#pragma unroll
        for (int n = 0; n < 2; ++n) bv[bj][n] = bias ? *(const f32x4*)(bias + bc0 + bj * 128 + 4 * n) : (f32x4){0.f, 0.f, 0.f, 0.f};
#pragma unroll
    for (int ai = 0; ai < 2; ++ai)
#pragma unroll
        for (int m = 0; m < 4; ++m) { bf16_t* rowp = O + (size_t)(r0 + ai * 128 + m * 16) * ldc + c0;
#pragma unroll
            for (int bj = 0; bj < 2; ++bj) { const f32x4 v0 = acc[ai][bj][m][0] + bv[bj][0], v1 = acc[ai][bj][m][1] + bv[bj][1];
                u32x4 w; w.x = cvt_pk_bf16(v0[0], v0[1]); w.y = cvt_pk_bf16(v0[2], v0[3]); w.z = cvt_pk_bf16(v1[0], v1[1]); w.w = cvt_pk_bf16(v1[2], v1[3]);
                if (NT) __builtin_nontemporal_store(w, (u32x4*)(rowp + bj * 128)); else *(u32x4*)(rowp + bj * 128) = w; } }
}

struct PolDenseBase {
    const bf16_t* A; const bf16_t* Bt; int lda, ldb, K, nM, nN;
    __device__ __forceinline__ int nunits() const { return nM * nN; }
    __device__ __forceinline__ int first() const { return blockIdx.x; }
    __device__ __forceinline__ int stride() const { return gridDim.x; }
    __device__ __forceinline__ void unit(int L, Unit& u) const {
#if DENSE_XCD
        const int nwg = nM * nN; int wgid = L;
        if ((gridDim.x & 7) == 0) { const int q = nwg / 8, r = nwg % 8, xcd = wgid % 8, off = wgid / 8; wgid = (xcd < r ? xcd * (q + 1) : r * (q + 1) + (xcd - r) * q) + off; }
        const int nig = 8 * nN, gid = wgid / nig, fm = gid * 8, gsz = (nM - fm) < 8 ? (nM - fm) : 8;
        u.a = fm + ((wgid % nig) % gsz); u.b = (wgid % nig) / gsz; u.c = 0; u.d = 0;
#else
        if (nM == 64 && gridDim.x == 256) {
            const int x = L & 7, sq = (L >> 8) * 32 + ((L & 255) >> 3), g = sq >> 5, w = sq & 31;
            u.a = x + 8 * (w & 7); u.b = 4 * g + (w >> 3); u.c = 0; u.d = 0;
        } else { u.a = L / nN; u.b = L - u.a * nN; u.c = 0; u.d = 0; }
#endif
    }
    __device__ __forceinline__ const char* abase() const { return (const char*)A; }
    __device__ __forceinline__ void a_off(const Unit& u, const int (&R)[2], const int (&C)[2], unsigned (&off)[2][2]) const {
#pragma unroll
        for (int h = 0; h < 2; ++h)
#pragma unroll
            for (int i = 0; i < 2; ++i) off[h][i] = (unsigned)((u.a * 256 + h * 128 + R[i]) * lda + C[i]) * 2u;
    }
    __device__ __forceinline__ const char* bbase(const Unit& u) const { return (const char*)(Bt + (size_t)u.b * 256 * ldb); }
};
struct PolBf16 : PolDenseBase {
    static constexpr bool PERM = true;
    bf16_t* O; int ldc; const float* bias;
    __device__ __forceinline__ void epi(const f32x4 (&acc)[2][2][4][2], const Unit& u, int wr, int wc, int fr, int fq) const {
        store_bf16_tile<false>(acc, O, ldc, u.a * 256, u.b * 256, bias, u.b * 256, wr, wc, fr, fq);
    }
};
struct PolBf16KV : PolBf16 {
    __device__ __forceinline__ bool rebal() const { return gridDim.x == 256 && nM * nN == 512; }
    __device__ __forceinline__ int nunits() const { return rebal() ? ((int)blockIdx.x < 128 ? 256 : 768) : nM * nN; }
    __device__ __forceinline__ void unit(int L, Unit& u) const {
        if (rebal()) { const int b = L & 255, ui = L >> 8; L = (ui == 0) ? b : 256 + (b - 128) * 2 + (ui - 1); }
        PolDenseBase::unit(L, u);
    }
};
template <bool XIN_BF16>
struct PolResid : PolDenseBase {
    static constexpr bool PERM = true;
    const void* xin; const float* g; bf16_t* xout;
    __device__ __forceinline__ void epi(const f32x4 (&acc)[2][2][4][2], const Unit& u, int wr, int wc, int fr, int fq) const {
        const int row0 = u.a * 256 + wr * 64 + fr, col0 = u.b * 256 + wc * 32 + 8 * fq;
        f32x4 gv[2][2];
#pragma unroll
        for (int bj = 0; bj < 2; ++bj)
#pragma unroll
            for (int n = 0; n < 2; ++n) gv[bj][n] = *(const f32x4*)(g + col0 + bj * 128 + n * 4);
        if (XIN_BF16) {
            u32x4 xw[2][4][2];
#pragma unroll
            for (int ai = 0; ai < 2; ++ai)
#pragma unroll
                for (int m = 0; m < 4; ++m) { const size_t ro = (size_t)(row0 + ai * 128 + m * 16) * D + col0;
#pragma unroll
                    for (int bj = 0; bj < 2; ++bj) xw[ai][m][bj] = *(const u32x4*)((const bf16_t*)xin + ro + bj * 128); }
            __builtin_amdgcn_sched_barrier(0);
#pragma unroll
            for (int ai = 0; ai < 2; ++ai)
#pragma unroll
                for (int m = 0; m < 4; ++m) { const size_t ro = (size_t)(row0 + ai * 128 + m * 16) * D + col0;
#pragma unroll
                    for (int bj = 0; bj < 2; ++bj) { const u32x4 x = xw[ai][m][bj];
                        const f32x4 v0 = (f32x4){bflo(x.x), bfhi(x.x), bflo(x.y), bfhi(x.y)} + gv[bj][0] * acc[ai][bj][m][0], v1 = (f32x4){bflo(x.z), bfhi(x.z), bflo(x.w), bfhi(x.w)} + gv[bj][1] * acc[ai][bj][m][1];
                        u32x4 w; w.x = cvt_pk_bf16(v0[0], v0[1]); w.y = cvt_pk_bf16(v0[2], v0[3]); w.z = cvt_pk_bf16(v1[0], v1[1]); w.w = cvt_pk_bf16(v1[2], v1[3]);
                        *(u32x4*)(xout + ro + bj * 128) = w; } }
            __builtin_amdgcn_sched_barrier(0);
        } else {
#pragma unroll
            for (int ai = 0; ai < 2; ++ai) {
                f32x4 xi[4][2][2];
#pragma unroll
                for (int m = 0; m < 4; ++m) { const size_t ro = (size_t)(row0 + ai * 128 + m * 16) * D + col0;
#pragma unroll
                    for (int bj = 0; bj < 2; ++bj)
#pragma unroll
                        for (int n = 0; n < 2; ++n) xi[m][bj][n] = *(const f32x4*)((const float*)xin + ro + bj * 128 + n * 4); }
                __builtin_amdgcn_sched_barrier(0);
#pragma unroll
                for (int m = 0; m < 4; ++m) { const size_t ro = (size_t)(row0 + ai * 128 + m * 16) * D + col0;
#pragma unroll
                    for (int bj = 0; bj < 2; ++bj) { const f32x4 v0 = xi[m][bj][0] + gv[bj][0] * acc[ai][bj][m][0], v1 = xi[m][bj][1] + gv[bj][1] * acc[ai][bj][m][1];
                        u32x4 w; w.x = cvt_pk_bf16(v0[0], v0[1]); w.y = cvt_pk_bf16(v0[2], v0[3]); w.z = cvt_pk_bf16(v1[0], v1[1]); w.w = cvt_pk_bf16(v1[2], v1[3]);
                        *(u32x4*)(xout + ro + bj * 128) = w; } }
                __builtin_amdgcn_sched_barrier(0);
            }
        }
    }
};
struct PolRouter {
    static constexpr bool PERM = false;
    const bf16_t* A; const bf16_t* Bt; float* part; int K, ldb;
    __device__ __forceinline__ int nunits() const { return 64 * 4; }
    __device__ __forceinline__ int first() const { return blockIdx.x; }
    __device__ __forceinline__ int stride() const { return gridDim.x; }
    __device__ __forceinline__ void unit(int L, Unit& u) const { u.a = L >> 2; u.b = L & 3; u.c = 0; u.d = 0; }
    __device__ __forceinline__ const char* abase() const { return (const char*)A; }
    __device__ __forceinline__ void a_off(const Unit& u, const int (&R)[2], const int (&C)[2], unsigned (&off)[2][2]) const {
#pragma unroll
        for (int h = 0; h < 2; ++h)
#pragma unroll
            for (int i = 0; i < 2; ++i) off[h][i] = (unsigned)((u.a * 256 + h * 128 + R[i]) * 2048 + u.b * 512 + C[i]) * 2u;
    }
    __device__ __forceinline__ const char* bbase(const Unit& u) const { return (const char*)(Bt + (size_t)u.b * 512); }
    __device__ __forceinline__ void epi(const f32x4 (&acc)[2][2][4][2], const Unit& u, int wr, int wc, int fr, int fq) const {
        const int row0 = u.a * 256 + wr * 64 + fr, col0 = wc * 32 + 4 * fq;
        float* P = part + (size_t)u.b * T * 128;
#pragma unroll
        for (int ai = 0; ai < 2; ++ai)
#pragma unroll
            for (int m = 0; m < 4; ++m)
#pragma unroll
                for (int n = 0; n < 2; ++n) *(f32x4*)(P + (size_t)(row0 + ai * 128 + m * 16) * 128 + col0 + n * 16) = acc[ai][0][m][n];
    }
};
struct MoeTab { const LAS int* blk_e; const LAS int* blk_row0; int rb0, nrb, rank, nrank; };
__device__ __forceinline__ void moe_decode(const MoeTab& tb, int j, int NT, Unit& u) {
    const int rbl = j / NT, pn = j - rbl * NT, rb = tb.rb0 + rbl;
    u.a = tb.blk_row0[rb]; u.b = pn; u.c = tb.blk_e[rb]; u.d = 0;
}
struct PolGateUp {
    static constexpr bool PERM = true;
    const bf16_t* A; const bf16_t* W; const int* rowtok; bf16_t* act; MoeTab tb; int K, ldb; const LAS int* ridx;
    __device__ __forceinline__ int nunits() const { return tb.nrb * 2; }
    __device__ __forceinline__ int first() const { return tb.rank; }
    __device__ __forceinline__ int stride() const { return tb.nrank; }
    __device__ __forceinline__ void unit(int L, Unit& u) const { moe_decode(tb, L, 2, u); u.d = (L - tb.rank) / tb.nrank; }
    __device__ __forceinline__ const char* abase() const { return (const char*)A; }
    __device__ __forceinline__ void a_off(const Unit& u, const int (&R)[2], const int (&C)[2], unsigned (&off)[2][2]) const {
#pragma unroll
        for (int h = 0; h < 2; ++h)
#pragma unroll
            for (int i = 0; i < 2; ++i) { const int tok = (u.d < 8) ? ridx[u.d * 256 + h * 128 + R[i]] : rowtok[u.a + h * 128 + R[i]]; off[h][i] = (unsigned)(tok * 2048 + C[i]) * 2u; }
    }
    __device__ __forceinline__ const char* bbase(const Unit& u) const { return (const char*)(W + ((size_t)u.c * 512 + (size_t)u.b * 256) * 2048); }
    __device__ __forceinline__ void epi(const f32x4 (&acc)[2][2][4][2], const Unit& u, int wr, int wc, int fr, int fq) const {
        const int r0 = u.a + wr * 64 + fr, c0 = u.b * 128 + wc * 32 + 8 * fq;
#pragma unroll
        for (int ai = 0; ai < 2; ++ai)
#pragma unroll
            for (int m = 0; m < 4; ++m) {
                float o[8];
#pragma unroll
                for (int n = 0; n < 2; ++n)
#pragma unroll
                    for (int e = 0; e < 4; ++e) { const float gt = acc[ai][0][m][n][e], up = acc[ai][1][m][n][e]; o[n * 4 + e] = gt * __builtin_amdgcn_rcpf(1.0f + __expf(-gt)) * up; }
                u32x4 w; w.x = cvt_pk_bf16(o[0], o[1]); w.y = cvt_pk_bf16(o[2], o[3]); w.z = cvt_pk_bf16(o[4], o[5]); w.w = cvt_pk_bf16(o[6], o[7]);
                *(u32x4*)(act + (size_t)(r0 + ai * 128 + m * 16) * 256 + c0) = w; }
    }
};
constexpr float Y_SCALE = 8.0f;
struct PolDown {
    static constexpr bool PERM = true;
    const bf16_t* A; const bf16_t* W; unsigned char* Y; MoeTab tb; int K, ldb; int nostore;
    __device__ __forceinline__ int nunits() const { return tb.nrb * 8; }
    __device__ __forceinline__ int first() const { return tb.rank; }
    __device__ __forceinline__ int stride() const { return tb.nrank; }
    __device__ __forceinline__ void unit(int L, Unit& u) const { moe_decode(tb, L, 8, u); }
    __device__ __forceinline__ const char* abase() const { return (const char*)A; }
    __device__ __forceinline__ void a_off(const Unit& u, const int (&R)[2], const int (&C)[2], unsigned (&off)[2][2]) const {
#pragma unroll
        for (int h = 0; h < 2; ++h)
#pragma unroll
            for (int i = 0; i < 2; ++i) off[h][i] = (unsigned)((u.a + h * 128 + R[i]) * 256 + C[i]) * 2u;
    }
    __device__ __forceinline__ const char* bbase(const Unit& u) const { return (const char*)(W + ((size_t)u.c * 2048 + (size_t)u.b * 256) * 256); }
    __device__ __forceinline__ void epi(const f32x4 (&acc)[2][2][4][2], const Unit& u, int wr, int wc, int fr, int fq) const {
        const int odd = fq & 1, pq = fq >> 1;
#pragma unroll
        for (int ai = 0; ai < 2; ++ai)
#pragma unroll
            for (int bj = 0; bj < 2; ++bj) {
                int D[4][2];
#pragma unroll
                for (int m = 0; m < 4; ++m)
#pragma unroll
                    for (int n = 0; n < 2; ++n) { const f32x4 v = acc[ai][bj][m][n] * Y_SCALE; int w_ = __builtin_amdgcn_cvt_pk_fp8_f32(v[0], v[1], 0, false); D[m][n] = __builtin_amdgcn_cvt_pk_fp8_f32(v[2], v[3], w_, true); }
#pragma unroll
                for (int pr = 0; pr < 2; ++pr) {
                    const int s0 = odd ? D[2 * pr][0] : D[2 * pr + 1][0], s1 = odd ? D[2 * pr][1] : D[2 * pr + 1][1];
                    const int r0 = __builtin_amdgcn_ds_swizzle(s0, 0x401F), r1 = __builtin_amdgcn_ds_swizzle(s1, 0x401F);
                    u32x4 w;
                    if (odd) { w.x = (unsigned)r0; w.y = (unsigned)r1; w.z = (unsigned)D[2 * pr + 1][0]; w.w = (unsigned)D[2 * pr + 1][1]; }
                    else { w.x = (unsigned)D[2 * pr][0]; w.y = (unsigned)D[2 * pr][1]; w.z = (unsigned)r0; w.w = (unsigned)r1; }
                    const int row = u.a + ai * 128 + wr * 64 + (2 * pr + odd) * 16 + fr, col = u.b * 256 + bj * 128 + wc * 32 + pq * 16;
                    if (!nostore) { if (NT_STORES) __builtin_nontemporal_store(w, (u32x4*)(Y + (size_t)row * 2048 + col)); else *(u32x4*)(Y + (size_t)row * 2048 + col) = w; } else asm volatile("" :: "v"(w));
                }
            }
    }
};


__device__ __forceinline__ void ph_route(const Frame& F, int layer) {
    const float* part = WSP(float, WS_LOGP); const float* rbias = F.in[18] + layer * 64;
    int* tki = WSP(int, WS_TKI); float* tkw = WSP(float, WS_TKW); int* hist = WSP(int, WS_HIST);
    LAS int* lh = (LAS int*)F.aux;
    const int lane = F.lane; const int g = lane >> 3;
    const float bia = rbias[lane];
    for (int tb = F.bid; tb < 256; tb += F.G) {
        if (F.tid < 64) lh[F.tid] = 0;
        __syncthreads();
        float pv[8][8];
#pragma unroll
        for (int ti = 0; ti < 8; ++ti) { const int t = tb * 64 + F.wid * 8 + ti;
#pragma unroll
            for (int ks = 0; ks < 4; ++ks) { const float* pr = part + ((size_t)ks * T + t) * 128; pv[ti][2 * ks] = pr[lane]; pv[ti][2 * ks + 1] = pr[64 + lane]; } }
#pragma unroll
        for (int ti = 0; ti < 8; ++ti) {
            const int t = tb * 64 + F.wid * 8 + ti;
            float logit = 0.f;
#pragma unroll
            for (int ks = 0; ks < 4; ++ks) logit += pv[ti][2 * ks] + pv[ti][2 * ks + 1];
            const float score = 1.0f / (1.0f + expf(-logit));
            const float biased = score + bia;
            const float m1 = grp8_max(biased);
            const unsigned long long eqm = __ballot(biased == m1);
            const unsigned long long gm = eqm & (0xFFull << (8 * g));
            const int first = __builtin_ctzll(gm);
            const float v2 = grp8_max((lane == first) ? -__builtin_inff() : biased);
            const float gs = m1 + v2;
            int cnt = 0;
#pragma unroll
            for (int gg = 0; gg < 8; ++gg) { const float o = __int_as_float(__builtin_amdgcn_readlane(__float_as_int(gs), 8 * gg)); cnt += ((o > gs) || (o == gs && gg < g)) ? 1 : 0; }
            const bool sel = cnt < 4;
            const float masked = sel ? biased : -__builtin_inff();
            int rank = 64; float cur = masked;
#pragma unroll
            for (int r = 0; r < 8; ++r) {
                float mx = dpp_max<0xB1>(cur); mx = dpp_max<0x4E>(mx); mx = dpp_max<0x141>(mx); mx = dpp_max<0x140>(mx);
                mx = fmaxf(mx, __int_as_float(__builtin_amdgcn_ds_swizzle(__float_as_int(mx), 0x401F)));
                mx = fmaxf(__int_as_float(__builtin_amdgcn_readlane(__float_as_int(mx), 0)), __int_as_float(__builtin_amdgcn_readlane(__float_as_int(mx), 32)));
                const int win = __builtin_ctzll(__ballot(cur == mx));
                if (lane == win) { rank = r; cur = -__builtin_inff(); }
            }
            const bool chosen = sel && rank < 8;
            const float wsum = wave_sum(chosen ? score : 0.f);
            if (chosen) { tki[t * 8 + rank] = lane; tkw[t * 8 + rank] = score / wsum * 2.5f; (void)__hip_atomic_fetch_add(lh + lane, 1, __ATOMIC_RELAXED, __HIP_MEMORY_SCOPE_WORKGROUP); }
        }
        __syncthreads();
        if (F.tid < 64) hist[tb * 64 + F.tid] = lh[F.tid];
        __syncthreads();
    }
}

__device__ __forceinline__ void ph_dispatch(const Frame& F) {
    const int* hist = WSP(int, WS_HIST); const int* tki = WSP(int, WS_TKI);
    int* pslot = WSP(int, WS_PSLOT); int* rowtok = WSP(int, WS_ROWTOK); int* etab = WSP(int, WS_ETAB);
    LAS int* tot = (LAS int*)F.aux; LAS int* pre = tot + 64; LAS int* eoff = tot + 128; LAS int* cursor = tot + 192;
    LAS int* ps = tot + 256;
    LAS int* wc = tot + 1280;
    for (int tb = F.bid; tb < 256; tb += F.G) {
        __syncthreads();
        {
            const int e = F.tid & 63, gq = F.tid >> 6;
            int hv[32];
#pragma unroll
            for (int b = 0; b < 32; ++b) hv[b] = hist[(gq * 32 + b) * 64 + e];
            int s_ = 0, p_ = 0;
#pragma unroll
            for (int b = 0; b < 32; ++b) { s_ += hv[b]; p_ += (gq * 32 + b < tb) ? hv[b] : 0; }
            ps[gq * 64 + e] = s_; ps[512 + gq * 64 + e] = p_; wc[F.tid] = 0;
        }
        __syncthreads();
        if (F.tid < 64) { int s_ = 0, p_ = 0;
#pragma unroll
            for (int q = 0; q < 8; ++q) { s_ += ps[q * 64 + F.tid]; p_ += ps[512 + q * 64 + F.tid]; }
            tot[F.tid] = s_; pre[F.tid] = p_;
            const int pad = (s_ + 255) & ~255; const int off = T + wave_incl_scan(pad, F.tid) - pad;
            eoff[F.tid] = off; cursor[F.tid] = off + p_;
            if (tb == 0) { etab[F.tid] = off; etab[64 + F.tid] = s_; } }
        { const int t = tb * 64 + (F.tid >> 3), k = F.tid & 7; const int e = tki[t * 8 + k];
          int rnk = 0;
#pragma unroll 8
          for (int l = 0; l < 64; ++l) { const int o = __builtin_amdgcn_readlane(e, l); rnk += (o == e && l < F.lane) ? 1 : 0; }
          (void)__hip_atomic_fetch_add(wc + F.wid * 64 + e, 1, __ATOMIC_RELAXED, __HIP_MEMORY_SCOPE_WORKGROUP);
          __syncthreads();
          for (int w = 0; w < F.wid; ++w) rnk += wc[w * 64 + e];
          const int slot = cursor[e] + rnk; rowtok[slot] = t; pslot[t * 8 + k] = slot; }
        if (F.tid < 64) rowtok[tb * 64 + F.tid] = tb * 64 + F.tid;
        if (tb < 64) { const int e = tb; const int beg = eoff[e] + tot[e], end = eoff[e] + ((tot[e] + 255) & ~255); for (int s = beg + F.tid; s < end; s += NTHREADS) rowtok[s] = 0; }
        __syncthreads();
    }
}

__device__ __forceinline__ MoeTab moe_tables(const Frame& F) {
    const int* etab = WSP(int, WS_ETAB);
    LAS int* blk_e = (LAS int*)F.aux; LAS int* blk_row0 = blk_e + 640; LAS int* pre = blk_e + 1280;
    __syncthreads();
    if (F.tid < 64) { blk_e[F.tid] = 64; blk_row0[F.tid] = F.tid * 256; }
    if (F.tid < 64) { const int nb_ = (etab[64 + F.tid] + 255) >> 8, inc = wave_incl_scan(nb_, F.tid); pre[F.tid] = inc - nb_; if (F.tid == 63) pre[64] = inc; }
    __syncthreads();
    if (F.tid < 64) { const int e = F.tid, nb = (etab[64 + e] + 255) >> 8, b0 = 64 + pre[e], r0 = etab[e]; for (int i = 0; i < nb; ++i) { blk_e[b0 + i] = e; blk_row0[b0 + i] = r0 + i * 256; } }
    __syncthreads();
    const int nblk = 64 + pre[64];
    const int ng = ((F.G & 7) == 0) ? 8 : 1, x = F.bid % ng;
    MoeTab tb; tb.blk_e = blk_e; tb.blk_row0 = blk_row0;
    tb.rb0 = (int)(((long)nblk * x) / ng); tb.nrb = (int)(((long)nblk * (x + 1)) / ng) - tb.rb0; tb.rank = F.bid / ng; tb.nrank = F.G / ng;
    return tb;
}

#define SBAR() __builtin_amdgcn_sched_barrier(0)
__device__ __forceinline__ int v_st(int k, int c) { const int kk = (k & ~0xC) | ((k & 4) << 1) | ((k & 8) >> 1); return ((kk >> 3) * 4 + (c >> 5)) * 512 + ((kk & 7) * 32 + (c & 31)) * 2; }
__device__ __forceinline__ int v_rd_base(int lane) { return ((lane & 3) << 3) | (((lane >> 2) & 3) << 6) | (((lane >> 4) & 1) << 5) | (((lane >> 5) & 1) << 8); }
constexpr int v_rd_off(int d0, int ks, int half) { return d0 * 512 + ks * 4096 + half * 2048; }
__device__ __forceinline__ int crow(int r, int hi) { return (r & 3) + 8 * (r >> 2) + 4 * hi; }
template <int OFF> __device__ __forceinline__ s16x4 trrd(int base) { s16x4 d; asm volatile("ds_read_b64_tr_b16 %0, %1 offset:%2" : "=&v"(d) : "v"(base), "i"(OFF) : "memory"); return d; }
#define LGKM0() asm volatile("s_waitcnt lgkmcnt(0)" ::: "memory")
#define ROPE2(W0, W1, CS, O0, O1) do { const float a0 = bflo(W0), a1 = bfhi(W0), b0_ = bflo(W1), b1_ = bfhi(W1); \
    O0 = cvt_pk_bf16(a0 * CS[0] - b0_ * CS[1], a1 * CS[2] - b1_ * CS[3]); O1 = cvt_pk_bf16(b0_ * CS[0] + a0 * CS[1], b1_ * CS[2] + a1 * CS[3]); } while (0)
__device__ __forceinline__ bf16x8 cat44(s16x4 l, s16x4 h) { return (bf16x8){l[0], l[1], l[2], l[3], h[0], h[1], h[2], h[3]}; }

__device__ __forceinline__ void mask_tile(f32x16& p0, f32x16& p1, int dq, unsigned W) {
    const float NEG = -__builtin_inff();
#pragma unroll
    for (int r = 0; r < 16; ++r) {
        const int c = (r & 3) + 8 * (r >> 2);
        if ((unsigned)(dq - c) >= W) p0[r] = NEG;
        if ((unsigned)(dq - c - 32) >= W) p1[r] = NEG;
    }
}
__device__ __forceinline__ float softmax_tile(f32x16& p0, f32x16& p1, float& m_reg, float& l_reg, float C2, bf16x8& pa0, bf16x8& pa1, bf16x8& pa2, bf16x8& pa3) {
    float pmax = p0[0];
#pragma unroll
    for (int r = 1; r < 16; ++r) pmax = fmaxf(pmax, p0[r]);
#pragma unroll
    for (int r = 0; r < 16; ++r) pmax = fmaxf(pmax, p1[r]);
    { auto rr = __builtin_amdgcn_permlane32_swap(__float_as_uint(pmax), __float_as_uint(pmax), false, false);
      pmax = fmaxf(__uint_as_float(rr[0]), __uint_as_float(rr[1])); }
    float mn, alpha;
    if (__all((pmax - m_reg) * C2 <= 11.5f)) { mn = m_reg; alpha = 1.f; }
    else { mn = fmaxf(m_reg, pmax); alpha = __builtin_amdgcn_exp2f((m_reg - mn) * C2); m_reg = mn; }
    const float mnL = -mn * C2;
    float ps = 0.f;
#pragma unroll
    for (int r = 0; r < 16; ++r) { p0[r] = __builtin_amdgcn_exp2f(fmaf(p0[r], C2, mnL)); ps += p0[r]; }
#pragma unroll
    for (int r = 0; r < 16; ++r) { p1[r] = __builtin_amdgcn_exp2f(fmaf(p1[r], C2, mnL)); ps += p1[r]; }
    { auto rr = __builtin_amdgcn_permlane32_swap(__float_as_uint(ps), __float_as_uint(ps), false, false);
      ps = __uint_as_float(rr[0]) + __uint_as_float(rr[1]); }
    l_reg = l_reg * alpha + ps;
#define PK4(P, B_, OUT) do { unsigned a0 = cvt_pk_bf16(P[B_+0], P[B_+1]), a1 = cvt_pk_bf16(P[B_+2], P[B_+3]);                          \
        unsigned b0 = cvt_pk_bf16(P[B_+4], P[B_+5]), b1 = cvt_pk_bf16(P[B_+6], P[B_+7]);                                             \
        auto r0 = __builtin_amdgcn_permlane32_swap(a0, b0, false, false); auto r1 = __builtin_amdgcn_permlane32_swap(a1, b1, false, false); \
        u32x4 w = {r0[0], r1[0], r0[1], r1[1]}; OUT = *reinterpret_cast<bf16x8*>(&w); } while (0)
    PK4(p0, 0, pa0); PK4(p0, 8, pa1); PK4(p1, 0, pa2); PK4(p1, 8, pa3);
    return alpha;
}
template <int VOFF, int ND0, int KG = 2048>
__device__ __forceinline__ void pv_tile(f32x16* o, int vb, bf16x8 pa0, bf16x8 pa1, bf16x8 pa2, bf16x8 pa3) {
#define PV_D0(d0) do { s16x4 l0, l1, l2, l3, h0, h1, h2, h3; constexpr int b_ = VOFF + d0 * 512; \
        l0 = trrd<b_>(vb); h0 = trrd<b_ + KG>(vb); l1 = trrd<b_ + 2 * KG>(vb); h1 = trrd<b_ + 3 * KG>(vb); l2 = trrd<b_ + 4 * KG>(vb); h2 = trrd<b_ + 5 * KG>(vb); l3 = trrd<b_ + 6 * KG>(vb); h3 = trrd<b_ + 7 * KG>(vb); \
        LGKM0(); SBAR(); \
        o[d0] = __builtin_amdgcn_mfma_f32_32x32x16_bf16(pa0, cat44(l0, h0), o[d0], 0, 0, 0); \
        o[d0] = __builtin_amdgcn_mfma_f32_32x32x16_bf16(pa1, cat44(l1, h1), o[d0], 0, 0, 0); \
        o[d0] = __builtin_amdgcn_mfma_f32_32x32x16_bf16(pa2, cat44(l2, h2), o[d0], 0, 0, 0); \
        o[d0] = __builtin_amdgcn_mfma_f32_32x32x16_bf16(pa3, cat44(l3, h3), o[d0], 0, 0, 0); } while (0)
    PV_D0(0); PV_D0(1);
    if (ND0 > 2) { PV_D0(2); PV_D0(3); }
#undef PV_D0
}

template <int DQK, int DV, int D2>
struct AttnBlk {
    static constexpr int RB = DQK * 2, KBYTES = 64 * RB, VBYTES = 16384, KOFF = 0, VOFF = 2 * KBYTES, SOFF = VOFF + 3 * VBYTES;
    static constexpr int NC = DQK / 16, ND0 = DV / 32, KPIECES = 64 * DQK / 8, KPT = KPIECES / NTHREADS, VPIECES = 64 * DV / 8, VPT = (VPIECES + NTHREADS - 1) / NTHREADS, PPR = DQK / 8, VPR = DV / 8;
    const bf16_t* Q; int ldq; const bf16_t* K1; int ldk1; const bf16_t* K2; int ldk2; const bf16_t* V; int ldv; bf16_t* O; int ldo;
    float C2; float m_init; float l_init; unsigned W;
    int wrow; int wq; int wo; const float* sinks; float sink_scale; const float2* ropeq;

    struct StageOffs { unsigned ko[KPT]; unsigned vo[1]; };
    __device__ __forceinline__ void stage_setup(StageOffs& so_, int tid) const {
#pragma unroll
        for (int i = 0; i < KPT; ++i) { const int p = tid + NTHREADS * i, row = p / PPR, sp = p - row * PPR;
            const int pc = (sp & ~7) | ((sp ^ (row >> 1)) & 7);
            const bool k1 = (D2 == 0 || pc < (DQK - D2) / 8);
            so_.ko[i] = k1 ? (unsigned)(row * ldk1 + pc * 8) * 2u : ((unsigned)(row * ldk2 + (pc - (DQK - D2) / 8) * 8) * 2u) | 0x80000000u; }
        { const int p = tid;
            const int off = p * 16, sub = off >> 9, g8 = sub >> 2, cblk = sub & 3, rem = (off & 511) >> 1, kkl = rem >> 5, cl = rem & 31;
            const int kk = g8 * 8 + kkl, k = (kk & ~0xC) | ((kk & 4) << 1) | ((kk & 8) >> 1), c = cblk * 32 + cl;
            so_.vo[0] = (unsigned)(k * ldv + c) * 2u; }
    }
    __device__ __forceinline__ void stage_tile(LAS unsigned char* lds, int kbuf, int vbuf, int kb, const StageOffs& so_, int tid, int wid) const {
        const char* kb1 = (const char*)(K1 + (size_t)kb * ldk1); const char* kb2 = (const char*)(K2 + (size_t)kb * ldk2); const char* vbp = (const char*)(V + (size_t)kb * ldv);
#pragma unroll
        for (int i = 0; i < KPT; ++i) {
            const unsigned o_ = so_.ko[i]; LAS unsigned* dst_ = (LAS unsigned*)(lds + KOFF + kbuf * KBYTES + (NTHREADS * i + 64 * wid) * 16);
            if (D2 == 0 || !(o_ >> 31)) __builtin_amdgcn_global_load_lds((const unsigned*)(kb1 + o_), dst_, 16, 0, 0);
            else __builtin_amdgcn_global_load_lds((const unsigned*)(kb2 + (o_ & 0x7fffffffu)), dst_, 16, 0, 0); }
#pragma unroll
        for (int i = 0; i < VPT; ++i) { const int p = tid + NTHREADS * i;
            if (VPIECES >= NTHREADS * (i + 1) || p < VPIECES)
                __builtin_amdgcn_global_load_lds((const unsigned*)(vbp + (size_t)i * 32 * ldv * 2 + so_.vo[0]), (LAS unsigned*)(lds + VOFF + vbuf * VBYTES + (NTHREADS * i + 64 * wid) * 16), 16, 0, 0); }
    }
    __device__ __forceinline__ void run(LAS unsigned char* lds, int P0, int j_lo, int j_hi) const {
        const int tid = threadIdx.x, wid = __builtin_amdgcn_readfirstlane(tid >> 6), lane = tid & 63, r32 = lane & 31, hi = lane >> 5;
        const int qlo = P0 + wid * 32, qm = qlo + r32 - 4 * hi;
        const bool grpB = ATT_STAGGER && wid >= 4;
        LAS float* ws = (LAS float*)(lds + SOFF) + wid * 64; LAS float* li_l = ws; LAS float* al_l = ws + 32;
        bf16x8 qr[NC];
#pragma unroll
        for (int c = 0; c < NC; ++c) qr[c] = *(const bf16x8*)(Q + (size_t)(qlo + r32) * ldq + c * 16 + hi * 8);
        if (NC == 12 && ropeq) {
            const float2* rp = ropeq + (size_t)(qlo + r32) * 32 + hi * 8;
#pragma unroll
            for (int cc = 0; cc < 2; ++cc) {
                const f32x4* cs = (const f32x4*)(rp + cc * 16);
                const f32x4 c0 = cs[0], c1 = cs[1], c2 = cs[2], c3 = cs[3];
                const u32x4 a = __builtin_bit_cast(u32x4, qr[(NC == 12 ? 8 : 0) + cc]), b = __builtin_bit_cast(u32x4, qr[(NC == 12 ? 10 : 0) + cc]);
                u32x4 ra, rb_;
                ROPE2(a.x, b.x, c0, ra.x, rb_.x); ROPE2(a.y, b.y, c1, ra.y, rb_.y); ROPE2(a.z, b.z, c2, ra.z, rb_.z); ROPE2(a.w, b.w, c3, ra.w, rb_.w);
                qr[(NC == 12 ? 8 : 0) + cc] = __builtin_bit_cast(bf16x8, ra); qr[(NC == 12 ? 10 : 0) + cc] = __builtin_bit_cast(bf16x8, rb_);
            }
        }
        float m_reg = m_init, l_reg = l_init; f32x16 o[ND0];
#pragma unroll
        for (int d = 0; d < ND0; ++d) o[d] = f32x16{};
        const int vb0 = (int)(uintptr_t)(lds + VOFF) + v_rd_base(lane);
        const LAS unsigned char* kb4[4];
#pragma unroll
        for (int cl = 0; cl < 4; ++cl) kb4[cl] = lds + KOFF + r32 * RB + ((cl * 32 + hi * 16) ^ (((r32 >> 1) & 7) << 4));
        f32x16 p0, p1; bf16x8 pa0, pa1, pa2, pa3; float alpha = 1.f;
#define ATT_QK(kbuf_) do { \
            _Pragma("unroll") for (int g = 0; g < NC / 4; ++g) { bf16x8 b0[4], b1[4]; \
                _Pragma("unroll") for (int cl = 0; cl < 4; ++cl) { b0[cl] = *(const LAS bf16x8*)(kb4[cl] + (kbuf_) * KBYTES + g * 128); b1[cl] = *(const LAS bf16x8*)(kb4[cl] + (kbuf_) * KBYTES + g * 128 + 32 * RB); } \
                SBAR(); \
                _Pragma("unroll") for (int cl = 0; cl < 4; ++cl) { \
                    if (g == 0 && cl == 0) { p0 = __builtin_amdgcn_mfma_f32_32x32x16_bf16(b0[cl], qr[0], (f32x16){0.f,0.f,0.f,0.f,0.f,0.f,0.f,0.f,0.f,0.f,0.f,0.f,0.f,0.f,0.f,0.f}, 0, 0, 0); \
                                             p1 = __builtin_amdgcn_mfma_f32_32x32x16_bf16(b1[cl], qr[0], (f32x16){0.f,0.f,0.f,0.f,0.f,0.f,0.f,0.f,0.f,0.f,0.f,0.f,0.f,0.f,0.f,0.f}, 0, 0, 0); } \
                    else { p0 = __builtin_amdgcn_mfma_f32_32x32x16_bf16(b0[cl], qr[g * 4 + cl], p0, 0, 0, 0); \
                           p1 = __builtin_amdgcn_mfma_f32_32x32x16_bf16(b1[cl], qr[g * 4 + cl], p1, 0, 0, 0); } } \
                SBAR(); } } while (0)
#define ATT_SM(kb_) do { if ((kb_) + 63 > qlo || (kb_) + (int)W <= qlo + 31) mask_tile(p0, p1, qm - (kb_), W); \
            alpha = softmax_tile(p0, p1, m_reg, l_reg, C2, pa0, pa1, pa2, pa3); } while (0)
#define ATT_PV(vbuf_) do { if (__any(alpha < 1.f)) { if (hi == 0) al_l[r32] = alpha; LGKM0(); \
                _Pragma("unroll") for (int d = 0; d < ND0; ++d) _Pragma("unroll") for (int r = 0; r < 16; ++r) o[d][r] *= al_l[crow(r, hi)]; } \
            if ((vbuf_) == 0) pv_tile<0, ND0>(o, vb0, pa0, pa1, pa2, pa3); else if ((vbuf_) == 1) pv_tile<VBYTES, ND0>(o, vb0, pa0, pa1, pa2, pa3); else pv_tile<2 * VBYTES, ND0>(o, vb0, pa0, pa1, pa2, pa3); } while (0)
        __syncthreads();
        StageOffs SO; stage_setup(SO, tid);
        stage_tile(lds, 0, 0, j_lo * 64, SO, tid, wid);
        asm volatile("s_waitcnt vmcnt(0)" ::: "memory");
        __syncthreads();
        const int NT = j_hi - j_lo;
#if ATT_STAGGER
        {
        int vcur = 0;
        for (int t = 0; t < NT; ++t) {
            const int kbuf = t & 1, kb = (j_lo + t) * 64;
            const int vnext = (vcur == 2) ? 0 : vcur + 1;
            if (t + 1 < NT) stage_tile(lds, kbuf ^ 1, vnext, kb + 64, SO, tid, wid);
            ATT_QK(kbuf); ATT_SM(kb);
            if (grpB) { asm volatile("s_waitcnt vmcnt(0)" ::: "memory"); __syncthreads(); }
            ATT_PV(vcur);
            if (!grpB) { asm volatile("s_waitcnt vmcnt(0)" ::: "memory"); __syncthreads(); }
            vcur = vnext;
        } }
#else
        for (int t = 0; t < NT; ++t) {
            const int kbuf = t & 1, kb = (j_lo + t) * 64;
            if (t + 1 < NT) stage_tile(lds, kbuf ^ 1, kbuf ^ 1, kb + 64, SO, tid, wid);
            if (kb <= qlo + 31) {
            ATT_QK(kbuf); ATT_SM(kb);
            if (__any(alpha < 1.f)) { if (hi == 0) al_l[r32] = alpha; LGKM0();
#pragma unroll
                for (int d = 0; d < ND0; ++d)
#pragma unroll
                    for (int r = 0; r < 16; ++r) o[d][r] *= al_l[crow(r, hi)]; }
            if (kbuf == 0) pv_tile<0, ND0>(o, vb0, pa0, pa1, pa2, pa3); else pv_tile<VBYTES, ND0>(o, vb0, pa0, pa1, pa2, pa3);
            }
            asm volatile("s_waitcnt vmcnt(0)" ::: "memory");
            __syncthreads();
        }
#endif
#undef ATT_QK
#undef ATT_SM
#undef ATT_PV
        if (hi == 0) li_l[r32] = l_reg; LGKM0();
        int hi_o = hi, r32_o = r32; asm volatile("" : "+v"(hi_o), "+v"(r32_o));
        bf16_t* Ow = O + (size_t)qlo * ldo;
#pragma unroll
        for (int r = 0; r < 16; ++r) { const int orow = crow(r, hi_o); const float rl = 1.0f / li_l[orow];
#pragma unroll
            for (int d = 0; d < ND0; ++d) { const float v = o[d][r] * rl; const float vn = __int_as_float(__builtin_amdgcn_update_dpp(0, __float_as_int(v), 0xB1, 0xF, 0xF, true));
                if ((r32_o & 1) == 0) *(unsigned*)(Ow + (size_t)orow * ldo + d * 32 + r32_o) = cvt_pk_bf16(v, vn); } }
    }
};

__device__ __forceinline__ int v_st64(int k, int c) { const int kk = (k & ~0xC) | ((k & 4) << 1) | ((k & 8) >> 1); return ((kk >> 3) * 2 + (c >> 5)) * 512 + ((kk & 7) * 32 + (c & 31)) * 2; }
__device__ __forceinline__ void ph_swa(const Frame& F) {
    const bf16_t* qkv = WSP(bf16_t, WS_PROJ); bf16_t* hcat = WSP(bf16_t, WS_HCAT); const float* sinks = F.in[15];
    LAS unsigned char* lds = F.lds;
    constexpr int KT = 8192, VT = 8192, VBASE = 6 * KT, SCR = VBASE + 6 * VT;
    const int tid = F.tid, wid = F.wid, lane = F.lane, r32 = lane & 31, hi = lane >> 5;
    const float C2 = 0.125f * 1.4426950408889634f;
    LAS float* ws = (LAS float*)(lds + SCR) + wid * 64; LAS float* li_l = ws; LAS float* al_l = ws + 32;
    const LAS unsigned char* kb4[4];
#pragma unroll
    for (int cl = 0; cl < 4; ++cl) kb4[cl] = lds + r32 * 128 + ((cl * 32 + hi * 16) ^ (((r32 >> 1) & 7) << 4));
    const int vbase = (int)(uintptr_t)(lds + VBASE) + v_rd_base(lane);
    for (int U = F.bid; U < 256; U += F.G) {
        const int hkv = U & 3, P0 = (U >> 2) * 256;
        const int tile0 = (P0 >> 6) - 2 < 0 ? 0 : (P0 >> 6) - 2, ntl = (P0 >> 6) + 4 - tile0;
        __syncthreads();
        { int tq = tid; asm volatile("" : "+v"(tq));
          const float2* rope = WSP(float2, WS_ROPE);
#pragma unroll
          for (int i = 0; i < 3; ++i) { const int q = tq + NTHREADS * i, key = q >> 2, pc = q & 3;
              if (key < ntl * 64) { const int tl = key >> 6, row = key & 63; const int kabs = tile0 * 64 + key; const size_t g = (size_t)kabs * 2560;
                  const u32x4 k0 = *(const u32x4*)(qkv + g + 2048 + 64 * hkv + pc * 8), k1 = *(const u32x4*)(qkv + g + 2048 + 64 * hkv + 32 + pc * 8);
                  const u32x4 v0 = *(const u32x4*)(qkv + g + 2304 + 64 * hkv + pc * 8), v1 = *(const u32x4*)(qkv + g + 2304 + 64 * hkv + 32 + pc * 8);
                  const f32x4 c0 = *(const f32x4*)(rope + (size_t)kabs * 32 + pc * 8), c1 = *(const f32x4*)(rope + (size_t)kabs * 32 + pc * 8 + 2), c2 = *(const f32x4*)(rope + (size_t)kabs * 32 + pc * 8 + 4), c3 = *(const f32x4*)(rope + (size_t)kabs * 32 + pc * 8 + 6);
                  u32x4 r0, r1;
                  ROPE2(k0.x, k1.x, c0, r0.x, r1.x); ROPE2(k0.y, k1.y, c1, r0.y, r1.y); ROPE2(k0.z, k1.z, c2, r0.z, r1.z); ROPE2(k0.w, k1.w, c3, r0.w, r1.w);
                  *(LAS u32x4*)(lds + tl * KT + row * 128 + ((pc * 16) ^ (((row >> 1) & 7) << 4))) = r0;
                  *(LAS u32x4*)(lds + tl * KT + row * 128 + (((pc + 4) * 16) ^ (((row >> 1) & 7) << 4))) = r1;
                  *(LAS u32x4*)(lds + VBASE + tl * VT + v_st64(row, pc * 8)) = v0;
                  *(LAS u32x4*)(lds + VBASE + tl * VT + v_st64(row, 32 + pc * 8)) = v1; } } }
        __syncthreads();
        const int hq = hkv * 8 + wid;
        const float m0 = sinks[hq] * 8.0f;
        const float2* rope = WSP(float2, WS_ROPE);
        u32x4 qn[4]; f32x4 cn[2][4];
#define SWA_LDQ(rb_) do { const int ql_ = P0 + 32 * (rb_); \
            _Pragma("unroll") for (int c = 0; c < 4; ++c) qn[c] = *(const u32x4*)(qkv + (size_t)(ql_ + r32) * 2560 + 64 * hq + c * 16 + hi * 8); \
            _Pragma("unroll") for (int c = 0; c < 2; ++c) { const f32x4* cs = (const f32x4*)(rope + (size_t)(ql_ + r32) * 32 + 16 * c + 8 * hi); cn[c][0] = cs[0]; cn[c][1] = cs[1]; cn[c][2] = cs[2]; cn[c][3] = cs[3]; } } while (0)
        SWA_LDQ(0);
        for (int rb = 0; rb < 8; ++rb) {
            const int qlo = P0 + 32 * rb, qm = qlo + r32 - 4 * hi;
            bf16x8 qr[4];
            {
#pragma unroll
              for (int c = 0; c < 2; ++c) { const u32x4 a = qn[c], b = qn[c + 2]; u32x4 ra, rb_;
                  ROPE2(a.x, b.x, cn[c][0], ra.x, rb_.x); ROPE2(a.y, b.y, cn[c][1], ra.y, rb_.y); ROPE2(a.z, b.z, cn[c][2], ra.z, rb_.z); ROPE2(a.w, b.w, cn[c][3], ra.w, rb_.w);
                  qr[c] = *reinterpret_cast<bf16x8*>(&ra); qr[c + 2] = *reinterpret_cast<bf16x8*>(&rb_); } }
            __builtin_amdgcn_sched_barrier(0);
            if (rb + 1 < 8) SWA_LDQ(rb + 1);
            __builtin_amdgcn_sched_barrier(0);
            float m_reg = m0, l_reg = 1.f; f32x16 o[2] = {f32x16{}, f32x16{}};
            const int tlo = (qlo - 127 < 0) ? 0 : (qlo - 127) >> 6, thi = (qlo + 31) >> 6;
            for (int tile = tlo; tile <= thi; ++tile) {
                const int lt = tile - tile0, kb = tile * 64;
                f32x16 p0 = f32x16{}, p1 = f32x16{};
                { bf16x8 b0[4], b1[4];
#pragma unroll
                  for (int cl = 0; cl < 4; ++cl) { b0[cl] = *(const LAS bf16x8*)(kb4[cl] + lt * KT); b1[cl] = *(const LAS bf16x8*)(kb4[cl] + lt * KT + 32 * 128); }
#pragma unroll
                  for (int cl = 0; cl < 4; ++cl) { p0 = __builtin_amdgcn_mfma_f32_32x32x16_bf16(b0[cl], qr[cl], p0, 0, 0, 0); p1 = __builtin_amdgcn_mfma_f32_32x32x16_bf16(b1[cl], qr[cl], p1, 0, 0, 0); } }
                mask_tile(p0, p1, qm - kb, 128u);
                bf16x8 pa0, pa1, pa2, pa3;
                const float alpha = softmax_tile(p0, p1, m_reg, l_reg, C2, pa0, pa1, pa2, pa3);
                if (__any(alpha < 1.f)) { if (hi == 0) al_l[r32] = alpha; LGKM0();
#pragma unroll
                    for (int d = 0; d < 2; ++d)
#pragma unroll
                        for (int r = 0; r < 16; ++r) o[d][r] *= al_l[crow(r, hi)]; }
                pv_tile<0, 2, 1024>(o, vbase + lt * VT, pa0, pa1, pa2, pa3);
            }
            if (hi == 0) li_l[r32] = l_reg; LGKM0();
            int hi_o = hi, r32_o = r32; asm volatile("" : "+v"(hi_o), "+v"(r32_o));
            bf16_t* Ow = hcat + (size_t)qlo * 2048 + 64 * hq;
#pragma unroll
            for (int r = 0; r < 16; ++r) { const int orow = crow(r, hi_o); const float rl = 1.0f / li_l[orow];
#pragma unroll
                for (int d = 0; d < 2; ++d) { const float v = o[d][r] * rl; const float vn = __int_as_float(__builtin_amdgcn_update_dpp(0, __float_as_int(v), 0xB1, 0xF, 0xF, true));
                    if ((r32_o & 1) == 0) *(unsigned*)(Ow + (size_t)orow * 2048 + d * 32 + r32_o) = cvt_pk_bf16(v, vn); } }
        }
    }
    __syncthreads();
}

__device__ __forceinline__ void ph_mla_prep(const Frame& F) {
    const bf16_t* proj = WSP(bf16_t, WS_PROJ); const float* qn = F.in[8]; const float* kvn = F.in[9];
    bf16_t* cqn = WSP(bf16_t, WS_CQN); bf16_t* ckvn = WSP(bf16_t, WS_CKVN); bf16_t* kpe = WSP(bf16_t, WS_KPE); const float2* rope = WSP(float2, WS_ROPE);
    const int lane = F.lane;
    const int tstep = F.G * 8;
    for (int t0 = F.bid * 8 + F.wid; t0 < T; t0 += 2 * tstep) {
        u32x2 wq[2][3], wk[2][2]; bf16_t k1[2], k2[2]; float2 cs[2]; bool ok[2];
#pragma unroll
        for (int q = 0; q < 2; ++q) { const int t = t0 + q * tstep; ok[q] = t < T; const int tc = ok[q] ? t : t0; const bf16_t* pr = proj + (size_t)tc * IN_PAD;
#pragma unroll
            for (int j = 0; j < 3; ++j) wq[q][j] = *(const u32x2*)(pr + OFF_CQ + 4 * lane + 256 * j);
#pragma unroll
            for (int j = 0; j < 2; ++j) wk[q][j] = *(const u32x2*)(pr + OFF_CKV + 4 * lane + 256 * j);
            k1[q] = pr[OFF_KR + (lane & 31)]; k2[q] = pr[OFF_KR + 32 + (lane & 31)]; cs[q] = rope[tc * 32 + (lane & 31)]; }
        f32x4 gq[3], gk[2];
#pragma unroll
        for (int j = 0; j < 3; ++j) gq[j] = *(const f32x4*)(qn + 4 * lane + 256 * j);
#pragma unroll
        for (int j = 0; j < 2; ++j) gk[j] = *(const f32x4*)(kvn + 4 * lane + 256 * j);
#pragma unroll
        for (int q = 0; q < 2; ++q) { const int t = t0 + q * tstep; if (!ok[q]) break;
            { float v[3][4]; float ss = 0.f;
#pragma unroll
              for (int j = 0; j < 3; ++j) { const u32x2 w = wq[q][j]; v[j][0] = bflo(w.x); v[j][1] = bfhi(w.x); v[j][2] = bflo(w.y); v[j][3] = bfhi(w.y);
                  ss += v[j][0] * v[j][0] + v[j][1] * v[j][1] + v[j][2] * v[j][2] + v[j][3] * v[j][3]; }
              ss = wave_sum(ss); const float rstd = rsqrtf(ss * (1.0f / 768.0f) + EPS);
#pragma unroll
              for (int j = 0; j < 3; ++j) { const int col = 4 * lane + 256 * j; const f32x4 g = gq[j];
                  u32x2 o; o.x = cvt_pk_bf16(v[j][0] * rstd * g[0], v[j][1] * rstd * g[1]); o.y = cvt_pk_bf16(v[j][2] * rstd * g[2], v[j][3] * rstd * g[3]);
                  *(u32x2*)(cqn + (size_t)t * 768 + col) = o; } }
            { float v[2][4]; float ss = 0.f;
#pragma unroll
              for (int j = 0; j < 2; ++j) { const u32x2 w = wk[q][j]; v[j][0] = bflo(w.x); v[j][1] = bfhi(w.x); v[j][2] = bflo(w.y); v[j][3] = bfhi(w.y);
                  ss += v[j][0] * v[j][0] + v[j][1] * v[j][1] + v[j][2] * v[j][2] + v[j][3] * v[j][3]; }
              ss = wave_sum(ss); const float rstd = rsqrtf(ss * (1.0f / 512.0f) + EPS);
#pragma unroll
              for (int j = 0; j < 2; ++j) { const int col = 4 * lane + 256 * j; const f32x4 g = gk[j];
                  u32x2 o; o.x = cvt_pk_bf16(v[j][0] * rstd * g[0], v[j][1] * rstd * g[1]); o.y = cvt_pk_bf16(v[j][2] * rstd * g[2], v[j][3] * rstd * g[3]);
                  *(u32x2*)(ckvn + (size_t)t * 512 + col) = o; } }
            if (lane < 32) { const float x1 = bf2f(k1[q]), x2 = bf2f(k2[q]);
                kpe[(size_t)t * 64 + lane] = f2bf(x1 * cs[q].x - x2 * cs[q].y); kpe[(size_t)t * 64 + 32 + lane] = f2bf(x2 * cs[q].x + x1 * cs[q].y); }
        }
    }
}

__device__ __forceinline__ void ph_gates(const Frame& F) {
    const bf16_t* proj = WSP(bf16_t, WS_PROJ); const float* bif = F.in[6];
    float* GA = WSP(float, WS_GA); float* GB = WSP(float, WS_GB); float* GCM = WSP(float, WS_GCM); float* GST = WSP(float, WS_GST);
    const int lane = F.lane;
    for (int u = F.bid * 8 + F.wid; u < NCH * 4; u += F.G * 8) {
        const int c = u >> 2, h = u & 3, t = c * 64 + lane;
        const float ipre = bf2f(proj[(size_t)t * IN_PAD + OFF_MI + h]) + bif[h], fpre = bf2f(proj[(size_t)t * IN_PAD + OFF_MF + h]) + bif[4 + h];
        const float ig = 15.0f * tanhf(ipre * (1.0f / 15.0f)); const float z = 15.0f * tanhf(fpre * (1.0f / 15.0f));
        const float lf = (z >= 0.f) ? -log1pf(expf(-z)) : z - log1pf(expf(z));
        float b = lf;
#pragma unroll
        for (int o = 1; o < 64; o <<= 1) { const float v = __shfl_up(b, o); if (lane >= o) b += v; }
        const float a = ig - b;
        float cm = a;
#pragma unroll
        for (int o = 1; o < 64; o <<= 1) { const float v = __shfl_up(cm, o); if (lane >= o) cm = fmaxf(cm, v); }
        GA[h * T + t] = a; GB[h * T + t] = b; GCM[h * T + t] = cm;
        if (lane == 63) { GST[h * 256 + c] = cm; GST[1024 + h * 256 + c] = b; }
    }
}

__device__ __forceinline__ void m_scan(const Frame& F, LAS float* mst) {
    float* GST = WSP(float, WS_GST);
    LAS float* tmp = mst + 4 * 257 + 3;
    __syncthreads();
    for (int i = F.tid; i < 2048; i += NTHREADS) tmp[i] = GST[i];
    __syncthreads();
    if (F.tid < 4) { const int h = F.tid; float m = 0.f; mst[h * 257] = 0.f;
        for (int c = 0; c < 256; ++c) { m = tmp[1024 + h * 256 + c] + fmaxf(m, tmp[h * 256 + c]); mst[h * 257 + c + 1] = m; } }
    __syncthreads();
    if (F.bid == 0) for (int i = F.tid; i < 4 * 257; i += NTHREADS) GST[2048 + i] = mst[i];
}

__device__ __forceinline__ void ph_rope_q(const Frame& F) {
    const float2* rope = WSP(float2, WS_ROPE); bf16_t* qraw = WSP(bf16_t, WS_QRAW);
    for (int idx = F.bid * NTHREADS + F.tid; idx < T * 32; idx += F.G * NTHREADS) {
        const int t = idx >> 5, hh = (idx >> 2) & 7, pc = idx & 3;
        bf16_t* p = qraw + (size_t)t * 1536 + hh * 192 + 128 + pc * 8;
        const u32x4 a = *(const u32x4*)p, b = *(const u32x4*)(p + 32);
        const f32x4* cs = (const f32x4*)(rope + (size_t)t * 32 + pc * 8);
        const f32x4 c0 = cs[0], c1 = cs[1], c2 = cs[2], c3 = cs[3];
        u32x4 ra, rb_;
        ROPE2(a.x, b.x, c0, ra.x, rb_.x); ROPE2(a.y, b.y, c1, ra.y, rb_.y); ROPE2(a.z, b.z, c2, ra.z, rb_.z); ROPE2(a.w, b.w, c3, ra.w, rb_.w);
        *(u32x4*)p = ra; *(u32x4*)(p + 32) = rb_;
    }
}

#define TRF(dst, base, TOFF, d0, ks) do { const s16x4 l_ = trrd<(TOFF) + v_rd_off(d0, ks, 0)>(base); const s16x4 h_ = trrd<(TOFF) + v_rd_off(d0, ks, 1)>(base); LGKM0(); dst = cat44(l_, h_); } while (0)
__device__ __forceinline__ void ph_mlstm_B(const Frame& F, const LAS float* mst) {
    const bf16_t* proj = WSP(bf16_t, WS_PROJ); const float* GA = WSP(float, WS_GA); const float* GST = WSP(float, WS_GST);
    bf16_t* dC = WSP(bf16_t, WS_DC); float* DN = WSP(float, WS_DN);
    LAS unsigned char* lds = F.lds;
    const int tid = F.tid, lane = F.lane, w = F.wid, r32 = lane & 31, hi = lane >> 5;
    const int lbase = (int)(uintptr_t)lds + v_rd_base(lane);
    for (int u = F.bid; u < NCH * 4; u += F.G) {
        const int c = u >> 2, h = u & 3, t0 = c * 64;
        const float mx = fmaxf(mst[h * 257 + c], GST[h * 256 + c]);
        __syncthreads();
#pragma unroll
        for (int i = 0; i < 2; ++i) { const int q = tid + NTHREADS * i, s = q >> 4, dc = (q & 15) * 8;
            const u32x4 raw = *(const u32x4*)(proj + (size_t)(t0 + s) * IN_PAD + OFF_MK + h * 128 + dc);
            const float wsc = expf(GA[h * T + t0 + s] - mx) * 0.08838834764831845f;
            u32x4 o; o.x = cvt_pk_bf16(bflo(raw.x) * wsc, bfhi(raw.x) * wsc); o.y = cvt_pk_bf16(bflo(raw.y) * wsc, bfhi(raw.y) * wsc);
            o.z = cvt_pk_bf16(bflo(raw.z) * wsc, bfhi(raw.z) * wsc); o.w = cvt_pk_bf16(bflo(raw.w) * wsc, bfhi(raw.w) * wsc);
            *(LAS u32x4*)(lds + v_st(s, dc)) = o; }
#pragma unroll
        for (int i = 0; i < 4; ++i) { const int q = tid + NTHREADS * i, s = q >> 5, vc = (q & 31) * 8;
            const u32x4 raw = *(const u32x4*)(proj + (size_t)(t0 + s) * IN_PAD + OFF_MV + h * 256 + vc);
            *(LAS u32x4*)(lds + 16384 + (vc >> 7) * 16384 + v_st(s, vc & 127)) = raw; }
        __syncthreads();
        bf16x8 Bf[4];
        {
            const int vb = lbase + 16384 + (w >> 2) * 16384 + (w & 3) * 512;
            TRF(Bf[0], vb, 0, 0, 0); TRF(Bf[1], vb, 0, 0, 1); TRF(Bf[2], vb, 0, 0, 2); TRF(Bf[3], vb, 0, 0, 3);
        }
        f32x16 acc[4];
#define MB_STEP(mb) do { bf16x8 a0, a1, a2, a3; TRF(a0, lbase, 0, mb, 0); TRF(a1, lbase, 0, mb, 1); TRF(a2, lbase, 0, mb, 2); TRF(a3, lbase, 0, mb, 3); \
        f32x16 z = f32x16{}; z = __builtin_amdgcn_mfma_f32_32x32x16_bf16(a0, Bf[0], z, 0, 0, 0); z = __builtin_amdgcn_mfma_f32_32x32x16_bf16(a1, Bf[1], z, 0, 0, 0); \
        z = __builtin_amdgcn_mfma_f32_32x32x16_bf16(a2, Bf[2], z, 0, 0, 0); z = __builtin_amdgcn_mfma_f32_32x32x16_bf16(a3, Bf[3], z, 0, 0, 0); acc[mb] = z; } while (0)
        MB_STEP(0); MB_STEP(1); MB_STEP(2); MB_STEP(3);
#undef MB_STEP
        bf16_t* outp = dC + ((size_t)u * 256 + w * 32 + r32) * 128;
#pragma unroll
        for (int mb = 0; mb < 4; ++mb)
#pragma unroll
            for (int rq = 0; rq < 4; ++rq) { u32x2 o; o.x = cvt_pk_bf16(acc[mb][4 * rq + 0], acc[mb][4 * rq + 1]); o.y = cvt_pk_bf16(acc[mb][4 * rq + 2], acc[mb][4 * rq + 3]);
                *(u32x2*)(outp + mb * 32 + 8 * rq + 4 * hi) = o; }
        if (tid < 128) { float s_ = 0.f; const int d = tid;
            for (int s = 0; s < 64; ++s) s_ += bf2f(*(const LAS bf16_t*)(lds + v_st(s, d & ~7) + (d & 7) * 2));
            DN[(size_t)u * 128 + d] = s_; }
    }
    __syncthreads();
}

__device__ __forceinline__ void mlstm_C_item(const Frame& F, int item) {
    const float* GST = WSP(float, WS_GST);
    const bf16_t* dC = WSP(bf16_t, WS_DC); bf16_t* Cst = WSP(bf16_t, WS_CST); const float* DN = WSP(float, WS_DN); float* NST = WSP(float, WS_NST);
    LAS float* dec = (LAS float*)F.aux;
    __syncthreads();
    for (int i = F.tid; i < 1024; i += NTHREADS) { const int h = i >> 8, c = i & 255; const float m = GST[2048 + h * 257 + c]; dec[i] = expf(m - fmaxf(m, GST[h * 256 + c])); }
    __syncthreads();
    if (item < 64) {
        const int it = item * 512 + F.tid;
        const int h = it >> 13, rem = it & 8191;
        const size_t off0 = (size_t)h * 256 * 128 + (size_t)rem * 4;
        float s0 = 0.f, s1 = 0.f, s2 = 0.f, s3 = 0.f;
        u32x2 buf[16];
#pragma unroll
        for (int j = 0; j < 16; ++j) buf[j] = __builtin_nontemporal_load((const u32x2*)(dC + (size_t)j * 131072 + off0));
        for (int cb = 0; cb < 256; cb += 16) {
            u32x2 nb[16];
            if (cb + 16 < 256) {
#pragma unroll
                for (int j = 0; j < 16; ++j) nb[j] = __builtin_nontemporal_load((const u32x2*)(dC + (size_t)(cb + 16 + j) * 131072 + off0));
            }
#pragma unroll
            for (int j = 0; j < 16; ++j) {
                const unsigned long long o = (unsigned long long)cvt_pk_bf16(s0, s1) | ((unsigned long long)cvt_pk_bf16(s2, s3) << 32);
                __hip_atomic_store((unsigned long long*)(Cst + (size_t)(cb + j) * 131072 + off0), o, __ATOMIC_RELAXED, __HIP_MEMORY_SCOPE_AGENT);
                const float d = dec[h * 256 + cb + j];
                s0 = d * s0 + bflo(buf[j].x); s1 = d * s1 + bfhi(buf[j].x); s2 = d * s2 + bflo(buf[j].y); s3 = d * s3 + bfhi(buf[j].y);
            }
            if (cb + 16 < 256) {
#pragma unroll
                for (int j = 0; j < 16; ++j) buf[j] = nb[j];
            }
        }
    } else {
        const int it = F.tid; const int h = it >> 7;
        float s = 0.f;
#pragma unroll 16
        for (int c = 0; c < 256; ++c) { __hip_atomic_store((unsigned*)&NST[(size_t)c * 512 + it], __float_as_uint(s), __ATOMIC_RELAXED, __HIP_MEMORY_SCOPE_AGENT); s = dec[h * 256 + c] * s + DN[(size_t)c * 512 + it]; }
    }
}

__device__ __forceinline__ void ph_mlstm_D(const Frame& F) {
    const bf16_t* proj = WSP(bf16_t, WS_PROJ); const float* GA = WSP(float, WS_GA); const float* GB = WSP(float, WS_GB); const float* GCM = WSP(float, WS_GCM);
    const float* GST = WSP(float, WS_GST); const bf16_t* Cst = WSP(bf16_t, WS_CST); const float* NST = WSP(float, WS_NST);
    const float* gain = F.in[7]; bf16_t* hcat = WSP(bf16_t, WS_HCAT);
    const int tid = F.tid, lane = F.lane, r32 = lane & 31, hi = lane >> 5;
    const int hb = F.wid >> 2, wl = F.wid & 3, rh = wl & 1, vh = wl >> 1, htid = tid & 255;
    LAS unsigned char* hl = F.lds + hb * 40960;
    LAS float* a_l = (LAS float*)(hl + 32768); LAS float* n_l = (LAS float*)(hl + 33024); LAS float* rowss = (LAS float*)(hl + 33536);
    LAS float* scr = (LAS float*)(hl + 34048 + wl * 256);
    for (int pi = F.bid; pi < NCH * 2; pi += F.G) {
        const int u = pi * 2 + hb, c = u >> 2, h = u & 3, t0 = c * 64;
        __syncthreads();
        { u32x4 raw[8];
#pragma unroll
          for (int i = 0; i < 8; ++i) { const int q = htid + 256 * i, s = q >> 5, vc = (q & 31) * 8;
              raw[i] = *(const u32x4*)(proj + (size_t)(t0 + s) * IN_PAD + OFF_MV + h * 256 + vc); }
          SBAR();
#pragma unroll
          for (int i = 0; i < 8; ++i) { const int q = htid + 256 * i, s = q >> 5, vc = (q & 31) * 8;
              *(LAS u32x4*)(hl + (vc >> 7) * 16384 + v_st(s, vc & 127)) = raw[i]; } }
        if (htid < 64) a_l[htid] = GA[h * T + t0 + htid];
        if (htid < 128) n_l[htid] = NST[(size_t)u * 128 + htid];
        __syncthreads();
        const int j = 32 * rh + r32, t = t0 + j;
        const float m_c = GST[2048 + h * 257 + c];
        const float M_j = fmaxf(m_c, GCM[h * T + t]), b_j = GB[h * T + t];
        bf16x8 qr[8];
#pragma unroll
        for (int cc = 0; cc < 8; ++cc) qr[cc] = *(const bf16x8*)(proj + (size_t)t * IN_PAD + OFF_MQ + h * 128 + cc * 16 + hi * 8);
        f32x16 p0 = f32x16{}, p1 = f32x16{};
#pragma unroll
        for (int cc = 0; cc < 8; ++cc) {
            const bf16x8 k0 = *(const bf16x8*)(proj + (size_t)(t0 + r32) * IN_PAD + OFF_MK + h * 128 + cc * 16 + hi * 8);
            const bf16x8 k1 = *(const bf16x8*)(proj + (size_t)(t0 + 32 + r32) * IN_PAD + OFF_MK + h * 128 + cc * 16 + hi * 8);
            p0 = __builtin_amdgcn_mfma_f32_32x32x16_bf16(k0, qr[cc], p0, 0, 0, 0);
            p1 = __builtin_amdgcn_mfma_f32_32x32x16_bf16(k1, qr[cc], p1, 0, 0, 0);
        }
        float dsum = 0.f;
#pragma unroll
        for (int r = 0; r < 16; ++r) {
            const int s0 = crow(r, hi), s1 = 32 + s0;
            const float e0 = __expf(fminf(a_l[s0] - M_j, 0.f)) * 0.08838834764831845f, e1 = __expf(fminf(a_l[s1] - M_j, 0.f)) * 0.08838834764831845f;
            const float w0 = (s0 <= j) ? e0 : 0.f, w1 = (s1 <= j) ? e1 : 0.f;
            p0[r] *= w0; p1[r] *= w1; dsum += p0[r] + p1[r];
        }
        { auto rr = __builtin_amdgcn_permlane32_swap(__float_as_uint(dsum), __float_as_uint(dsum), false, false); dsum = __uint_as_float(rr[0]) + __uint_as_float(rr[1]); }
        bf16x8 pa0, pa1, pa2, pa3;
        PK4(p0, 0, pa0); PK4(p0, 8, pa1); PK4(p1, 0, pa2); PK4(p1, 8, pa3);
        f32x16 o[4];
#pragma unroll
        for (int d = 0; d < 4; ++d) o[d] = f32x16{};
        const int vb0 = (int)(uintptr_t)(hl + vh * 16384) + v_rd_base(lane);
        pv_tile<0, 4>(o, vb0, pa0, pa1, pa2, pa3);
        const float w_inter = expf(m_c - M_j);
        float qn = 0.f;
        bf16x8 qs[8];
#pragma unroll
        for (int cc = 0; cc < 8; ++cc) {
            const u32x4 w = *reinterpret_cast<const u32x4*>(&qr[cc]);
            const float q0 = bflo(w.x), q1 = bfhi(w.x), q2 = bflo(w.y), q3 = bfhi(w.y), q4 = bflo(w.z), q5 = bfhi(w.z), q6 = bflo(w.w), q7 = bfhi(w.w);
            const LAS float* np = n_l + cc * 16 + hi * 8;
            qn += q0 * np[0] + q1 * np[1] + q2 * np[2] + q3 * np[3] + q4 * np[4] + q5 * np[5] + q6 * np[6] + q7 * np[7];
            u32x4 o_; o_.x = cvt_pk_bf16(q0 * w_inter, q1 * w_inter); o_.y = cvt_pk_bf16(q2 * w_inter, q3 * w_inter); o_.z = cvt_pk_bf16(q4 * w_inter, q5 * w_inter); o_.w = cvt_pk_bf16(q6 * w_inter, q7 * w_inter);
            qs[cc] = *reinterpret_cast<bf16x8*>(&o_);
        }
        { auto rr = __builtin_amdgcn_permlane32_swap(__float_as_uint(qn), __float_as_uint(qn), false, false); qn = __uint_as_float(rr[0]) + __uint_as_float(rr[1]); }
        {
            const bf16_t* cp = Cst + ((size_t)u * 256 + 128 * vh + r32) * 128 + hi * 8;
            bf16x8 cfa[8], cfb[8];
#pragma unroll
            for (int cc = 0; cc < 8; ++cc) cfa[cc] = *(const bf16x8*)(cp + cc * 16);
#pragma unroll
            for (int cc = 0; cc < 8; ++cc) cfb[cc] = *(const bf16x8*)(cp + (size_t)32 * 128 + cc * 16);
            SBAR();
#pragma unroll
            for (int cc = 0; cc < 8; ++cc) o[0] = __builtin_amdgcn_mfma_f32_32x32x16_bf16(qs[cc], cfa[cc], o[0], 0, 0, 0);
            SBAR();
#pragma unroll
            for (int cc = 0; cc < 8; ++cc) cfa[cc] = *(const bf16x8*)(cp + (size_t)64 * 128 + cc * 16);
            SBAR();
#pragma unroll
            for (int cc = 0; cc < 8; ++cc) o[1] = __builtin_amdgcn_mfma_f32_32x32x16_bf16(qs[cc], cfb[cc], o[1], 0, 0, 0);
            SBAR();
#pragma unroll
            for (int cc = 0; cc < 8; ++cc) cfb[cc] = *(const bf16x8*)(cp + (size_t)96 * 128 + cc * 16);
            SBAR();
#pragma unroll
            for (int cc = 0; cc < 8; ++cc) o[2] = __builtin_amdgcn_mfma_f32_32x32x16_bf16(qs[cc], cfa[cc], o[2], 0, 0, 0);
            SBAR();
#pragma unroll
            for (int cc = 0; cc < 8; ++cc) o[3] = __builtin_amdgcn_mfma_f32_32x32x16_bf16(qs[cc], cfb[cc], o[3], 0, 0, 0);
        }
        const float den = dsum + w_inter * qn;
        const float inv = 1.0f / fmaxf(fabsf(den), expf(-(b_j + M_j)));
        if (hi == 0) scr[r32] = inv;
        LGKM0();
        float ss[16];
#pragma unroll
        for (int r = 0; r < 16; ++r) { const float iv = scr[crow(r, hi)]; float a = 0.f;
#pragma unroll
            for (int d = 0; d < 4; ++d) { o[d][r] *= iv; a += o[d][r] * o[d][r]; }
            a = dpp_add<0xB1>(a); a = dpp_add<0x4E>(a); a = dpp_add<0x141>(a); a = dpp_add<0x140>(a);
            a += __int_as_float(__builtin_amdgcn_ds_swizzle(__float_as_int(a), 0x401F));
            ss[r] = a; }
        if (r32 == 0) {
#pragma unroll
            for (int r = 0; r < 16; ++r) rowss[vh * 64 + 32 * rh + crow(r, hi)] = ss[r]; }
        __syncthreads();
#pragma unroll
        for (int r = 0; r < 16; ++r) { const int jr = 32 * rh + crow(r, hi);
#pragma unroll
            for (int d = 0; d < 4; ++d) *(LAS bf16_t*)(hl + jr * 512 + (128 * vh + 32 * d + r32) * 2) = f2bf(o[d][r]); }
        __syncthreads();
        { u32x4 ov[8], mv[8];
#pragma unroll
          for (int i = 0; i < 8; ++i) { const int q = htid + 256 * i, row = q >> 5, c8 = (q & 31) * 8;
              ov[i] = *(const LAS u32x4*)(hl + row * 512 + c8 * 2);
              mv[i] = *(const u32x4*)(proj + (size_t)(t0 + row) * IN_PAD + OFF_MO + h * 256 + c8); }
#pragma unroll
          for (int i = 0; i < 8; ++i) { const int q = htid + 256 * i, row = q >> 5, c8 = (q & 31) * 8;
              const float rstd = rsqrtf((rowss[row] + rowss[64 + row]) * (1.0f / 256.0f) + EPS);
              const f32x4 g0 = *(const f32x4*)(gain + h * 256 + c8), g1 = *(const f32x4*)(gain + h * 256 + c8 + 4);
              float v[8];
#pragma unroll
              for (int e = 0; e < 4; ++e) { const unsigned ow = ov[i][e], mw = mv[i][e];
                  v[2 * e] = bflo(ow) * rstd * ((e < 2) ? g0[2 * e] : g1[2 * e - 4]) * __builtin_amdgcn_rcpf(1.0f + __expf(-bflo(mw)));
                  v[2 * e + 1] = bfhi(ow) * rstd * ((e < 2) ? g0[2 * e + 1] : g1[2 * e - 3]) * __builtin_amdgcn_rcpf(1.0f + __expf(-bfhi(mw))); }
              u32x4 w; w.x = cvt_pk_bf16(v[0], v[1]); w.y = cvt_pk_bf16(v[2], v[3]); w.z = cvt_pk_bf16(v[4], v[5]); w.w = cvt_pk_bf16(v[6], v[7]);
              *(u32x4*)(hcat + (size_t)(t0 + row) * 2048 + h * 256 + c8) = w; } }
    }
    __syncthreads();
}

constexpr int NPHASE = 26;
__device__ __forceinline__ void moe_phase_router(const Frame& F, int layer) {
    PolRouter p; p.A = WSP(bf16_t, WS_H2); p.Bt = WSP(bf16_t, WS_WR) + (size_t)layer * 256 * 2048; p.part = WSP(float, WS_LOGP); p.K = 512; p.ldb = 2048;
    pg8::gemm_phase(F.lds, p);
}
__device__ __forceinline__ void moe_phase_gateup(const Frame& F, int layer) {
    PolGateUp p; p.A = WSP(bf16_t, WS_H2); p.W = WSP(bf16_t, WS_WGU) + (size_t)layer * 65 * 512 * 2048; p.rowtok = WSP(int, WS_ROWTOK); p.act = WSP(bf16_t, WS_ACT);
    p.tb = moe_tables(F); p.K = 2048; p.ldb = 2048;
    {
        LAS int* ridx = (LAS int*)(F.aux + 6144);
        for (int idx = F.tid; idx < 8 * 256; idx += NTHREADS) { const int i = idx >> 8, r = idx & 255, L = p.tb.rank + i * p.tb.nrank;
            if (L < p.tb.nrb * 2) ridx[idx] = p.rowtok[p.tb.blk_row0[p.tb.rb0 + (L >> 1)] + r]; }
        __syncthreads();
        p.ridx = ridx; }
    pg8::gemm_phase(F.lds, p);
}
__device__ __forceinline__ void moe_phase_down(const Frame& F, int layer, int nostore = 0) {
    PolDown p; p.nostore = nostore; p.A = WSP(bf16_t, WS_ACT); p.W = WSP(bf16_t, WS_WDN) + (size_t)layer * 65 * 2048 * 256; p.Y = WSP(unsigned char, WS_Y);
    p.tb = moe_tables(F); p.K = 256; p.ldb = 256;
    pg8::gemm_phase(F.lds, p);
}

__global__ void __launch_bounds__(NTHREADS, 2) mk_fwd(Args args) {
    extern __shared__ __attribute__((aligned(16))) unsigned char lds_raw[];
    Frame F;
    F.lds = (LAS unsigned char*)lds_raw; F.aux = F.lds + LDS_MAIN;
    F.in = args.in; F.out = args.out; F.ws = args.ws;
    F.tid = threadIdx.x; F.lane = F.tid & 63; F.wid = __builtin_amdgcn_readfirstlane(F.tid >> 6); F.G = gridDim.x; F.bid = blockIdx.x;
    volatile LAS unsigned* xbw = (volatile LAS unsigned*)(F.lds + LDS_MAIN + LDS_AUX);
    if (F.tid < 4) xbw[F.tid] = 0u;
    __syncthreads();
    const int lo = args.ph_lo, hi = args.ph_hi;
    XcdBarrier bar; bar.bar = WSP(unsigned, WS_ZERO + ZB_BAR); bar.x = 0; bar.st = xbw;
    if (hi - lo > 1) bar = xcd_barrier_post(WSP(unsigned, WS_ZERO + ZB_BAR), xbw);
#ifdef PH_ONLY
#define IN(k) ((k) == PH_ONLY)
#else
#define IN(k) (lo <= (k) && (k) < hi)
#endif
#define SEAM(k) do { if (IN(k) && IN((k) + 1)) xcd_barrier(bar); { int t_ = threadIdx.x; asm volatile("" : "+v"(t_)); F.tid = t_; F.lane = t_ & 63; F.wid = __builtin_amdgcn_readfirstlane(t_ >> 6); } } while (0)
    const float* mod = WSP(float, WS_ZERO + ZB_MOD);
    const float* mod0 = mod; const float* mod1 = mod + 12288;

    if (IN(0)) { PRB(0) { ph_adaln(F); ph_rope_table(F); ph_convert(F); } } SEAM(0);
#if PROBE_EXTRA_BARRIERS
    if (hi - lo > 1) { for (int xb = 0; xb < 16; ++xb) xcd_barrier(bar); }
#endif
    if (IN(1)) { PRB(15) ph_modulate<0>(F, F.in[0], mod0 + 0, mod0 + 2048, WSP(bf16_t, WS_HA)); } SEAM(1);
    if (IN(2)) { PRB(5) { PolBf16 p{{WSP(bf16_t, WS_HA), WSP(bf16_t, WS_WIN), 2048, 2048, 2048, 64, IN_PAD / 256}, WSP(bf16_t, WS_PROJ), IN_PAD, nullptr}; pg8::gemm_phase(F.lds, p); } } SEAM(2);
    if (IN(3)) { PRB(14) { ph_mla_prep(F); ph_gates(F); } } SEAM(3);
    if (IN(4)) {
        LAS float* mst = (LAS float*)F.aux;
        m_scan(F, mst);
        { PolBf16 p{{WSP(bf16_t, WS_CQN), WSP(bf16_t, WS_WUQ), 768, 768, 768, 64, 6}, WSP(bf16_t, WS_QRAW), 1536, nullptr}; pg8::gemm_phase(F.lds, p); }
        { PolBf16KV p{{{WSP(bf16_t, WS_CKVN), WSP(bf16_t, WS_WUKV), 512, 512, 512, 64, 8}, WSP(bf16_t, WS_KVRAW), 2048, nullptr}}; pg8::gemm_phase(F.lds, p); }
        PRB(12) ph_mlstm_B(F, mst);
    } SEAM(4);
    if (IN(6)) {
        {
            unsigned* cctr = WSP(unsigned, WS_ZERO + ZB_CTR + 256); unsigned* cdone = WSP(unsigned, WS_ZERO + ZB_CTR + 384);
            for (;;) { const int c = grab(F, cctr); if (c >= 65) break;
                mlstm_C_item(F, c);
                asm volatile("s_waitcnt vmcnt(0)" ::: "memory"); __syncthreads();
                if (F.tid == 0) (void)__hip_atomic_fetch_add(cdone, 1u, __ATOMIC_RELAXED, __HIP_MEMORY_SCOPE_AGENT); }
        }
        AttnBlk<192, 128, 64> A;
        A.ldq = 1536; A.ldk1 = 2048; A.K2 = WSP(bf16_t, WS_KPE); A.ldk2 = 64; A.ldv = 2048; A.ldo = 2048;
        A.C2 = 0.07216878364870323f * 1.4426950408889634f; A.m_init = -1e30f; A.l_init = 0.f; A.W = 1u << 30; A.wrow = 32; A.wq = 0; A.wo = 0; A.sinks = nullptr; A.sink_scale = 0.f; A.ropeq = WSP(float2, WS_ROPE);
        const bool cvt_first = F.bid < MCV_BLOCKS;
        if (cvt_first) moe_cvt_queue(F);
        unsigned* actr = WSP(unsigned, WS_ZERO + ZB_CTR + 128);
        for (;;) {
            const int u = grab(F, actr); if (u >= 512) break;
            const int h = u & 7, qb = 63 - (u >> 3);
            A.Q = WSP(bf16_t, WS_QRAW) + 192 * h; A.K1 = WSP(bf16_t, WS_KVRAW) + 256 * h; A.V = WSP(bf16_t, WS_KVRAW) + 256 * h + 128; A.O = WSP(bf16_t, WS_HCAT) + 1024 + 128 * h;
            A.run(F.lds, qb * 256, 0, qb * 4 + 4);
        }
        if (!cvt_first) moe_cvt_queue(F);
        __syncthreads();
        {
            unsigned* cdone = WSP(unsigned, WS_ZERO + ZB_CTR + 384);
            if (F.tid == 0) { unsigned sp = 0; while (__hip_atomic_load(cdone, __ATOMIC_RELAXED, __HIP_MEMORY_SCOPE_AGENT) < 65u) { __builtin_amdgcn_s_sleep(1); if (++sp > (1u << 24)) break; }
                __builtin_amdgcn_fence(__ATOMIC_ACQUIRE, "agent"); }
            __syncthreads();
            ph_mlstm_D(F);
        }
        __syncthreads();
    } SEAM(6);
    if (IN(7)) { PolResid<false> p{{WSP(bf16_t, WS_HCAT), WSP(bf16_t, WS_WOUT), 2048, 2048, 2048, 64, 8}, F.in[0], mod0 + 4096, WSP(bf16_t, WS_XA)}; pg8::gemm_phase(F.lds, p); } SEAM(7);
    if (IN(8)) { PRB(4) ph_modulate<1>(F, WSP(bf16_t, WS_XA), mod0 + 6144, mod0 + 8192, WSP(bf16_t, WS_H2)); } SEAM(8);
    if (IN(9)) { PRB(6) moe_phase_router(F, 0); } SEAM(9);
    if (IN(10)) { PRB(9) ph_route(F, 0); } SEAM(10);
    if (IN(11)) { PRB(9) ph_dispatch(F); } SEAM(11);
    if (IN(12)) { PRB(1) moe_phase_gateup(F, 0); } SEAM(12);
    if (IN(13)) { moe_phase_down(F, 0);
#if PROBE_DOWN_NOSTORE == 1
        moe_phase_down(F, 0, 1);
#elif PROBE_DOWN_NOSTORE == 2
        moe_phase_down(F, 0, 0);
#endif
    } SEAM(13);
    if (IN(14)) { PRB(3) ph_combine<0>(F, WSP(bf16_t, WS_XA), mod0 + 10240, WSP(bf16_t, WS_XB), mod1 + 0, mod1 + 2048, WSP(bf16_t, WS_HA), nullptr); } SEAM(14);
    if (IN(15)) { PolBf16 p{{WSP(bf16_t, WS_HA), WSP(bf16_t, WS_WQKV), 2048, 2048, 2048, 64, 10}, WSP(bf16_t, WS_PROJ), 2560, F.in[14]}; pg8::gemm_phase(F.lds, p); } SEAM(15);
    if (IN(17)) { PRB(7) ph_swa(F);
    } SEAM(17);
    if (IN(18)) { PolResid<true> p{{WSP(bf16_t, WS_HCAT), WSP(bf16_t, WS_WO), 2048, 2048, 2048, 64, 8}, WSP(bf16_t, WS_XB), mod1 + 4096, WSP(bf16_t, WS_XA)}; pg8::gemm_phase(F.lds, p); } SEAM(18);
    if (IN(19)) { ph_modulate<1>(F, WSP(bf16_t, WS_XA), mod1 + 6144, mod1 + 8192, WSP(bf16_t, WS_H2)); } SEAM(19);
    if (IN(20)) { moe_phase_router(F, 1); } SEAM(20);
    if (IN(21)) { ph_route(F, 1); } SEAM(21);
    if (IN(22)) { ph_dispatch(F); } SEAM(22);
    if (IN(23)) { moe_phase_gateup(F, 1); } SEAM(23);
    if (IN(24)) { moe_phase_down(F, 1); } SEAM(24);
    if (IN(25)) { ph_combine<1>(F, WSP(bf16_t, WS_XA), mod1 + 10240, nullptr, nullptr, F.in[23], nullptr, F.out); }
#undef IN
#undef SEAM
}

#ifdef DBG_DUMP_OFF
__global__ void __launch_bounds__(512) dbg_dump(unsigned char* ws, float* out) {
    const size_t NOUT = (size_t)T * D;
    for (size_t i = (size_t)blockIdx.x * 512 + threadIdx.x; i < NOUT; i += (size_t)gridDim.x * 512) {
        float a = 0.f;
        for (size_t j = i; j < (size_t)(DBG_DUMP_N); j += NOUT) a += (DBG_DUMP_KIND == 0) ? bf2f(((const bf16_t*)(ws + DBG_DUMP_OFF))[j]) : (DBG_DUMP_KIND == 1 ? ((const float*)(ws + DBG_DUMP_OFF))[j] : (DBG_DUMP_KIND == 2 ? (float)((const int*)(ws + DBG_DUMP_OFF))[j] : ((((const int*)(ws + DBG_DUMP_OFF))[j] < 0 || ((const int*)(ws + DBG_DUMP_OFF))[j] > 63) ? 1.0e6f : 0.0f)));
        if (DBG_DUMP_KIND == 4) { a = 0.f; if (i < (size_t)T * 8) { const int sl = ((const int*)(ws + WS_PSLOT))[i]; const int tk = (sl >= 0 && sl < NSLOT) ? ((const int*)(ws + WS_ROWTOK))[sl] : -7; a = (tk == (int)(i >> 3)) ? 0.f : 1.0e6f; } }
        if (DBG_DUMP_KIND == 5) { const int t = (int)(i >> 11), c = (int)(i & 2047); const bf16_t* Yp = (const bf16_t*)(ws + WS_Y); a = bf2f(Yp[(size_t)t * 2048 + c]);
            for (int k = 0; k < 8; ++k) { const int sl = ((const int*)(ws + WS_PSLOT))[t * 8 + k]; a += bf2f(Yp[(size_t)sl * 2048 + c]); } }
        if (DBG_DUMP_KIND == 6) { const int t = (int)(i >> 11), c = (int)(i & 2047); const bf16_t* Ap = (const bf16_t*)(ws + WS_ACT); a = 0.f; if (c < 256) { a = bf2f(Ap[(size_t)t * 256 + c]);
            for (int k = 0; k < 8; ++k) { const int sl = ((const int*)(ws + WS_PSLOT))[t * 8 + k]; a += bf2f(Ap[(size_t)sl * 256 + c]); } } }
        out[i] = a;
    }
}
#endif
extern "C" void kernel_launch(void* const* d_in, const int* in_sizes, int n_in, void* d_out, int out_size, void* d_ws, size_t ws_size, hipStream_t stream) {
    static int grid = 0;
    if (grid == 0) {
        if (n_in != 24 || out_size != T * D || ws_size < WS_END) { fprintf(stderr, "kernel_launch: unexpected shapes (n_in %d out %d ws %zu need %zu)\n", n_in, out_size, ws_size, (size_t)WS_END); grid = -1; return; }
        int dev = 0, cus = 0;
        if (hipGetDevice(&dev) != hipSuccess || hipDeviceGetAttribute(&cus, hipDeviceAttributeMultiprocessorCount, dev) != hipSuccess) { grid = -1; return; }
        if (hipFuncSetAttribute((const void*)mk_fwd, hipFuncAttributeMaxDynamicSharedMemorySize, LDS_BYTES) != hipSuccess) { fprintf(stderr, "kernel_launch: hipFuncSetAttribute failed\n"); grid = -1; return; }
        int per_cu = 0;
        if (hipOccupancyMaxActiveBlocksPerMultiprocessor(&per_cu, (const void*)mk_fwd, NTHREADS, LDS_BYTES) != hipSuccess || per_cu < 1) { fprintf(stderr, "kernel_launch: occupancy query says %d blocks per CU\n", per_cu); }
        (void)hipGetLastError();
        grid = cus;
    }
    if (grid < 0) return;
    (void)hipMemsetAsync((char*)d_ws + WS_ZERO, 0, ZERO_BYTES, stream);
    Args a; memset(&a, 0, sizeof(a));
    for (int i = 0; i < 24; ++i) a.in[i] = (const float*)d_in[i];
    a.out = (float*)d_out; a.ws = (unsigned char*)d_ws;
#if MK_MULTI
#ifdef DBG_DUMP_OFF
    for (int p = 0; p <= DBG_LAST; ++p) { a.ph_lo = p; a.ph_hi = p + 1; hipLaunchKernelGGL(mk_fwd, dim3(grid), dim3(NTHREADS), LDS_BYTES, stream, a); }
    hipLaunchKernelGGL(dbg_dump, dim3(1024), dim3(512), 0, stream, (unsigned char*)d_ws, (float*)d_out);
#else
    for (int p = 0; p < NPHASE; ++p) { a.ph_lo = p; a.ph_hi = p + 1; hipLaunchKernelGGL(mk_fwd, dim3(grid), dim3(NTHREADS), LDS_BYTES, stream, a); }
#endif
#else
    a.ph_lo = 0; a.ph_hi = NPHASE;
    hipLaunchKernelGGL(mk_fwd, dim3(grid), dim3(NTHREADS), LDS_BYTES, stream, a);
#endif
}
```
